# Optimizing an MI355X kernel written in HIP

```python
import math
import jax, jax.numpy as jnp
from jax import lax
import numpy as np

D_MODEL = 1024
BATCH = 4
SEQ = 4096
DEPTH = 1

A_HEADS = 8
A_HEAD_DIM = 64
A_PATTERNS = ((128, 1), (512, 4), (2048, 16))
B_HEADS = 8
B_HEAD_DIM = 128
CONV_K = 5
CHUNK = 64
N_EXPERTS = 32
TOP_K = 4
D_FF = D_MODEL
SWIGLU_LIMIT = 7.0
SWIGLU_ALPHA = 1.702
MOE_BLOCK = 128
EPS = 1e-6
NEG_INF = -1e30

A_WIDTH = A_HEADS * A_HEAD_DIM
B_WIDTH = B_HEADS * B_HEAD_DIM
IN_SPLITS = (A_WIDTH, A_WIDTH, A_WIDTH, 3 * B_WIDTH, B_WIDTH,
             B_HEADS, B_HEADS, B_HEADS, B_HEADS, D_MODEL, D_MODEL)
IN_COLS = sum(IN_SPLITS)

kernel_name = 'hybrid_dilated_attn_gdn_moe_encoder'


def rms_norm(x, w):
    xf = x.astype(jnp.float32)
    y = xf * lax.rsqrt(jnp.mean(xf * xf, axis=-1, keepdims=True) + EPS)
    return (y * w.astype(jnp.float32)).astype(x.dtype)


def l2_normalize(x):
    xf = x.astype(jnp.float32)
    return xf * lax.rsqrt(jnp.sum(xf * xf, axis=-1, keepdims=True) + EPS)


def alibi_slopes(n_heads):
    return jnp.asarray(2.0 ** (-8.0 * np.arange(1, n_heads + 1) / n_heads), dtype=jnp.float32)


def dilated_window_attention(q, k, v, window, dilation, slopes):
    Bsz, S, H, dh = q.shape
    blk = window // (2 * dilation)
    L = S // dilation
    nb = -(-L // blk)
    Lp = nb * blk

    def by_residue(t):
        t = t.astype(jnp.float32).reshape(Bsz, L, dilation, H, dh).transpose(0, 3, 2, 1, 4)
        return jnp.pad(t, ((0, 0), (0, 0), (0, 0), (0, Lp - L), (0, 0)))

    def key_blocks(t):
        t = jnp.pad(by_residue(t), ((0, 0), (0, 0), (0, 0), (blk, blk), (0, 0)))
        t = t.reshape(Bsz, H, dilation, nb + 2, blk, dh)
        return (t[:, :, :, :-2], t[:, :, :, 1:-1], t[:, :, :, 2:])

    qr = by_residue(q).reshape(Bsz, H, dilation, nb, blk, dh)
    kbs = key_blocks(k)
    vbs = key_blocks(v)
    scores = jnp.concatenate(
        [jnp.einsum('bhrnqd,bhrnkd->bhrnqk', qr, kk) for kk in kbs], axis=-1) * (dh ** -0.5)
    q_idx = jnp.arange(nb)[:, None] * blk + jnp.arange(blk)[None, :]
    k_idx = (jnp.arange(nb)[:, None] - 1) * blk + jnp.arange(3 * blk)[None, :]
    diff = k_idx[:, None, :] - q_idx[:, :, None]
    valid = (jnp.abs(diff) <= blk) & (k_idx[:, None, :] >= 0) & (k_idx[:, None, :] < L)
    dist = (dilation * jnp.abs(diff)).astype(jnp.float32)
    bias = -slopes[:, None, None, None] * dist[None]
    scores = jnp.where(valid, scores + bias[None, :, None], NEG_INF)
    m = jnp.max(scores, axis=-1, keepdims=True)
    p = jnp.exp(scores - m)
    l = jnp.sum(p, axis=-1, keepdims=True)
    pv = sum(jnp.einsum('bhrnqk,bhrnkd->bhrnqd', p[..., i * blk:(i + 1) * blk], vbs[i])
             for i in range(3))
    out = (pv / l).reshape(Bsz, H, dilation, Lp, dh)[:, :, :, :L]
    lse = (m[..., 0] + jnp.log(l[..., 0])).reshape(Bsz, H, dilation, Lp)[:, :, :, :L]
    out = out.transpose(0, 3, 2, 1, 4).reshape(Bsz, S, H, dh)
    lse = lse.transpose(0, 3, 2, 1).reshape(Bsz, S, H)
    return out, lse


def dilated_attention_branch(qa, ka, va):
    Bsz, S, _ = qa.shape
    shp = (Bsz, S, A_HEADS, A_HEAD_DIM)
    q, k, v = qa.reshape(shp), ka.reshape(shp), va.reshape(shp)
    slopes = alibi_slopes(A_HEADS)
    results = [dilated_window_attention(q, k, v, w, r, slopes) for (w, r) in A_PATTERNS]
    outs = jnp.stack([o for o, _ in results])
    lses = jnp.stack([s for _, s in results])
    wts = jax.nn.softmax(lses, axis=0)
    o = jnp.sum(wts[..., None] * outs, axis=0)
    return o.reshape(Bsz, S, A_WIDTH).astype(qa.dtype)


def centred_depthwise_conv(x, w):
    C = x.shape[-1]
    return lax.conv_general_dilated(
        x, w[:, None, :].astype(x.dtype), window_strides=(1,),
        padding=((CONV_K // 2, CONV_K // 2),),
        dimension_numbers=('NWC', 'WIO', 'NWC'), feature_group_count=C)


def gated_delta_rule_chunked(q, k, v, g, beta):
    Bsz, S, H, dk = q.shape
    dv = v.shape[-1]
    n = S // CHUNK

    def chunks(t):
        return t.astype(jnp.float32).reshape(Bsz, n, CHUNK, H, -1).transpose(0, 3, 1, 2, 4)

    qc, kc, vc = chunks(q), chunks(k), chunks(v)
    gc = jnp.cumsum(chunks(g[..., None])[..., 0], axis=-1)
    bc = chunks(beta[..., None])[..., 0]
    incl = jnp.tril(jnp.ones((CHUNK, CHUNK), dtype=bool))
    strict = jnp.tril(jnp.ones((CHUNK, CHUNK), dtype=bool), -1)
    gdiff = gc[..., :, None] - gc[..., None, :]
    decay = jnp.where(incl, jnp.exp(jnp.where(incl, gdiff, 0.0)), 0.0)
    kb = kc * bc[..., None]
    a_mat = jnp.where(strict, jnp.einsum('bhnid,bhnjd->bhnij', kb, kc) * decay, 0.0)
    rhs = jnp.concatenate([vc * bc[..., None], kb * jnp.exp(gc)[..., None]], axis=-1)
    sol = lax.linalg.triangular_solve(a_mat, rhs, left_side=True, lower=True,
                                      unit_diagonal=True)
    u, w = sol[..., :dv], sol[..., dv:]
    qk = jnp.einsum('bhnid,bhnjd->bhnij', qc, kc) * decay
    q_dec = qc * jnp.exp(gc)[..., None]
    k_dec = kc * jnp.exp(gc[..., -1:] - gc)[..., None]
    g_last = jnp.exp(gc[..., -1])
    to_lead = lambda t: jnp.moveaxis(t, 2, 0)
    xs = (to_lead(u), to_lead(w), to_lead(qk), to_lead(q_dec), to_lead(k_dec), to_lead(g_last))

    def step(state, inp):
        u_i, w_i, qk_i, qd_i, kd_i, gl_i = inp
        v_new = u_i - jnp.einsum('bhcd,bhde->bhce', w_i, state)
        o_i = jnp.einsum('bhcd,bhde->bhce', qd_i, state) + jnp.einsum('bhij,bhje->bhie', qk_i, v_new)
        state = state * gl_i[..., None, None] + jnp.einsum('bhcd,bhce->bhde', kd_i, v_new)
        return state, o_i

    _, o = lax.scan(step, jnp.zeros((Bsz, H, dk, dv), jnp.float32), xs)
    return o.transpose(1, 0, 3, 2, 4).reshape(Bsz, S, H, dv)


def gated_deltanet_branch(qkv, z, a_f, a_b, b_f, b_b, conv_w, a_log_f, a_log_b,
                          dt_bias_f, dt_bias_b, norm_w):
    Bsz, S, _ = qkv.shape
    shp = (Bsz, S, B_HEADS, B_HEAD_DIM)
    qkv = jax.nn.silu(centred_depthwise_conv(qkv, conv_w))
    q, k, v = jnp.split(qkv, 3, axis=-1)
    q = l2_normalize(q.reshape(shp)) * (B_HEAD_DIM ** -0.5)
    k = l2_normalize(k.reshape(shp))
    v = v.reshape(shp).astype(jnp.float32)

    def decay_and_beta(a, b, a_log, dt_bias):
        g = -jnp.exp(a_log.astype(jnp.float32)) * jax.nn.softplus(
            a.astype(jnp.float32) + dt_bias.astype(jnp.float32))
        return g, jax.nn.sigmoid(b.astype(jnp.float32))

    g_f, beta_f = decay_and_beta(a_f, b_f, a_log_f, dt_bias_f)
    g_b, beta_b = decay_and_beta(a_b, b_b, a_log_b, dt_bias_b)
    flip = lambda t: jnp.flip(t, axis=1)
    o_f = gated_delta_rule_chunked(q, k, v, g_f, beta_f)
    o_b = flip(gated_delta_rule_chunked(flip(q), flip(k), flip(v), flip(g_b), flip(beta_b)))
    o = rms_norm(o_f + o_b, norm_w) * jax.nn.silu(z.reshape(shp).astype(jnp.float32))
    return o.reshape(Bsz, S, B_WIDTH).astype(z.dtype)


def moe_ffn(h, router_w, router_b, w_gate_up, b_gate_up, w_down, b_down):
    Bsz, S, D = h.shape
    hf = h.reshape(-1, D)
    n_tok = hf.shape[0]
    logits = (hf @ router_w + router_b).astype(jnp.float32)
    top_logits, top_idx = lax.top_k(logits, TOP_K)
    gates = jax.nn.softmax(top_logits, axis=-1)
    n_assign = n_tok * TOP_K
    flat_e = top_idx.reshape(-1)
    order = jnp.argsort(flat_e)
    e_sorted = flat_e[order]
    tok_sorted = order // TOP_K
    gate_sorted = gates.reshape(-1)[order]
    counts = jnp.bincount(flat_e, length=N_EXPERTS)
    padded = (counts + MOE_BLOCK - 1) // MOE_BLOCK * MOE_BLOCK
    pad_end = jnp.cumsum(padded)
    pad_start = pad_end - padded
    start = jnp.cumsum(counts) - counts
    dest = pad_start[e_sorted] + jnp.arange(n_assign) - start[e_sorted]
    n_blocks = -(-n_assign // MOE_BLOCK) + N_EXPERTS
    slot_tok = jnp.zeros((n_blocks * MOE_BLOCK,), jnp.int32).at[dest].set(tok_sorted)
    block_expert = jnp.clip(
        jnp.searchsorted(pad_end, jnp.arange(n_blocks) * MOE_BLOCK, side='right'),
        0, N_EXPERTS - 1)
    xb = hf[slot_tok].reshape(n_blocks, MOE_BLOCK, D)

    def expert_block(args):
        xe, e = args
        gu = xe @ w_gate_up[e] + b_gate_up[e]
        x_glu = jnp.minimum(gu[:, :D_FF], SWIGLU_LIMIT)
        x_lin = jnp.clip(gu[:, D_FF:], -SWIGLU_LIMIT, SWIGLU_LIMIT)
        act = x_glu * jax.nn.sigmoid(SWIGLU_ALPHA * x_glu) * (x_lin + 1.0)
        return act @ w_down[e] + b_down[e]

    yb = lax.map(expert_block, (xb, block_expert)).reshape(-1, D)
    contrib = (yb[dest].astype(jnp.float32) * gate_sorted[:, None]).astype(h.dtype)
    out = jnp.zeros((n_tok, D), h.dtype).at[tok_sorted].add(contrib)
    return out.reshape(Bsz, S, D)


def setup_inputs(seed: int = 0) -> dict:
    key = jax.random.key(seed)
    ks = jax.random.split(key, 24)
    f32 = jnp.float32

    def normal(k, shape, fan_in):
        return jax.random.normal(k, shape, f32) * (fan_in ** -0.5)

    def gain(k, shape):
        return 1.0 + 0.01 * jax.random.normal(k, shape, f32)

    def dt_bias(k):
        dt = jnp.exp(jax.random.uniform(k, (DEPTH, B_HEADS), f32, math.log(1e-3), math.log(1e-1)))
        return dt + jnp.log(-jnp.expm1(-dt))

    return {
        'x': jax.random.normal(ks[0], (BATCH, SEQ, D_MODEL), f32),
        'norm1_w': gain(ks[1], (DEPTH, D_MODEL)),
        'w_in': normal(ks[2], (DEPTH, D_MODEL, IN_COLS), D_MODEL),
        'conv_w': normal(ks[3], (DEPTH, CONV_K, 3 * B_WIDTH), CONV_K),
        'a_log_f': jnp.log(jax.random.uniform(ks[4], (DEPTH, B_HEADS), f32, 1.0, 16.0)),
        'a_log_b': jnp.log(jax.random.uniform(ks[5], (DEPTH, B_HEADS), f32, 1.0, 16.0)),
        'dt_bias_f': dt_bias(ks[6]),
        'dt_bias_b': dt_bias(ks[7]),
        'gdn_norm_w': gain(ks[8], (DEPTH, B_HEAD_DIM)),
        'w_branch_a': normal(ks[9], (DEPTH, A_WIDTH, D_MODEL), A_WIDTH),
        'w_branch_b': normal(ks[10], (DEPTH, B_WIDTH, D_MODEL), B_WIDTH),
        'w_out': normal(ks[11], (DEPTH, D_MODEL, D_MODEL), D_MODEL),
        'norm2_w': gain(ks[12], (DEPTH, D_MODEL)),
        'router_w': normal(ks[13], (DEPTH, D_MODEL, N_EXPERTS), D_MODEL),
        'router_b': 0.01 * jax.random.normal(ks[14], (DEPTH, N_EXPERTS), f32),
        'w_gate_up': normal(ks[15], (DEPTH, N_EXPERTS, D_MODEL, 2 * D_FF), D_MODEL),
        'b_gate_up': 0.01 * jax.random.normal(ks[16], (DEPTH, N_EXPERTS, 2 * D_FF), f32),
        'w_down': normal(ks[17], (DEPTH, N_EXPERTS, D_FF, D_MODEL), D_FF),
        'b_down': 0.01 * jax.random.normal(ks[18], (DEPTH, N_EXPERTS, D_MODEL), f32),
        'norm_f_w': gain(ks[19], (D_MODEL,)),
    }


def reference(x, norm1_w, w_in, conv_w, a_log_f, a_log_b, dt_bias_f, dt_bias_b,
              gdn_norm_w, w_branch_a, w_branch_b, w_out, norm2_w, router_w, router_b,
              w_gate_up, b_gate_up, w_down, b_down, norm_f_w):
    split_points = [int(s) for s in np.cumsum(IN_SPLITS)[:-1]]
    for layer in range(DEPTH):
        h = rms_norm(x, norm1_w[layer])
        proj = h @ w_in[layer]
        (qa, ka, va, qkv_b, z_b, a_f, a_b, b_f, b_b,
         gate_a, gate_b) = jnp.split(proj, split_points, axis=-1)
        y_a = dilated_attention_branch(qa, ka, va)
        y_b = gated_deltanet_branch(qkv_b, z_b, a_f, a_b, b_f, b_b, conv_w[layer],
                                    a_log_f[layer], a_log_b[layer], dt_bias_f[layer],
                                    dt_bias_b[layer], gdn_norm_w[layer])
        merged = (jax.nn.sigmoid(gate_a) * (y_a @ w_branch_a[layer])
                  + jax.nn.sigmoid(gate_b) * (y_b @ w_branch_b[layer]))
        x = x + merged @ w_out[layer]
        h2 = rms_norm(x, norm2_w[layer])
        x = x + moe_ffn(h2, router_w[layer], router_b[layer], w_gate_up[layer],
                        b_gate_up[layer], w_down[layer], b_down[layer])
    return rms_norm(x, norm_f_w)
```

```cpp
#include <hip/hip_runtime.h>
#include <cstdint>
#include <cstdio>

constexpr int BATCH = 4, SEQ = 4096, DM = 1024, M = BATCH * SEQ;
constexpr int NIN = 7712;
constexpr int C_QA = 0, C_KA = 512, C_VA = 1024, C_QB = 1536, C_ZB = 4608, C_AF = 5632, C_AB = 5640, C_BF = 5648, C_BB = 5656, C_GA = 5664, C_GB = 6688;
constexpr int NE = 32, DFF = 1024;
constexpr float EPS = 1e-6f;

__device__ __forceinline__ float wave_sum(float v) {
#pragma unroll
    for (int o = 1; o < 64; o <<= 1) v += __shfl_xor(v, o);
    return v;
}
__device__ __forceinline__ float sigmoidf_(float x) { return 1.f / (1.f + __expf(-x)); }
__device__ __forceinline__ float siluf_(float x) { return x / (1.f + __expf(-x)); }

template <int MODE>
__global__ void __launch_bounds__(256) rmsnorm_k(const float* x, const float* w, float* out, const float* yexp) {
    const int row = blockIdx.x * 4 + (threadIdx.x >> 6), lane = threadIdx.x & 63;
    const float4* xr = (const float4*)(x + (size_t)row * DM) + lane;
    float4 v[4]; float s = 0.f;
#pragma unroll
    for (int j = 0; j < 4; ++j) {
        v[j] = xr[64 * j];
        if (MODE == 1) {
#pragma unroll
            for (int k = 0; k < 4; ++k) { const float4 y = ((const float4*)(yexp + ((size_t)row * 4 + k) * DM) + lane)[64 * j]; v[j].x += y.x; v[j].y += y.y; v[j].z += y.z; v[j].w += y.w; }
        }
        s += v[j].x * v[j].x + v[j].y * v[j].y + v[j].z * v[j].z + v[j].w * v[j].w;
    }
    const float r = rsqrtf(wave_sum(s) * (1.f / DM) + EPS);
    float4* orow = (float4*)(out + (size_t)row * DM) + lane;
#pragma unroll
    for (int j = 0; j < 4; ++j) { const float4 ww = ((const float4*)w + lane)[64 * j]; orow[64 * j] = make_float4(v[j].x * r * ww.x, v[j].y * r * ww.y, v[j].z * r * ww.z, v[j].w * r * ww.w); }
}

template <int NB>
__device__ __forceinline__ void mm64(const float* aptr, const float* b0, const float* b1, bool bvalid, int ldb, int K, float (&acc)[NB][4][4], float* As, float* Bs) {
    const int tid = threadIdx.x, ty = tid >> 4, tx = tid & 15;
#pragma unroll
    for (int nb = 0; nb < NB; ++nb)
#pragma unroll
        for (int i = 0; i < 4; ++i)
#pragma unroll
            for (int j = 0; j < 4; ++j) acc[nb][i][j] = 0.f;
    for (int k0 = 0; k0 < K; k0 += 16) {
        float4 av = aptr ? *(const float4*)(aptr + k0) : make_float4(0.f, 0.f, 0.f, 0.f);
        const int ak = (tid & 3) * 4, am = tid >> 2;
        As[(ak + 0) * 68 + am] = av.x; As[(ak + 1) * 68 + am] = av.y; As[(ak + 2) * 68 + am] = av.z; As[(ak + 3) * 68 + am] = av.w;
#pragma unroll
        for (int nb = 0; nb < NB; ++nb) {
            const float* bp = nb == 0 ? b0 : b1;
            float4 bv = bvalid ? *(const float4*)(bp + (size_t)k0 * ldb) : make_float4(0.f, 0.f, 0.f, 0.f);
            *(float4*)(Bs + nb * 1024 + (tid >> 4) * 64 + (tid & 15) * 4) = bv;
        }
        __syncthreads();
#pragma unroll
        for (int kk = 0; kk < 16; ++kk) {
            const float4 a = *(const float4*)(As + kk * 68 + ty * 4);
            const float aa[4] = {a.x, a.y, a.z, a.w};
#pragma unroll
            for (int nb = 0; nb < NB; ++nb) {
                const float4 b = *(const float4*)(Bs + nb * 1024 + kk * 64 + tx * 4);
                const float bb[4] = {b.x, b.y, b.z, b.w};
#pragma unroll
                for (int i = 0; i < 4; ++i)
#pragma unroll
                    for (int j = 0; j < 4; ++j) acc[nb][i][j] += aa[i] * bb[j];
            }
        }
        __syncthreads();
    }
}

template <int MODE>
__global__ void __launch_bounds__(256) gemm_dense_k(const float* A, int lda, const float* B, int N, int K, float* out, const float* aux, int goff) {
    __shared__ float As[16 * 68]; __shared__ float Bs[1024];
    const int tid = threadIdx.x, m0 = blockIdx.y * 64, n0 = blockIdx.x * 64;
    const float* aptr = A + (size_t)(m0 + (tid >> 2)) * lda + (tid & 3) * 4;
    const int bn = n0 + (tid & 15) * 4; const bool bvalid = bn < N;
    const float* b0 = B + (size_t)(tid >> 4) * N + bn;
    float acc[1][4][4];
    mm64<1>(aptr, b0, nullptr, bvalid, N, K, acc, As, Bs);
    const int ty = tid >> 4, tx = tid & 15;
#pragma unroll
    for (int i = 0; i < 4; ++i)
#pragma unroll
        for (int j = 0; j < 4; ++j) {
            const int m = m0 + ty * 4 + i, n = n0 + tx * 4 + j;
            if (n < N) {
                const float v = acc[0][i][j]; const size_t o = (size_t)m * N + n;
                if (MODE == 0) out[o] = v;
                else if (MODE == 1) out[o] = sigmoidf_(aux[(size_t)m * NIN + goff + n]) * v;
                else if (MODE == 2) out[o] += sigmoidf_(aux[(size_t)m * NIN + goff + n]) * v;
                else out[o] = aux[o] + v;
            }
        }
}

__global__ void __launch_bounds__(256) conv_k(const float* proj, const float* conv_w, float* qkvc) {
    const int item = blockIdx.x * 4 + (threadIdx.x >> 6), lane = threadIdx.x & 63;
    const int m = item >> 3, h = item & 7, t = m % SEQ;
#pragma unroll
    for (int which = 0; which < 3; ++which) {
        const int c = which * 1024 + h * 128 + lane * 2;
        float a0 = 0.f, a1 = 0.f;
#pragma unroll
        for (int j = 0; j < 5; ++j) {
            const int tt = t + j - 2;
            if (tt >= 0 && tt < SEQ) {
                const float2 xv = *(const float2*)(proj + (size_t)(m + j - 2) * NIN + C_QB + c);
                const float2 wv = *(const float2*)(conv_w + j * 3072 + c);
                a0 += xv.x * wv.x; a1 += xv.y * wv.y;
            }
        }
        a0 = siluf_(a0); a1 = siluf_(a1);
        if (which < 2) {
            const float ss = wave_sum(a0 * a0 + a1 * a1);
            float r = rsqrtf(ss + EPS); if (which == 0) r *= 0.08838834764831845f;
            a0 *= r; a1 *= r;
        }
        *(float2*)(qkvc + (size_t)m * 3072 + c) = make_float2(a0, a1);
    }
}

__global__ void __launch_bounds__(256) gdn_k(const float* proj, const float* qkvc, const float* a_log_f, const float* a_log_b, const float* dtb_f, const float* dtb_b, float* o) {
    __shared__ float kq[2][256]; __shared__ float red[16 * 16]; __shared__ float red2[16 * 16];
    const int tid = threadIdx.x, dvc = tid & 15, kg = tid >> 4;
    const int sl = blockIdx.x & 7, bh = blockIdx.x >> 3, b = bh >> 3, h = bh & 7;
    for (int dir = 0; dir < 2; ++dir) {
        const float A = __expf(dir == 0 ? a_log_f[h] : a_log_b[h]);
        const float dtb = dir == 0 ? dtb_f[h] : dtb_b[h];
        const int ca = dir == 0 ? C_AF : C_AB, cb = dir == 0 ? C_BF : C_BB;
        float S[8];
#pragma unroll
        for (int i = 0; i < 8; ++i) S[i] = 0.f;
        for (int step = 0; step < SEQ; ++step) {
            const int t = dir == 0 ? step : SEQ - 1 - step; const size_t m = (size_t)b * SEQ + t;
            const int buf = step & 1;
            kq[buf][tid] = qkvc[m * 3072 + (tid < 128 ? 1024 + h * 128 + tid : h * 128 + tid - 128)];
            const float av = proj[m * NIN + ca + h] + dtb;
            const float sp = av > 20.f ? av : log1pf(__expf(av));
            const float eg = __expf(-A * sp);
            const float beta = sigmoidf_(proj[m * NIN + cb + h]);
            const float v = qkvc[m * 3072 + 2048 + h * 128 + sl * 16 + dvc];
            __syncthreads();
            float p = 0.f;
#pragma unroll
            for (int i = 0; i < 8; ++i) { S[i] *= eg; p += S[i] * kq[buf][kg * 8 + i]; }
            red[kg * 16 + dvc] = p;
            __syncthreads();
            float pt = 0.f;
#pragma unroll
            for (int g = 0; g < 16; ++g) pt += red[g * 16 + dvc];
            const float d = beta * (v - pt);
            float oq = 0.f;
#pragma unroll
            for (int i = 0; i < 8; ++i) { S[i] += kq[buf][kg * 8 + i] * d; oq += S[i] * kq[buf][128 + kg * 8 + i]; }
            red2[kg * 16 + dvc] = oq;
            __syncthreads();
            if (kg == 0) {
                float ot = 0.f;
#pragma unroll
                for (int g = 0; g < 16; ++g) ot += red2[g * 16 + dvc];
                float* op = o + m * 1024 + h * 128 + sl * 16 + dvc;
                if (dir == 0) *op = ot; else *op += ot;
            }
        }
        __syncthreads();
    }
}

__global__ void __launch_bounds__(256) gdn_out_k(float* o, const float* proj, const float* nw) {
    const int item = blockIdx.x * 4 + (threadIdx.x >> 6), lane = threadIdx.x & 63;
    const int m = item >> 3, h = item & 7;
    float2 v = *(float2*)(o + (size_t)m * 1024 + h * 128 + lane * 2);
    const float r = rsqrtf(wave_sum(v.x * v.x + v.y * v.y) * (1.f / 128.f) + EPS);
    const float2 z = *(const float2*)(proj + (size_t)m * NIN + C_ZB + h * 128 + lane * 2);
    const float2 w = *(const float2*)(nw + lane * 2);
    *(float2*)(o + (size_t)m * 1024 + h * 128 + lane * 2) = make_float2(v.x * r * w.x * siluf_(z.x), v.y * r * w.y * siluf_(z.y));
}

__global__ void __launch_bounds__(256) attn_k(const float* proj, float* ya) {
    const int gid = blockIdx.x * 256 + threadIdx.x;
    const int h = gid / M, m = gid % M, b = m / SEQ, t = m % SEQ;
    float q[64], acc[64];
    const float* qp = proj + (size_t)m * NIN + C_QA + h * 64;
#pragma unroll
    for (int i = 0; i < 64; ++i) { q[i] = qp[i] * 0.125f; acc[i] = 0.f; }
    const float slope = exp2f(-(float)(h + 1));
    float mx = -1e30f, l = 0.f;
    for (int p = 0; p < 3; ++p) {
        const int dil = p == 0 ? 1 : (p == 1 ? 4 : 16);
        for (int j = -64; j <= 64; ++j) {
            const int s = t + dil * j;
            if (s < 0 || s >= SEQ) continue;
            const float* kp = proj + (size_t)(b * SEQ + s) * NIN + C_KA + h * 64;
            float sc = 0.f;
#pragma unroll
            for (int i = 0; i < 64; i += 4) { const float4 kv = *(const float4*)(kp + i); sc += q[i] * kv.x + q[i + 1] * kv.y + q[i + 2] * kv.z + q[i + 3] * kv.w; }
            sc -= slope * (float)(dil * (j < 0 ? -j : j));
            const float mn = fmaxf(mx, sc), f = __expf(mx - mn), pe = __expf(sc - mn);
            l = l * f + pe; mx = mn;
            const float* vp = kp + 512;
#pragma unroll
            for (int i = 0; i < 64; i += 4) { const float4 vv = *(const float4*)(vp + i); acc[i] = acc[i] * f + pe * vv.x; acc[i + 1] = acc[i + 1] * f + pe * vv.y; acc[i + 2] = acc[i + 2] * f + pe * vv.z; acc[i + 3] = acc[i + 3] * f + pe * vv.w; }
        }
    }
    const float il = 1.f / l;
    float* op = ya + (size_t)m * 512 + h * 64;
#pragma unroll
    for (int i = 0; i < 64; ++i) op[i] = acc[i] * il;
}

__global__ void __launch_bounds__(256) router_k(const float* h2, const float* rw, const float* rb, float* gate, int* cnt, int* list) {
    const int m = blockIdx.x * 4 + (threadIdx.x >> 6), lane = threadIdx.x & 63;
    const int e = lane & 31, half = lane >> 5;
    const float* hr = h2 + (size_t)m * DM + half * 512;
    float s = 0.f;
    for (int k = 0; k < 512; ++k) s += hr[k] * rw[(size_t)(half * 512 + k) * NE + e];
    s += __shfl_xor(s, 32);
    s += rb[e];
    float lv[4]; int li[4]; float cur = s;
#pragma unroll
    for (int r = 0; r < 4; ++r) {
        float bv = cur; int bi = e;
#pragma unroll
        for (int o = 1; o < 32; o <<= 1) { const float ov = __shfl_xor(bv, o); const int oi = __shfl_xor(bi, o); if (ov > bv || (ov == bv && oi < bi)) { bv = ov; bi = oi; } }
        lv[r] = bv; li[r] = bi; if (e == bi) cur = -3.0e38f;
    }
    const float e1 = __expf(lv[1] - lv[0]), e2 = __expf(lv[2] - lv[0]), e3 = __expf(lv[3] - lv[0]);
    const float inv = 1.f / (1.f + e1 + e2 + e3);
    if (lane < 4) {
        const float g = (lane == 0 ? 1.f : lane == 1 ? e1 : lane == 2 ? e2 : e3) * inv;
        const int ee = lane == 0 ? li[0] : lane == 1 ? li[1] : lane == 2 ? li[2] : li[3];
        gate[m * 4 + lane] = g;
        const int pos = atomicAdd(&cnt[ee], 1);
        list[(size_t)ee * M + pos] = m * 4 + lane;
    }
}

__global__ void __launch_bounds__(256) moe1_k(const float* h2, const float* wgu, const float* bgu, const int* cnt, const int* list, float* act) {
    __shared__ float As[16 * 68]; __shared__ float Bs[2048]; __shared__ int sl[64];
    const int e = blockIdx.z, c = cnt[e], m0 = blockIdx.y * 64, n0 = blockIdx.x * 64, tid = threadIdx.x;
    if (m0 >= c) return;
    if (tid < 64) sl[tid] = (m0 + tid < c) ? list[(size_t)e * M + m0 + tid] : -1;
    __syncthreads();
    const int a = sl[tid >> 2];
    const float* aptr = a >= 0 ? h2 + (size_t)(a >> 2) * DM + (tid & 3) * 4 : nullptr;
    const float* B = wgu + (size_t)e * DM * 2048;
    const float* b0 = B + (size_t)(tid >> 4) * 2048 + n0 + (tid & 15) * 4;
    float acc[2][4][4];
    mm64<2>(aptr, b0, b0 + 1024, true, 2048, DM, acc, As, Bs);
    const int ty = tid >> 4, tx = tid & 15;
#pragma unroll
    for (int i = 0; i < 4; ++i) {
        const int aa = sl[ty * 4 + i]; if (aa < 0) continue;
#pragma unroll
        for (int j = 0; j < 4; ++j) {
            const int n = n0 + tx * 4 + j;
            const float g = fminf(acc[0][i][j] + bgu[e * 2048 + n], 7.f);
            const float lin = fminf(fmaxf(acc[1][i][j] + bgu[e * 2048 + 1024 + n], -7.f), 7.f);
            act[(size_t)aa * DFF + n] = g * sigmoidf_(1.702f * g) * (lin + 1.f);
        }
    }
}
__global__ void __launch_bounds__(256) moe2_k(const float* act, const float* wd, const float* bd, const int* cnt, const int* list, const float* gate, float* yexp) {
    __shared__ float As[16 * 68]; __shared__ float Bs[1024]; __shared__ int sl[64];
    const int e = blockIdx.z, c = cnt[e], m0 = blockIdx.y * 64, n0 = blockIdx.x * 64, tid = threadIdx.x;
    if (m0 >= c) return;
    if (tid < 64) sl[tid] = (m0 + tid < c) ? list[(size_t)e * M + m0 + tid] : -1;
    __syncthreads();
    const int a = sl[tid >> 2];
    const float* aptr = a >= 0 ? act + (size_t)a * DFF + (tid & 3) * 4 : nullptr;
    const float* B = wd + (size_t)e * DFF * DM;
    const float* b0 = B + (size_t)(tid >> 4) * DM + n0 + (tid & 15) * 4;
    float acc[1][4][4];
    mm64<1>(aptr, b0, nullptr, true, DM, DFF, acc, As, Bs);
    const int ty = tid >> 4, tx = tid & 15;
#pragma unroll
    for (int i = 0; i < 4; ++i) {
        const int aa = sl[ty * 4 + i]; if (aa < 0) continue;
        const float g = gate[aa];
#pragma unroll
        for (int j = 0; j < 4; ++j) { const int n = n0 + tx * 4 + j; yexp[(size_t)aa * DM + n] = (acc[0][i][j] + bd[e * DM + n]) * g; }
    }
}

extern "C" void kernel_launch(void* const* d_in, const int* in_sizes, int n_in, void* d_out, int out_size, void* d_ws, size_t ws_size, hipStream_t stream) {
    const float* x = (const float*)d_in[0]; const float* norm1_w = (const float*)d_in[1]; const float* w_in = (const float*)d_in[2];
    const float* conv_w = (const float*)d_in[3]; const float* a_log_f = (const float*)d_in[4]; const float* a_log_b = (const float*)d_in[5];
    const float* dtb_f = (const float*)d_in[6]; const float* dtb_b = (const float*)d_in[7]; const float* gdn_nw = (const float*)d_in[8];
    const float* w_ba = (const float*)d_in[9]; const float* w_bb = (const float*)d_in[10]; const float* w_out = (const float*)d_in[11];
    const float* norm2_w = (const float*)d_in[12]; const float* router_w = (const float*)d_in[13]; const float* router_b = (const float*)d_in[14];
    const float* w_gu = (const float*)d_in[15]; const float* b_gu = (const float*)d_in[16]; const float* w_d = (const float*)d_in[17];
    const float* b_d = (const float*)d_in[18]; const float* normf_w = (const float*)d_in[19];
    float* out = (float*)d_out; char* ws = (char*)d_ws;
    constexpr size_t MiB = 1u << 20;
    if (ws_size < 1000 * MiB) { fprintf(stderr, "kernel_launch: ws too small: %zu\n", ws_size); return; }
    float* PROJ = (float*)(ws); float* ACT = (float*)(ws); float* YEXP = (float*)(ws + 256 * MiB);
    float* H = (float*)(ws + 512 * MiB); float* QKVC = (float*)(ws + 576 * MiB); float* YA = (float*)(ws + 768 * MiB);
    float* OB = (float*)(ws + 800 * MiB); float* MERGED = (float*)(ws + 864 * MiB);
    float* GATE = (float*)(ws + 928 * MiB); int* CNT = (int*)(ws + 929 * MiB); int* LIST = (int*)(ws + 930 * MiB);
    float* X1 = out;

    rmsnorm_k<0><<<M / 4, 256, 0, stream>>>(x, norm1_w, H, nullptr);
    gemm_dense_k<0><<<dim3((NIN + 63) / 64, M / 64), 256, 0, stream>>>(H, DM, w_in, NIN, DM, PROJ, nullptr, 0);
    conv_k<<<M * 8 / 4, 256, 0, stream>>>(PROJ, conv_w, QKVC);
    gdn_k<<<256, 256, 0, stream>>>(PROJ, QKVC, a_log_f, a_log_b, dtb_f, dtb_b, OB);
    gdn_out_k<<<M * 8 / 4, 256, 0, stream>>>(OB, PROJ, gdn_nw);
    attn_k<<<M * 8 / 256, 256, 0, stream>>>(PROJ, YA);
    gemm_dense_k<1><<<dim3(DM / 64, M / 64), 256, 0, stream>>>(YA, 512, w_ba, DM, 512, MERGED, PROJ, C_GA);
    gemm_dense_k<2><<<dim3(DM / 64, M / 64), 256, 0, stream>>>(OB, 1024, w_bb, DM, 1024, MERGED, PROJ, C_GB);
    gemm_dense_k<3><<<dim3(DM / 64, M / 64), 256, 0, stream>>>(MERGED, 1024, w_out, DM, 1024, X1, x, 0);
    rmsnorm_k<0><<<M / 4, 256, 0, stream>>>(X1, norm2_w, H, nullptr);
    hipMemsetAsync(CNT, 0, 256, stream);
    router_k<<<M / 4, 256, 0, stream>>>(H, router_w, router_b, GATE, CNT, LIST);
    moe1_k<<<dim3(DFF / 64, M / 64, NE), 256, 0, stream>>>(H, w_gu, b_gu, CNT, LIST, ACT);
    moe2_k<<<dim3(DM / 64, M / 64, NE), 256, 0, stream>>>(ACT, w_d, b_d, CNT, LIST, GATE, YEXP);
    rmsnorm_k<1><<<M / 4, 256, 0, stream>>>(X1, normf_w, out, YEXP);
}
```

```cpp
#include <hip/hip_runtime.h>
#include <cstdint>
#include <cstdio>

constexpr int BATCH = 4, SEQ = 4096, DM = 1024, M = BATCH * SEQ;
constexpr int NIN = 7712;
constexpr int NINP = 7936;
constexpr int P_QA = 0, P_KA = 512, P_VA = 1024, P_QB = 1536, P_ZB = 4608, P_GA = 5632, P_GB = 6656, P_AF = 7680, P_AB = 7688, P_BF = 7696, P_BB = 7704;
constexpr int NE = 32, DFF = 1024;
constexpr float EPS = 1e-6f;
constexpr int KAB = 1536;
constexpr int MAXBLK = 288;


#define PREP_PROBE 0
#define RIDE_OFF 0
#define PMODE 0
#define STAG_PRE 3
#define STORE_PROBE 0
namespace pg8 {
#define PG8_LAS __attribute__((address_space(3)))
typedef unsigned short bf16_t;
typedef short bf16x8 __attribute__((ext_vector_type(8)));
typedef float f32x4 __attribute__((ext_vector_type(4)));
typedef unsigned u32x4 __attribute__((ext_vector_type(4)));
constexpr int BM = 256, BK = 64, HALF = 128, HTB = HALF * BK * 2  , STAGE_BYTES = 8 * HTB, NXCD = 8, WGM = 8;

__host__ __device__ __forceinline__ int lds_byte(int r, int c) { const int st = (r >> 4) * 2 + (c >> 5), rr = r & 15, cc = c & 31, ob = rr * 64 + cc * 2; return st * 1024 + (ob ^ (((ob >> 9) & 1) << 5)); }
__host__ __device__ __forceinline__ void stage_rc(int b, int& R, int& C) { const int st = b / 1024, sb = b % 1024, swz = sb ^ (((sb >> 9) & 1) << 5); R = (st >> 1) * 16 + swz / 64; C = (st & 1) * 32 + (swz % 64) / 2; }
__host__ __device__ __forceinline__ int perm32(int rho) { const int n = rho >> 4, i = rho & 15; return 8 * (i >> 2) + 4 * n + (i & 3); }

struct Unit { int pm, pn; };
struct Gemm { const bf16_t* A; const bf16_t* Bt; int M, N, K; };

struct StaticOrder {
    int nM, nN, nwg, G, c;
    __host__ __device__ void init(int M, int N, int G_, int c_) { nM = M / BM; nN = N / BM; nwg = nM * nN; G = G_; c = c_; }
    __host__ __device__ bool next(int i, Unit& u) const {
        const long L = (long)i * G + c; if (L >= nwg) return false;
        int wgid = (int)L; { const int q = nwg / NXCD, r = nwg % NXCD, xcd = wgid % NXCD, off = wgid / NXCD; wgid = (xcd < r ? xcd * (q + 1) : r * (q + 1) + (xcd - r) * q) + off; }
        const int nig = WGM * nN, gid = wgid / nig, fm = gid * WGM, gsz = (nM - fm) < WGM ? (nM - fm) : WGM;
        u.pm = fm + ((wgid % nig) % gsz); u.pn = (wgid % nig) / gsz; return true;
    }
    __device__ __forceinline__ void a_ready(const Unit&) const {}
    __device__ __forceinline__ void done(const Unit&) const {}
};

__device__ __forceinline__ unsigned cvt_pk_bf16(float lo, float hi) { unsigned r; asm volatile("v_cvt_pk_bf16_f32 %0, %1, %2" : "=v"(r) : "v"(lo), "v"(hi)); return r; }
typedef float f32x2 __attribute__((ext_vector_type(2)));
__device__ __forceinline__ f32x2 gelu_pk(f32x2 v) {
    const f32x2 av = __builtin_elementwise_abs(v), d = av * 0.2316418882f + 1.0f;
    f32x2 t; t.x = __builtin_amdgcn_rcpf(d.x); t.y = __builtin_amdgcn_rcpf(d.y);
    f32x2 q = t * 0.5307027145f + (-0.7265760135f); q = q * t + 0.7107068705f; q = q * t + (-0.142248368f); q = q * t + 0.127414796f; q = q * t;
    const f32x2 s = (v * v) * (-0.72134752044f);
    f32x2 e; e.x = __builtin_amdgcn_exp2f(s.x); e.y = __builtin_amdgcn_exp2f(s.y);
    const f32x2 m = v * (q * e), r = v - m;
    f32x2 o; o.x = v.x < 0.f ? m.x : r.x; o.y = v.y < 0.f ? m.y : r.y; return o;
}

template <int ACT  > struct EpiBf16 {
    static constexpr bool PERM = true, AFTER_DRAIN = false, HAS_MID = false; static_assert(ACT == 0 || ACT == 1, "EpiBf16: ACT is 0 (none) or 1 (gelu_pk)");
    bf16_t* O; int ldc; const float* bias; int split_cols; size_t split_stride; float scale0;
    __device__ __forceinline__ void operator()(const f32x4 (&acc)[2][2][4][2], const Unit& u, int wr, int wc, int fr, int fq) const {
        const int row0 = u.pm * BM + wr * 64 + fr; int colt = u.pn * BM; bf16_t* base = O;
        float sc = 1.f; if (split_cols) { const int t = colt / split_cols; base += (size_t)t * split_stride; colt -= t * split_cols; if (t == 0) sc = scale0; }
        const int col0 = colt + wc * 32 + 8 * fq, bcol0 = u.pn * BM + wc * 32 + 8 * fq;
        f32x4 bv[2][2];
#pragma unroll
        for (int bj = 0; bj < 2; ++bj)
#pragma unroll
            for (int n = 0; n < 2; ++n) bv[bj][n] = bias ? *(const f32x4*)(bias + bcol0 + bj * HALF + 4 * n) : (f32x4){0.f, 0.f, 0.f, 0.f};
#pragma unroll
        for (int ai = 0; ai < 2; ++ai)
#pragma unroll
            for (int m = 0; m < 4; ++m) { bf16_t* rowp = base + (size_t)(row0 + ai * HALF + m * 16) * ldc + col0;
#pragma unroll
                for (int bj = 0; bj < 2; ++bj) { f32x4 v0 = acc[ai][bj][m][0] + bv[bj][0], v1 = acc[ai][bj][m][1] + bv[bj][1];
                    if (ACT == 1) { f32x2 a = gelu_pk((f32x2){v0[0], v0[1]}), b = gelu_pk((f32x2){v0[2], v0[3]}), c = gelu_pk((f32x2){v1[0], v1[1]}), d = gelu_pk((f32x2){v1[2], v1[3]});
                        v0 = (f32x4){a.x, a.y, b.x, b.y}; v1 = (f32x4){c.x, c.y, d.x, d.y}; }
                    v0 = v0 * sc; v1 = v1 * sc; u32x4 w; w.x = cvt_pk_bf16(v0[0], v0[1]); w.y = cvt_pk_bf16(v0[2], v0[3]); w.z = cvt_pk_bf16(v1[0], v1[1]); w.w = cvt_pk_bf16(v1[2], v1[3]);
                    *(u32x4*)(rowp + bj * HALF) = w; } }
    }
};
__device__ __forceinline__ float bflo(unsigned w) { return __uint_as_float(w << 16); }
__device__ __forceinline__ float bfhi(unsigned w) { return __uint_as_float(w & 0xffff0000u); }
__device__ __forceinline__ float sigm(float x) { return __builtin_amdgcn_rcpf(1.0f + __expf(-fmaxf(x, -30.0f))); }

struct DenseOrder {
    typedef Unit UnitT; static constexpr bool GATHER = false;
    StaticOrder so; const char* A; const char* Bt; size_t tstep;
    __device__ __forceinline__ bool next(int i, Unit& u) const { return so.next(i, u); }
    __device__ __forceinline__ const char* ptrA(const Unit& u) const { return A + (size_t)u.pm * tstep; }
    __device__ __forceinline__ const char* ptrB(const Unit& u) const { return Bt + (size_t)u.pn * tstep; }
    __device__ __forceinline__ unsigned rowoff(const Unit&, int) const { return 0u; }
    __device__ __forceinline__ void a_ready(const Unit&) const {}
    __device__ __forceinline__ void done(const Unit&) const {}
};
struct MUnit { int pm, pn, e, j, rows, slot0; };
template <int NT, bool GATHER_> struct MoeOrder {
    typedef MUnit UnitT; static constexpr bool GATHER = GATHER_;
    const PG8_LAS int* etab; int G, c, K; const char* A; const char* W; size_t wstride; const int* list;
    __device__ __forceinline__ bool next(int i, MUnit& u) const {
        const int L = i * G + c; if (L >= etab[32] * NT) return false;
        const int blk = L / NT; int e = 0;
#pragma unroll
        for (int q = 1; q < 32; ++q) e += (etab[q] <= blk) ? 1 : 0;
        u.e = e; u.j = blk - etab[e]; u.pm = blk; u.pn = L % NT; const int left = etab[40 + e] - 256 * u.j; u.rows = left < 256 ? left : 256; u.slot0 = blk * 256; return true;
    }
    __device__ __forceinline__ const char* ptrA(const MUnit& u) const { return GATHER_ ? A : A + (size_t)u.slot0 * K * 2; }
    __device__ __forceinline__ const char* ptrB(const MUnit& u) const { return W + (size_t)u.e * wstride + (size_t)u.pn * 256 * K * 2; }
    __device__ __forceinline__ unsigned rowoff(const MUnit& u, int r) const { const int pos = u.j * 256 + r; const int tok = list[(size_t)u.e * 16384 + (pos < etab[40 + u.e] ? pos : 0)]; return (unsigned)tok * (unsigned)K * 2u; }
    __device__ __forceinline__ void a_ready(const MUnit&) const {}
    __device__ __forceinline__ void done(const MUnit&) const {}
};

struct EpiMerged {
    static constexpr bool PERM = true, AFTER_DRAIN = false, HAS_MID = true; static constexpr int TMID = 8;
    const bf16_t* proj; bf16_t* out; int ld, ga_off, gb_off;
    __device__ __forceinline__ void mid(f32x4 (&acc)[2][2][4][2], const Unit& u, int wr, int wc, int fr, int fq) const {
        int row0 = u.pm * BM + wr * 64 + fr, c0 = u.pn * BM + wc * 32 + 8 * fq;
        asm volatile("" : "+v"(row0), "+v"(c0));
#pragma unroll
        for (int ai = 0; ai < 2; ++ai)
#pragma unroll
            for (int m = 0; m < 4; ++m) { const bf16_t* rp = proj + (size_t)(row0 + ai * HALF + m * 16) * ld + c0;
#pragma unroll
                for (int bj = 0; bj < 2; ++bj) { const u32x4 ga = *(const u32x4*)(rp + ga_off + bj * HALF), gb = *(const u32x4*)(rp + gb_off + bj * HALF);
#define EM_R(a, b) ((1.0f + __expf(-fmaxf((b), -30.0f))) * __builtin_amdgcn_rcpf(1.0f + __expf(-fmaxf((a), -30.0f))))
                    acc[ai][bj][m][0][0] *= EM_R(bflo(ga.x), bflo(gb.x)); acc[ai][bj][m][0][1] *= EM_R(bfhi(ga.x), bfhi(gb.x));
                    acc[ai][bj][m][0][2] *= EM_R(bflo(ga.y), bflo(gb.y)); acc[ai][bj][m][0][3] *= EM_R(bfhi(ga.y), bfhi(gb.y));
                    acc[ai][bj][m][1][0] *= EM_R(bflo(ga.z), bflo(gb.z)); acc[ai][bj][m][1][1] *= EM_R(bfhi(ga.z), bfhi(gb.z));
                    acc[ai][bj][m][1][2] *= EM_R(bflo(ga.w), bflo(gb.w)); acc[ai][bj][m][1][3] *= EM_R(bfhi(ga.w), bfhi(gb.w));
#undef EM_R
                }
                asm volatile("" : "+v"(acc[ai][0][m][0]), "+v"(acc[ai][0][m][1]), "+v"(acc[ai][1][m][0]), "+v"(acc[ai][1][m][1])); asm volatile("" ::: "memory"); }
    }
    __device__ __forceinline__ void operator()(const f32x4 (&acc)[2][2][4][2], const Unit& u, int wr, int wc, int fr, int fq) const {
        const int row0 = u.pm * BM + wr * 64 + fr, c0 = u.pn * BM + wc * 32 + 8 * fq;
#pragma unroll
        for (int ai = 0; ai < 2; ++ai)
#pragma unroll
            for (int m = 0; m < 4; ++m) { const size_t row = (size_t)(row0 + ai * HALF + m * 16);
#pragma unroll
                for (int bj = 0; bj < 2; ++bj) { const u32x4 gb = *(const u32x4*)(proj + row * ld + gb_off + c0 + bj * HALF);
                    const f32x4 v0 = acc[ai][bj][m][0], v1 = acc[ai][bj][m][1]; u32x4 w;
                    w.x = cvt_pk_bf16(v0[0] * sigm(bflo(gb.x)), v0[1] * sigm(bfhi(gb.x))); w.y = cvt_pk_bf16(v0[2] * sigm(bflo(gb.y)), v0[3] * sigm(bfhi(gb.y)));
                    w.z = cvt_pk_bf16(v1[0] * sigm(bflo(gb.z)), v1[1] * sigm(bfhi(gb.z))); w.w = cvt_pk_bf16(v1[2] * sigm(bflo(gb.w)), v1[3] * sigm(bfhi(gb.w)));
                    *(u32x4*)(out + row * 1024 + c0 + bj * HALF) = w; }
                asm volatile("" ::: "memory"); }
    }
};
struct EpiResid {
    static constexpr bool PERM = false, AFTER_DRAIN = false, HAS_MID = false;
    const float* base; float* out;
    __device__ __forceinline__ void operator()(const f32x4 (&acc)[2][2][4][2], const Unit& u, int wr, int wc, int fr, int fq) const {
        const int row0 = u.pm * BM + wr * 64 + fr, col0 = u.pn * BM + wc * 32 + 4 * fq;
#pragma unroll
        for (int ai = 0; ai < 2; ++ai)
#pragma unroll
            for (int m = 0; m < 4; ++m) { const size_t off = (size_t)(row0 + ai * HALF + m * 16) * 1024 + col0;
#pragma unroll
                for (int bj = 0; bj < 2; ++bj)
#pragma unroll
                    for (int n = 0; n < 2; ++n) { const size_t o = off + bj * HALF + n * 16; *(f32x4*)(out + o) = *(const f32x4*)(base + o) + acc[ai][bj][m][n]; } }
    }
};
struct EpiSwiglu {
    static constexpr bool PERM = true, AFTER_DRAIN = false, HAS_MID = false;
    bf16_t* act; const float* bgu;
    __device__ __forceinline__ void operator()(const f32x4 (&acc)[2][2][4][2], const MUnit& u, int wr, int wc, int fr, int fq) const {
        const int r0 = wr * 64 + fr, j0 = u.pn * HALF + wc * 32 + 8 * fq;
        const float* bp = bgu + (size_t)u.e * 2048 + j0;
        const f32x4 bg0 = *(const f32x4*)(bp), bg1 = *(const f32x4*)(bp + 4), bl0 = *(const f32x4*)(bp + 1024), bl1 = *(const f32x4*)(bp + 1028);
#pragma unroll
        for (int ai = 0; ai < 2; ++ai)
#pragma unroll
            for (int m = 0; m < 4; ++m) { const int r = r0 + ai * HALF + m * 16;
                if (r < u.rows) {
                    const f32x4 g0 = acc[ai][0][m][0] + bg0, g1 = acc[ai][0][m][1] + bg1, l0 = acc[ai][1][m][0] + bl0, l1 = acc[ai][1][m][1] + bl1;
                    float o[8];
#pragma unroll
                    for (int i = 0; i < 4; ++i) { const float g = fminf(g0[i], 7.0f), l = fminf(fmaxf(l0[i], -7.0f), 7.0f); o[i] = g * sigm(1.702f * g) * (l + 1.0f); }
#pragma unroll
                    for (int i = 0; i < 4; ++i) { const float g = fminf(g1[i], 7.0f), l = fminf(fmaxf(l1[i], -7.0f), 7.0f); o[4 + i] = g * sigm(1.702f * g) * (l + 1.0f); }
                    u32x4 w; w.x = cvt_pk_bf16(o[0], o[1]); w.y = cvt_pk_bf16(o[2], o[3]); w.z = cvt_pk_bf16(o[4], o[5]); w.w = cvt_pk_bf16(o[6], o[7]);
                    *(u32x4*)(act + (size_t)(u.slot0 + r) * 1024 + j0) = w; } }
    }
};
struct EpiDown {
    static constexpr bool PERM = true, AFTER_DRAIN = false, HAS_MID = false;
    bf16_t* yexp; const float* bd; const float* gatel;
    __device__ __forceinline__ void operator()(const f32x4 (&acc)[2][2][4][2], const MUnit& u, int wr, int wc, int fr, int fq) const {
        const int r0 = wr * 64 + fr, c0 = u.pn * BM + wc * 32 + 8 * fq;
        f32x4 bv[2][2];
#pragma unroll
        for (int bj = 0; bj < 2; ++bj)
#pragma unroll
            for (int n = 0; n < 2; ++n) bv[bj][n] = *(const f32x4*)(bd + (size_t)u.e * 1024 + c0 + bj * HALF + 4 * n);
#pragma unroll
        for (int ai = 0; ai < 2; ++ai)
#pragma unroll
            for (int m = 0; m < 4; ++m) { const int r = r0 + ai * HALF + m * 16;
                if (r < u.rows) { const float g = gatel[(size_t)u.e * 16384 + u.j * 256 + r];
#pragma unroll
                    for (int bj = 0; bj < 2; ++bj) { const f32x4 v0 = (acc[ai][bj][m][0] + bv[bj][0]) * g, v1 = (acc[ai][bj][m][1] + bv[bj][1]) * g;
                        u32x4 w; w.x = cvt_pk_bf16(v0[0], v0[1]); w.y = cvt_pk_bf16(v0[2], v0[3]); w.z = cvt_pk_bf16(v1[0], v1[1]); w.w = cvt_pk_bf16(v1[2], v1[3]);
                        *(u32x4*)(yexp + (size_t)(u.slot0 + r) * 1024 + c0 + bj * HALF) = w; } } }
    }
};

template <class Epi, class Sched, bool ALIGN_EPI = false, bool SP2 = false>
__device__ __forceinline__ void gemm_phase(PG8_LAS unsigned char* lds, const int K, const Sched& S, const Epi& E, PG8_LAS unsigned* gtab) {
    const int tid = threadIdx.x, wid = __builtin_amdgcn_readfirstlane(tid >> 6), lane = tid & 63, wr = wid >> 2, wc = wid & 3, fr = lane & 15, fq = lane >> 4;
    const int nt = K / BK;
    unsigned voffA[2], voffB[2]; unsigned voffG[2][2] = {{0u, 0u}, {0u, 0u}}; int gR[2]; unsigned gC2[2];
#pragma unroll
    for (int i = 0; i < 2; ++i) { int R, C; stage_rc(tid * 16 + i * 8192, R, C); const int Rb = Epi::PERM ? ((R & ~31) + perm32(R & 31)) : R;
        gR[i] = R; gC2[i] = (unsigned)C * 2u; voffA[i] = (unsigned)(R * K + C) * 2u; voffB[i] = (unsigned)(Rb * K + C) * 2u; }
    const size_t kstep = (size_t)(BK * 2);
    const size_t hstep = (size_t)HALF * K * 2;
    const size_t tstep = 2 * hstep;
    const unsigned ldsw = (unsigned)wid * 1024u;
    const int aoff = lds_byte(wr * 64 + fr, fq * 8), boff = lds_byte(wc * 32 + fr, fq * 8);
#define PG8_SA(b, h) (((b) * 2 + (h)) * HTB)
#define PG8_SB(b, h) ((4 + (b) * 2 + (h)) * HTB)
#define PG8_STAGE(bufoff, gbase, voff) do { _Pragma("unroll") for (int _i = 0; _i < 2; ++_i) \
        __builtin_amdgcn_global_load_lds((const unsigned*)((const char*)(gbase) + (voff)[_i]), (PG8_LAS unsigned*)(lds + (bufoff) + ldsw + _i * 8192), 16, 0, 0); } while (0)
#define PG8_STAGE_A(bufoff, gbase, h) do { _Pragma("unroll") for (int _i = 0; _i < 2; ++_i) { const char* _src; \
        if constexpr (Sched::GATHER) _src = (const char*)(gbase) + voffG[h][_i]; else _src = (const char*)(gbase) + (size_t)(h) * hstep + voffA[_i]; \
        __builtin_amdgcn_global_load_lds((const unsigned*)_src, (PG8_LAS unsigned*)(lds + (bufoff) + ldsw + _i * 8192), 16, 0, 0); } } while (0)
#define PG8_LOADG(uidx) do { _Pragma("unroll") for (int _h = 0; _h < 2; ++_h) _Pragma("unroll") for (int _i = 0; _i < 2; ++_i) voffG[_h][_i] = gtab[(uidx) * 256 + _h * 128 + gR[_i]] + gC2[_i]; } while (0)
#define PG8_GSWITCH do { if constexpr (Sched::GATHER) { if (last && has_next) PG8_LOADG(ui + 1); } } while (0)
#define PG8_LDA(dst, b, h) do { _Pragma("unroll") for (int m = 0; m < 4; ++m) _Pragma("unroll") for (int k = 0; k < 2; ++k) dst[m][k] = *(const PG8_LAS bf16x8*)(lds + PG8_SA(b, h) + aoff + m * 2048 + k * 1024); } while (0)
#define PG8_LDB(dst, b, h) do { _Pragma("unroll") for (int n = 0; n < 2; ++n) _Pragma("unroll") for (int k = 0; k < 2; ++k) dst[n][k] = *(const PG8_LAS bf16x8*)(lds + PG8_SB(b, h) + boff + n * 2048 + k * 1024); } while (0)
#define PG8_MMA(ai, bj, At, Bt) do { __builtin_amdgcn_s_setprio(1); _Pragma("unroll") for (int m = 0; m < 4; ++m) _Pragma("unroll") for (int n = 0; n < 2; ++n) _Pragma("unroll") for (int k = 0; k < 2; ++k) \
        acc[ai][bj][m][n] = __builtin_amdgcn_mfma_f32_16x16x32_bf16(Bt[n][k], At[m][k], acc[ai][bj][m][n], 0, 0, 0); __builtin_amdgcn_s_setprio(0); } while (0)
#define PG8_WAIT_V(n) asm volatile("s_waitcnt vmcnt(" #n ")" ::: "memory")
#define PG8_WAIT_L(n) asm volatile("s_waitcnt lgkmcnt(" #n ")" ::: "memory")
#define PG8_BAR __builtin_amdgcn_s_barrier()
#define PG8_SCHED __builtin_amdgcn_sched_barrier(0)
    typename Sched::UnitT cur, nxt; int ui = 0;
    if (!S.next(0, cur)) return;
    f32x4 acc[2][2][4][2];
#pragma unroll
    for (int a = 0; a < 2; ++a)
#pragma unroll
        for (int b = 0; b < 2; ++b)
#pragma unroll
            for (int m = 0; m < 4; ++m)
#pragma unroll
                for (int n = 0; n < 2; ++n) acc[a][b][m][n] = (f32x4){0.f, 0.f, 0.f, 0.f};
    bf16x8 At[4][2], B0[2][2], B1[2][2];
    const char* cA = S.ptrA(cur); const char* cB = S.ptrB(cur);
    if constexpr (Sched::GATHER) {
        typename Sched::UnitT gu; for (int i = 0; S.next(i, gu); ++i) { if (tid < 256) gtab[i * 256 + tid] = S.rowoff(gu, tid); }
        asm volatile("s_waitcnt vmcnt(0) lgkmcnt(0)" ::: "memory"); __builtin_amdgcn_s_barrier(); asm volatile("" ::: "memory");
        PG8_LOADG(0);
    }
    S.a_ready(cur);
    if constexpr (SP2) {
        PG8_STAGE(PG8_SB(0, 0), cB, voffB); PG8_STAGE(PG8_SB(0, 1), cB + hstep, voffB); PG8_STAGE_A(PG8_SA(0, 0), cA, 0); PG8_STAGE_A(PG8_SA(0, 1), cA, 1);
        if (wr == 1) PG8_BAR;
        PG8_WAIT_V(2); PG8_BAR;
        PG8_STAGE(PG8_SB(1, 0), cB + kstep, voffB); PG8_STAGE_A(PG8_SA(1, 0), cA + kstep, 0); PG8_STAGE(PG8_SB(1, 1), cB + hstep + kstep, voffB);
        PG8_WAIT_V(6); PG8_BAR;
    } else {
        PG8_STAGE(PG8_SB(0, 0), cB, voffB); PG8_STAGE_A(PG8_SA(0, 0), cA, 0); PG8_STAGE(PG8_SB(0, 1), cB + hstep, voffB); PG8_STAGE_A(PG8_SA(0, 1), cA, 1);
        if (wr == 1) PG8_BAR;
        PG8_WAIT_V(4); PG8_BAR;
        PG8_STAGE(PG8_SB(1, 0), cB + kstep, voffB); PG8_STAGE_A(PG8_SA(1, 0), cA + kstep, 0); PG8_STAGE(PG8_SB(1, 1), cB + hstep + kstep, voffB);
        PG8_WAIT_V(6); PG8_BAR;
    }
    for (;;) {
        const bool has_next = S.next(ui + 1, nxt);
        const char* nA = has_next ? S.ptrA(nxt) : cA; const char* nB = has_next ? S.ptrB(nxt) : cB;
        for (int t = 0; t < nt; t += 2) {
            if constexpr (Epi::HAS_MID) { if (t == Epi::TMID) E.mid(acc, cur, wr, wc, fr, fq); }
            const bool last = (t == nt - 2);
            const char* a1 = cA + (size_t)(t + 1) * kstep;
            const char* a2 = last ? nA : cA + (size_t)(t + 2) * kstep; const char* b2 = last ? nB : cB + (size_t)(t + 2) * kstep;
            const char* a3 = a2 + kstep; const char* b3 = b2 + kstep;
            if (last && has_next) S.a_ready(nxt);
            if constexpr (SP2) {
            PG8_LDB(B0, 0, 0); PG8_LDB(B1, 0, 1); PG8_SCHED; PG8_LDA(At, 0, 0); PG8_STAGE_A(PG8_SA(1, 1), a1, 1); PG8_GSWITCH;
            PG8_WAIT_V(8); PG8_WAIT_L(0); PG8_BAR; PG8_MMA(0, 0, At, B0); PG8_MMA(0, 1, At, B1); PG8_BAR; PG8_SCHED;
            PG8_LDA(At, 0, 1); PG8_STAGE(PG8_SB(0, 0), b2, voffB); PG8_STAGE(PG8_SB(0, 1), b2 + hstep, voffB); PG8_STAGE_A(PG8_SA(0, 0), a2, 0);
            PG8_WAIT_V(8); PG8_WAIT_L(0); PG8_BAR; PG8_MMA(1, 0, At, B0); PG8_MMA(1, 1, At, B1); PG8_BAR; PG8_SCHED;
            PG8_LDB(B0, 1, 0); PG8_LDB(B1, 1, 1); PG8_SCHED; PG8_LDA(At, 1, 0); PG8_STAGE_A(PG8_SA(0, 1), a2, 1);
            PG8_WAIT_V(8); PG8_WAIT_L(0); PG8_BAR; PG8_MMA(0, 0, At, B0); PG8_MMA(0, 1, At, B1); PG8_BAR; PG8_SCHED;
            PG8_LDA(At, 1, 1); PG8_STAGE(PG8_SB(1, 0), b3, voffB); PG8_STAGE(PG8_SB(1, 1), b3 + hstep, voffB); PG8_STAGE_A(PG8_SA(1, 0), a3, 0);
            PG8_WAIT_V(8); PG8_WAIT_L(0); PG8_BAR; PG8_MMA(1, 0, At, B0); PG8_MMA(1, 1, At, B1); PG8_BAR; PG8_SCHED;
            } else {
            PG8_LDB(B0, 0, 0); PG8_SCHED; PG8_LDA(At, 0, 0); PG8_STAGE_A(PG8_SA(1, 1), a1, 1); PG8_GSWITCH;
            PG8_WAIT_L(8); PG8_BAR; PG8_WAIT_L(0); PG8_MMA(0, 0, At, B0); PG8_BAR; PG8_SCHED;
            PG8_LDB(B1, 0, 1); PG8_STAGE(PG8_SB(0, 0), b2, voffB);
            PG8_BAR; PG8_WAIT_L(0); PG8_MMA(0, 1, At, B1); PG8_BAR;
            PG8_LDA(At, 0, 1); PG8_STAGE_A(PG8_SA(0, 0), a2, 0);
            PG8_BAR; PG8_WAIT_L(0); PG8_MMA(1, 0, At, B0); PG8_BAR; PG8_SCHED;
            PG8_STAGE(PG8_SB(0, 1), b2 + hstep, voffB);
            PG8_WAIT_V(6); PG8_BAR; PG8_MMA(1, 1, At, B1); PG8_BAR;
            PG8_LDB(B0, 1, 0); PG8_SCHED; PG8_LDA(At, 1, 0); PG8_STAGE_A(PG8_SA(0, 1), a2, 1);
            PG8_WAIT_L(8); PG8_BAR; PG8_WAIT_L(0); PG8_MMA(0, 0, At, B0); PG8_BAR; PG8_SCHED;
            PG8_LDB(B1, 1, 1); PG8_STAGE(PG8_SB(1, 0), b3, voffB);
            PG8_BAR; PG8_WAIT_L(0); PG8_MMA(0, 1, At, B1); PG8_BAR;
            PG8_LDA(At, 1, 1); PG8_STAGE_A(PG8_SA(1, 0), a3, 0);
            PG8_BAR; PG8_WAIT_L(0); PG8_MMA(1, 0, At, B0); PG8_BAR; PG8_SCHED;
            PG8_STAGE(PG8_SB(1, 1), b3 + hstep, voffB);
            PG8_WAIT_V(6); PG8_BAR; PG8_MMA(1, 1, At, B1); PG8_BAR;
            }
        }
        if constexpr (ALIGN_EPI) { if (wr == 0) PG8_BAR; }
        if constexpr (!Epi::AFTER_DRAIN) { E(acc, cur, wr, wc, fr, fq); S.done(cur); }
        if (!has_next) break;
#pragma unroll
        for (int a = 0; a < 2; ++a)
#pragma unroll
            for (int b = 0; b < 2; ++b)
#pragma unroll
                for (int m = 0; m < 4; ++m)
#pragma unroll
                    for (int n = 0; n < 2; ++n) acc[a][b][m][n] = (f32x4){0.f, 0.f, 0.f, 0.f};
        cur = nxt; cA = nA; cB = nB; ++ui;
        if constexpr (ALIGN_EPI) { if (wr == 1) PG8_BAR; }
    }
    PG8_WAIT_V(0);
    if constexpr (!ALIGN_EPI) { if (wr == 0) PG8_BAR; }
    PG8_BAR;
    if constexpr (Epi::AFTER_DRAIN) { E.fused(acc, cur, wr, wc, fr, fq, lds, wid, lane); S.done(cur); }
#undef PG8_SA
#undef PG8_SB
#undef PG8_STAGE
#undef PG8_STAGE_A
#undef PG8_LOADG
#undef PG8_GSWITCH
#undef PG8_LDA
#undef PG8_LDB
#undef PG8_MMA
#undef PG8_WAIT_V
#undef PG8_WAIT_L
#undef PG8_BAR
#undef PG8_SCHED
}
}
constexpr size_t MiB = 1u << 20;
constexpr size_t WS_CTL = 0, CTL_ZERO_BYTES = 128 * 1024;
constexpr size_t WS_WIN = 2 * MiB;
constexpr size_t WS_WAB = 18 * MiB;
constexpr size_t WS_WOUT = 21 * MiB;
constexpr size_t WS_GATEL = 23 * MiB;
constexpr size_t WS_LIST = 25 * MiB;
constexpr size_t WS_ASG = 27 * MiB;
constexpr size_t WS_WGU = 32 * MiB;
constexpr size_t WS_WD = 160 * MiB;
constexpr size_t WS_XN = 224 * MiB;
constexpr size_t WS_PROJ = 256 * MiB;
constexpr size_t WS_YAB = 504 * MiB;
constexpr size_t WS_MERGED = 552 * MiB;
constexpr size_t WS_ACT = 256 * MiB;
constexpr size_t WS_GQ = 584 * MiB;
constexpr size_t WS_GKT = 616 * MiB;
constexpr size_t WS_GUT = 648 * MiB;
constexpr size_t WS_GW = 712 * MiB;
constexpr size_t WS_GQK = 776 * MiB;
constexpr size_t WS_GEG = 808 * MiB;
constexpr size_t WS_OF = 890 * MiB;
constexpr size_t WS_OB = 922 * MiB;
constexpr size_t WS_YEXP = 840 * MiB;
constexpr size_t WS_OP = 840 * MiB;
constexpr size_t WS_LSE = 888 * MiB;
constexpr size_t WS_END = 984 * MiB;
constexpr int CW_TMO = 0, CW_CODE = 1, CW_BAR = 4096, CW_CNT = 16384;
constexpr int N_BAR_REGIONS = 3;
static_assert((CW_CNT + 64) * 4 <= (int)CTL_ZERO_BYTES && (CW_BAR + 3 * 3456) * 4 <= CW_CNT * 4, "control words inside the per-call memset");

constexpr int RING_OFF = 0, RING_BYTES = 131072;
constexpr int LDSCTL_OFF = RING_BYTES, MISC_OFF = LDSCTL_OFF + 320;
constexpr int ETAB_OFF = LDSCTL_OFF + 1024;
constexpr int GTAB_OFF = LDSCTL_OFF + 2048;
constexpr int LDS_BYTES = 163840;
static_assert(GTAB_OFF + 16 * 1024 <= LDS_BYTES, "LDS map");
constexpr int NWAVES = 8;

#define GAS __attribute__((address_space(1)))
#define LAS __attribute__((address_space(3)))
typedef unsigned short bf16;
typedef unsigned v4u __attribute__((ext_vector_type(4)));
typedef float f32x4 __attribute__((ext_vector_type(4)));
typedef short bf16x8 __attribute__((ext_vector_type(8)));
typedef GAS unsigned gu32;
typedef GAS unsigned long long gu64;
#define RLX_AGENT __ATOMIC_RELAXED, __HIP_MEMORY_SCOPE_AGENT
#define LDS_WAIT() asm volatile("s_waitcnt lgkmcnt(0)" ::: "memory")
#define VM_WAIT() asm volatile("s_waitcnt vmcnt(0)" ::: "memory")
__device__ __forceinline__ unsigned long long rt() { return __builtin_amdgcn_s_memrealtime(); }
typedef float pk_f32x2_t __attribute__((ext_vector_type(2))); typedef __bf16 pk_bf16x2_t __attribute__((ext_vector_type(2)));
__device__ __forceinline__ unsigned pk2(float lo, float hi) { pk_f32x2_t v = {lo, hi}; pk_bf16x2_t b = __builtin_convertvector(v, pk_bf16x2_t); return __builtin_bit_cast(unsigned, b); }
__device__ __forceinline__ unsigned f2bf(float f) { return pk2(f, 0.f) & 0xffffu; }

#define XB_TMO      128
#define XB_XCNT(j)  (256  + 64 * (j))
#define XB_XSUB(j)  (1280 + 64 * (j))
#define XB_XGEN(j)  (2304 + 64 * (j))
#define XB_TOP      3328
#define XB_TOPGEN   3392
#define XCD_BAR_WORDS 3456
#define XB_SPIN_CAP (1u << 18)

__device__ __forceinline__ unsigned xb_ld(unsigned* p)              { return __hip_atomic_load(p, __ATOMIC_RELAXED, __HIP_MEMORY_SCOPE_AGENT); }
__device__ __forceinline__ unsigned xb_add(unsigned* p, unsigned v) { return __hip_atomic_fetch_add(p, v, __ATOMIC_RELAXED, __HIP_MEMORY_SCOPE_AGENT); }
__device__ __forceinline__ unsigned xb_xcc_id() { return (unsigned)__builtin_amdgcn_s_getreg((3 << 11) | 20) & 0xFu; }
#define XB_SPIN(cond, bar) do { unsigned _sp = 0; while (cond) { __builtin_amdgcn_s_sleep(1); \
    if ((++_sp & 255u) == 0u) { if (xb_ld(&(bar)[XB_TMO])) break; if (_sp > XB_SPIN_CAP) { atomicAdd(&(bar)[XB_TMO], 1u); break; } } } } while (0)

struct XcdBarrier {
    unsigned* bar; unsigned x;
    volatile LAS unsigned* st;
};

__device__ __forceinline__ XcdBarrier xcd_barrier_post(unsigned* bar, volatile LAS unsigned* st) {
    XcdBarrier b; b.bar = bar; b.x = xb_xcc_id(); b.st = st;
    if (threadIdx.x == 0) (void)xb_add(&bar[XB_XCNT(b.x)], 1u);
    return b;
}
__device__ __forceinline__ void xcd_barrier_complete(unsigned* bar, unsigned x, unsigned& nloc, unsigned& nx) {
    const unsigned G = gridDim.x * gridDim.y * gridDim.z;
    unsigned sum, cnt, mine, sp = 0u;
    for (;;) {
        sum = 0u; cnt = 0u; mine = 0u;
#pragma unroll
        for (unsigned j = 0; j < 16; ++j) { const unsigned c = xb_ld(&bar[XB_XCNT(j)]); sum += c; cnt += (c > 0u) ? 1u : 0u; mine = (j == x) ? c : mine; }
        if (sum == G) break;
        __builtin_amdgcn_s_sleep(1);
        if ((++sp & 255u) == 0u) { if (xb_ld(&bar[XB_TMO])) break; if (sp > XB_SPIN_CAP) { atomicAdd(&bar[XB_TMO], 1u); break; } }
    }
    nloc = mine > 0u ? mine : 1u; nx = cnt > 0u ? cnt : 1u;
}

__device__ __forceinline__ void xcd_barrier(const XcdBarrier& b) {
    asm volatile("s_waitcnt vmcnt(0)" ::: "memory");
    __syncthreads();
    if (threadIdx.x == 0) {
        unsigned* bar = b.bar;
        __builtin_amdgcn_s_waitcnt(0);
        unsigned nloc = b.st[0], nx = b.st[1];
        if (nloc == 0u) { xcd_barrier_complete(bar, b.x, nloc, nx); b.st[0] = nloc; b.st[1] = nx; }
        const unsigned old = xb_add(&bar[XB_XSUB(b.x)], 1u);
        const unsigned gen = old / nloc;
        if (old + 1u == (gen + 1u) * nloc) {
            __builtin_amdgcn_fence(__ATOMIC_RELEASE, "agent");
            asm volatile("s_waitcnt vmcnt(0)" ::: "memory");
            const unsigned og = xb_add(&bar[XB_TOP], 1u);
            const unsigned tg = og / nx;
            if (og + 1u == (tg + 1u) * nx) xb_add(&bar[XB_TOPGEN], 1u);
            else XB_SPIN(xb_ld(&bar[XB_TOPGEN]) == tg, bar);
            __builtin_amdgcn_fence(__ATOMIC_ACQUIRE, "agent");
            xb_add(&bar[XB_XGEN(b.x)], 1u);
            asm volatile("s_waitcnt vmcnt(0)" ::: "memory");
        } else {
            XB_SPIN(xb_ld(&bar[XB_XGEN(b.x)]) == gen, bar);
            __builtin_amdgcn_fence(__ATOMIC_ACQUIRE, "agent");
            asm volatile("s_waitcnt vmcnt(0)" ::: "memory");
        }
    }
    __syncthreads();
}
__device__ __forceinline__ float wave_sum(float v) {
#pragma unroll
    for (int o = 1; o < 64; o <<= 1) v += __shfl_xor(v, o);
    return v;
}
__device__ __forceinline__ float bf2f(unsigned short b) { return __uint_as_float((unsigned)b << 16); }

__device__ __forceinline__ void tr_item(const float* W, int N, bf16* WT, int pitch, int kcol0, int k0, int n0, int drow0, LAS float* scr, int lane) {
#pragma unroll 8
    for (int i = 0; i < 32; ++i) { const int kk = 2 * i + (lane >> 5); scr[kk * 33 + (lane & 31)] = W[(size_t)(k0 + kk) * N + n0 + (lane & 31)]; }
    LDS_WAIT(); asm volatile("" ::: "memory");
    const int c = lane & 7;
#pragma unroll
    for (int j = 0; j < 4; ++j) { const int n = (lane >> 3) + 8 * j; const LAS float* s = scr + (8 * c) * 33 + n;
        v4u o; o.x = pk2(s[0 * 33], s[1 * 33]); o.y = pk2(s[2 * 33], s[3 * 33]); o.z = pk2(s[4 * 33], s[5 * 33]); o.w = pk2(s[6 * 33], s[7 * 33]);
        *(GAS v4u*)(WT + (size_t)(drow0 + n) * pitch + kcol0 + k0 + 8 * c) = o; }
    LDS_WAIT(); asm volatile("" ::: "memory");
}

struct Ptrs {
    const float *x, *norm1_w, *w_in, *conv_w, *a_log_f, *a_log_b, *dtb_f, *dtb_b, *gdn_nw, *w_ba, *w_bb, *w_out, *norm2_w, *router_w, *router_b, *w_gu, *b_gu, *w_d, *b_d, *normf_w;
    float* out; unsigned char* ws;
};
struct Args { Ptrs p; int ph_lo, ph_hi, li, pad; };

__device__ __forceinline__ void p0_prologue(const Ptrs& P, LAS unsigned char* lds, int vcu, int G, int wave, int lane) {
    LAS float* scr = (LAS float*)(lds + RING_OFF + wave * 16384);
    const int gw = vcu * NWAVES + wave, NGW = G * NWAVES;
    bf16* WIN = (bf16*)(P.ws + WS_WIN); bf16* WAB = (bf16*)(P.ws + WS_WAB); bf16* WOUT = (bf16*)(P.ws + WS_WOUT); bf16* WGU = (bf16*)(P.ws + WS_WGU); bf16* WD = (bf16*)(P.ws + WS_WD);
    constexpr int I_IN = 16 * 241, I_BA = 8 * 32, I_BB = 16 * 32, I_OUT = 16 * 32, I_GU = 32 * 16 * 64, I_D = 32 * 16 * 32;
    constexpr int NITEMS = I_IN + I_BA + I_BB + I_OUT + I_GU + I_D;
    const int nitems = (G == 256 && !RIDE_OFF) ? I_IN + I_BA + I_BB + I_OUT : NITEMS;
    for (int it = gw; it < nitems; it += NGW) {
        int r = it;
        if (r < I_IN) { const int kb = r / 241, nb = r % 241, n0 = 32 * nb;
            const int d0 = n0 < 5632 ? n0 : (n0 < 5664 ? P_AF + (n0 - 5632) : P_GA + (n0 - 5664));
            tr_item(P.w_in, NIN, WIN, 1024, 0, 64 * kb, n0, d0, scr, lane); continue; } r -= I_IN;
        if (r < I_BA) { tr_item(P.w_ba, 1024, WAB, KAB, 0, 64 * (r / 32), 32 * (r % 32), 32 * (r % 32), scr, lane); continue; } r -= I_BA;
        if (r < I_BB) { tr_item(P.w_bb, 1024, WAB, KAB, 512, 64 * (r / 32), 32 * (r % 32), 32 * (r % 32), scr, lane); continue; } r -= I_BB;
        if (r < I_OUT) { tr_item(P.w_out, 1024, WOUT, 1024, 0, 64 * (r / 32), 32 * (r % 32), 32 * (r % 32), scr, lane); continue; } r -= I_OUT;
        if (r < I_GU) { const int e = r / 1024, q = r % 1024, kb = q / 64, nb = q % 64, n0 = 32 * nb;
            const int d0 = n0 < 1024 ? 256 * (n0 / 128) + (n0 % 128) : 256 * ((n0 - 1024) / 128) + 128 + ((n0 - 1024) % 128);
            tr_item(P.w_gu + (size_t)e * 1024 * 2048, 2048, WGU + (size_t)e * 2048 * 1024, 1024, 0, 64 * kb, n0, d0, scr, lane); continue; } r -= I_GU;
        { const int e = r / 512, q = r % 512;
            tr_item(P.w_d + (size_t)e * 1024 * 1024, 1024, WD + (size_t)e * 1024 * 1024, 1024, 0, 64 * (q / 32), 32 * (q % 32), 32 * (q % 32), scr, lane); }
    }
    for (int i = gw * 64 + lane; i < 224 * 1024 / 8; i += NGW * 64) ((GAS v4u*)(WIN + (size_t)7712 * 1024))[i] = (v4u){0u, 0u, 0u, 0u};
    bf16* XN = (bf16*)(P.ws + WS_XN);
    for (int m = gw; m < M; m += NGW) {
        const GAS f32x4* xr = (const GAS f32x4*)(P.x + (size_t)m * DM) + lane; const GAS f32x4* wr = (const GAS f32x4*)P.norm1_w + lane;
        f32x4 v[4]; float s = 0.f;
#pragma unroll
        for (int j = 0; j < 4; ++j) { v[j] = xr[64 * j]; s += (v[j].x * v[j].x + v[j].y * v[j].y) + (v[j].z * v[j].z + v[j].w * v[j].w); }
        const float rstd = rsqrtf(wave_sum(s) * (1.f / DM) + EPS);
        GAS unsigned long long* o8 = (GAS unsigned long long*)(XN + (size_t)m * DM) + lane;
#pragma unroll
        for (int j = 0; j < 4; ++j) { const f32x4 w = wr[64 * j]; o8[64 * j] = (unsigned long long)pk2(v[j].x * rstd * w.x, v[j].y * rstd * w.y) | ((unsigned long long)pk2(v[j].z * rstd * w.z, v[j].w * rstd * w.w) << 32); }
    }
}

__device__ __forceinline__ void build_etab(const unsigned* cnt, LAS int* etab, int tid) {
    if (tid < 32) etab[40 + tid] = (int)__hip_atomic_load(cnt + tid, __ATOMIC_RELAXED, __HIP_MEMORY_SCOPE_AGENT);
    LDS_WAIT(); __syncthreads();
    if (tid == 0) { int s = 0; for (int e = 0; e < 32; ++e) { etab[e] = s; s += (etab[40 + e] + 255) >> 8; } etab[32] = s; }
    LDS_WAIT(); __syncthreads();
}

template <int VAR> __device__ __forceinline__ void p7_router(const Ptrs& P, LAS unsigned char* lds, int G, int tid, int wave, int lane) {
    LAS float* rw = (LAS float*)(lds + RING_OFF);
    LAS int* hist = (LAS int*)(lds + ETAB_OFF);
    LAS int* asg = (LAS int*)(lds + GTAB_OFF);
    const float* X1 = P.out; bf16* H2 = (bf16*)(P.ws + (VAR ? WS_ACT : WS_XN));
    unsigned* CNT = (unsigned*)(P.ws + WS_CTL) + CW_CNT; int* LIST = (int*)(P.ws + WS_LIST); float* GATEL = (float*)(P.ws + WS_GATEL); int* ASG = (int*)(P.ws + WS_ASG);
    for (int i = tid; i < 1024 * 8; i += 512) { const int c = i >> 3, e4 = i & 7, rho = ((((c >> 8) << 2) + (c & 3)) << 6) + ((c >> 2) & 63);
        ((LAS f32x4*)rw)[rho * 8 + (e4 ^ ((rho >> 1) & 7))] = ((const GAS f32x4*)P.router_w)[i]; }
    for (int grp = blockIdx.x; grp < M / 64; grp += G) {
        const int r0 = grp * 64;
        if (tid < 64) hist[tid] = 0;
        LDS_WAIT(); __syncthreads();
#pragma unroll 1
        for (int i = 0; i < 8; i += 2) {
            const int lrow = wave * 8 + i, m = r0 + lrow;
            const GAS f32x4* wr = (const GAS f32x4*)P.norm2_w + lane;
            f32x4 va[4], vb[4]; float sa = 0.f, sb = 0.f;
            { const GAS f32x4* xa = (const GAS f32x4*)(X1 + (size_t)m * DM) + lane; const GAS f32x4* xb = (const GAS f32x4*)(X1 + (size_t)(m + 1) * DM) + lane;
#pragma unroll
              for (int j = 0; j < 4; ++j) { va[j] = xa[64 * j]; vb[j] = xb[64 * j]; }
#pragma unroll
              for (int j = 0; j < 4; ++j) { sa += (va[j].x * va[j].x + va[j].y * va[j].y) + (va[j].z * va[j].z + va[j].w * va[j].w); sb += (vb[j].x * vb[j].x + vb[j].y * vb[j].y) + (vb[j].z * vb[j].z + vb[j].w * vb[j].w); } }
            const float rsa = rsqrtf(wave_sum(sa) * (1.f / DM) + EPS), rsb = rsqrtf(wave_sum(sb) * (1.f / DM) + EPS);
            GAS unsigned long long* oa8 = (GAS unsigned long long*)(H2 + (size_t)m * DM) + lane; GAS unsigned long long* ob8 = (GAS unsigned long long*)(H2 + (size_t)(m + 1) * DM) + lane;
            float acca[32], accb[32];
#pragma unroll
            for (int e = 0; e < 32; ++e) { acca[e] = 0.f; accb[e] = 0.f; }
#pragma unroll
            for (int j = 0; j < 4; ++j) { const f32x4 w = wr[64 * j];
                va[j].x *= rsa * w.x; va[j].y *= rsa * w.y; va[j].z *= rsa * w.z; va[j].w *= rsa * w.w; vb[j].x *= rsb * w.x; vb[j].y *= rsb * w.y; vb[j].z *= rsb * w.z; vb[j].w *= rsb * w.w;
                oa8[64 * j] = (unsigned long long)pk2(va[j].x, va[j].y) | ((unsigned long long)pk2(va[j].z, va[j].w) << 32);
                ob8[64 * j] = (unsigned long long)pk2(vb[j].x, vb[j].y) | ((unsigned long long)pk2(vb[j].z, vb[j].w) << 32);
#pragma unroll
                for (int q = 0; q < 4; ++q) { const float ha = va[j][q], hb = vb[j][q]; const LAS f32x4* rp = (const LAS f32x4*)rw + ((4 * j + q) * 64 + lane) * 8; const int sw = (lane >> 1) & 7;
#pragma unroll
                    for (int e4 = 0; e4 < 8; ++e4) { const f32x4 r4 = rp[e4 ^ sw];
                        acca[4 * e4] += ha * r4.x; acca[4 * e4 + 1] += ha * r4.y; acca[4 * e4 + 2] += ha * r4.z; acca[4 * e4 + 3] += ha * r4.w;
                        accb[4 * e4] += hb * r4.x; accb[4 * e4 + 1] += hb * r4.y; accb[4 * e4 + 2] += hb * r4.z; accb[4 * e4 + 3] += hb * r4.w; } } }
            float r32[32], r16[16], r8[8], r4[4], r2[2], lg;
            { const bool hi = (lane >> 5) & 1;
#pragma unroll
              for (int q = 0; q < 32; ++q) { const float keep = hi ? accb[q] : acca[q], send = hi ? acca[q] : accb[q]; r32[q] = keep + __shfl_xor(send, 32); } }
            { const bool hi = (lane >> 4) & 1;
#pragma unroll
              for (int q = 0; q < 16; ++q) { const float keep = hi ? r32[16 + q] : r32[q], send = hi ? r32[q] : r32[16 + q]; r16[q] = keep + __shfl_xor(send, 16); } }
            { const bool hi = (lane >> 3) & 1;
#pragma unroll
              for (int q = 0; q < 8; ++q) { const float keep = hi ? r16[8 + q] : r16[q], send = hi ? r16[q] : r16[8 + q]; r8[q] = keep + __shfl_xor(send, 8); } }
            { const bool hi = (lane >> 2) & 1;
#pragma unroll
              for (int q = 0; q < 4; ++q) { const float keep = hi ? r8[4 + q] : r8[q], send = hi ? r8[q] : r8[4 + q]; r4[q] = keep + __shfl_xor(send, 4); } }
            { const bool hi = (lane >> 1) & 1;
#pragma unroll
              for (int q = 0; q < 2; ++q) { const float keep = hi ? r4[2 + q] : r4[q], send = hi ? r4[q] : r4[2 + q]; r2[q] = keep + __shfl_xor(send, 2); } }
            { const bool hi = lane & 1; const float keep = hi ? r2[1] : r2[0], send = hi ? r2[0] : r2[1]; lg = keep + __shfl_xor(send, 1); }
            const int e = lane & 31, half = lane >> 5; lg += P.router_b[e];
            float lv[4]; int li[4]; float cur = lg;
#pragma unroll
            for (int r = 0; r < 4; ++r) { float bv = cur; int bi = e;
#pragma unroll
                for (int o = 1; o < 32; o <<= 1) { const float ov = __shfl_xor(bv, o); const int oi = __shfl_xor(bi, o); if (ov > bv || (ov == bv && oi < bi)) { bv = ov; bi = oi; } }
                lv[r] = bv; li[r] = bi; if (e == bi) cur = -3.0e38f; }
            const float e1 = __expf(lv[1] - lv[0]), e2 = __expf(lv[2] - lv[0]), e3 = __expf(lv[3] - lv[0]);
            const float inv = 1.f / (1.f + e1 + e2 + e3);
            if (e < 4) {
                const float g = (e == 0 ? 1.f : e == 1 ? e1 : e == 2 ? e2 : e3) * inv;
                const int ee = e == 0 ? li[0] : e == 1 ? li[1] : e == 2 ? li[2] : li[3];
                const int rank = atomicAdd((int*)(hist + ee), 1);
                const int a = (lrow + half) * 4 + e;
                asg[a] = ee | (rank << 8); asg[256 + a] = __float_as_int(g); asg[512 + a] = (m + half) * 4 + e;
            }
        }
        LDS_WAIT(); __syncthreads();
        if (tid < 32) hist[32 + tid] = VAR ? 0 : (int)__hip_atomic_fetch_add(CNT + tid, (unsigned)hist[tid], __ATOMIC_RELAXED, __HIP_MEMORY_SCOPE_AGENT);
        LDS_WAIT(); __syncthreads();
        if (tid < 256 && !VAR) { const int w = asg[tid], ee = w & 255, pos = hist[32 + ee] + (w >> 8); const int tk = asg[512 + tid];
            LIST[(size_t)ee * M + pos] = tk >> 2; GATEL[(size_t)ee * M + pos] = __int_as_float(asg[256 + tid]); ASG[tk] = (ee << 16) | pos; }
        LDS_WAIT(); __syncthreads();
    }
}

template <int VAR> __device__ __forceinline__ void p10_final(const Ptrs& P, LAS unsigned char* lds, int G, int tid, int wave, int lane) {
    LAS int* etab = (LAS int*)(lds + ETAB_OFF);
    build_etab((const unsigned*)(P.ws + WS_CTL) + CW_CNT, etab, tid);
    const int* ASG = (const int*)(P.ws + WS_ASG); const bf16* YEXP = (const bf16*)(P.ws + WS_YEXP);
    const int gw = blockIdx.x * NWAVES + wave, NGW = G * NWAVES;
    typedef unsigned u32x2 __attribute__((ext_vector_type(2)));
    const GAS f32x4* wr = (const GAS f32x4*)P.normf_w + lane;
    for (int m0 = gw; m0 < M; m0 += 2 * NGW) {
        const int m1 = m0 + NGW < M ? m0 + NGW : m0;
        int slot[2][4];
#pragma unroll
        for (int q = 0; q < 2; ++q) { const int4 a4 = *(const int4*)(ASG + (size_t)(q ? m1 : m0) * 4);
            slot[q][0] = etab[a4.x >> 16] * 256 + (a4.x & 0xffff); slot[q][1] = etab[a4.y >> 16] * 256 + (a4.y & 0xffff); slot[q][2] = etab[a4.z >> 16] * 256 + (a4.z & 0xffff); slot[q][3] = etab[a4.w >> 16] * 256 + (a4.w & 0xffff); }
        f32x4 v[2][4]; u32x2 y[2][4][4];
#pragma unroll
        for (int q = 0; q < 2; ++q) { const GAS f32x4* xr = (const GAS f32x4*)(P.out + (size_t)(q ? m1 : m0) * DM) + lane;
#pragma unroll
            for (int j = 0; j < 4; ++j) v[q][j] = xr[64 * j];
#pragma unroll
            for (int k = 0; k < 4; ++k) { const GAS u32x2* yr = (const GAS u32x2*)(YEXP + (size_t)slot[q][k] * DM) + lane;
#pragma unroll
                for (int j = 0; j < 4; ++j) y[q][k][j] = yr[64 * j]; } }
#pragma unroll
        for (int q = 0; q < 2; ++q) {
            float s = 0.f;
#pragma unroll
            for (int j = 0; j < 4; ++j) {
#pragma unroll
                for (int k = 0; k < 4; ++k) { const u32x2 yy = y[q][k][j]; v[q][j].x += __uint_as_float(yy.x << 16); v[q][j].y += __uint_as_float(yy.x & 0xffff0000u); v[q][j].z += __uint_as_float(yy.y << 16); v[q][j].w += __uint_as_float(yy.y & 0xffff0000u); }
                s += (v[q][j].x * v[q][j].x + v[q][j].y * v[q][j].y) + (v[q][j].z * v[q][j].z + v[q][j].w * v[q][j].w); }
            const float rstd = rsqrtf(wave_sum(s) * (1.f / DM) + EPS);
            if (q == 0 || m1 != m0) { GAS f32x4* xo = (GAS f32x4*)((VAR ? (float*)(P.ws + WS_ACT) : P.out) + (size_t)(q ? m1 : m0) * DM) + lane;
#pragma unroll
                for (int j = 0; j < 4; ++j) { const f32x4 w = wr[64 * j]; xo[64 * j] = (f32x4){v[q][j].x * rstd * w.x, v[q][j].y * rstd * w.y, v[q][j].z * rstd * w.z, v[q][j].w * rstd * w.w}; } }
        }
    }
}

typedef float f32x16 __attribute__((ext_vector_type(16)));
typedef short v4i16_t __attribute__((ext_vector_type(4)));
typedef float f32x2_t __attribute__((ext_vector_type(2))); typedef __bf16 bf16x2_t __attribute__((ext_vector_type(2)));
__device__ __forceinline__ unsigned cvtpk(float lo, float hi) { f32x2_t v = {lo, hi}; bf16x2_t b = __builtin_convertvector(v, bf16x2_t); return __builtin_bit_cast(unsigned, b); }
constexpr int ATT_VPITCH = 144;
constexpr int ATT_WAVE_LDS = 32 * ATT_VPITCH;
__device__ __forceinline__ void attn_unit(const bf16* proj, bf16* OP, float* LSE, LAS unsigned char* vt, int unit, int lane) {
    const int q128 = unit & 127, p = (unit >> 7) % 3, bh = unit / 384, b = bh >> 3, h = bh & 7;
    const int r = p == 0 ? 1 : (p == 1 ? 4 : 16), gpc = 128 / r, c = q128 / gpc, g = q128 % gpc, L = SEQ / r, u0 = 32 * g;
    int lq = lane & 31, hi = lane >> 5;
    asm volatile("" : "+v"(lq), "+v"(hi));
    const bf16* base = proj + ((size_t)b * SEQ + c) * NINP + h * 64;
    const size_t ustride = (size_t)r * NINP;
    const int vrow = lane >> 3, vch = lane & 7;
    v4u qst[4], kst[5][4];
#pragma unroll
    for (int i = 0; i < 4; ++i) qst[i] = *(const v4u*)(base + (size_t)(u0 + vrow + 8 * i) * ustride + P_QA + 8 * vch);
#define ATT_KLOAD(t) do { _Pragma("unroll") for (int i = 0; i < 4; ++i) { int uk_ = u0 - 64 + 32 * (t) + vrow + 8 * i; uk_ = uk_ < 0 ? 0 : (uk_ > L - 1 ? L - 1 : uk_); kst[t][i] = *(const v4u*)(base + (size_t)uk_ * ustride + P_KA + 8 * vch); } } while (0)
    ATT_KLOAD(0); ATT_KLOAD(1); ATT_KLOAD(2);
    bf16x8 qf[4];
#pragma unroll
    for (int i = 0; i < 4; ++i) *(LAS v4u*)(vt + (vrow + 8 * i) * ATT_VPITCH + vch * 16) = qst[i];
    asm volatile("" ::: "memory");
#pragma unroll
    for (int d0 = 0; d0 < 4; ++d0) qf[d0] = *(const LAS bf16x8*)(vt + lq * ATT_VPITCH + (16 * d0 + 8 * hi) * 2);
    asm volatile("" ::: "memory");
    f32x16 sc[5];
#pragma unroll
    for (int t = 0; t < 5; ++t) {
#pragma unroll
        for (int i = 0; i < 4; ++i) *(LAS v4u*)(vt + (vrow + 8 * i) * ATT_VPITCH + vch * 16) = kst[t][i];
        asm volatile("" ::: "memory");
        if (t == 0) ATT_KLOAD(3);
        if (t == 1) ATT_KLOAD(4);
        f32x16 a = {};
#pragma unroll
        for (int d0 = 0; d0 < 4; ++d0) a = __builtin_amdgcn_mfma_f32_32x32x16_bf16(*(const LAS bf16x8*)(vt + lq * ATT_VPITCH + (16 * d0 + 8 * hi) * 2), qf[d0], a, 0, 0, 0);
        sc[t] = a;
        asm volatile("" ::: "memory");
    }
#undef ATT_KLOAD
    v4u vst[5][4];
#define ATT_VLOAD(t) do { _Pragma("unroll") for (int i = 0; i < 4; ++i) { int uk_ = u0 - 64 + 32 * (t) + vrow + 8 * i; uk_ = uk_ < 0 ? 0 : (uk_ > L - 1 ? L - 1 : uk_); vst[t][i] = *(const v4u*)(base + (size_t)uk_ * ustride + P_VA + 8 * vch); } } while (0)
    ATT_VLOAD(0); ATT_VLOAD(1);
    const float slope2 = exp2f(-(float)(h + 1)) * (float)r * 1.4426950408889634f, qs = 0.125f * 1.4426950408889634f;
    const float Df = (float)(4 * hi - lq);
    float mx = -1e30f;
#pragma unroll
    for (int t = 0; t < 5; ++t)
#pragma unroll
        for (int i = 0; i < 16; ++i) {
            const float diff = (float)(32 * t + (i & 3) + 8 * (i >> 2) - 64) + Df;
            float v = fmaf(sc[t][i], qs, -slope2 * fabsf(diff));
            if (t == 0) v = diff >= -64.f ? v : -1e30f;
            if (t == 4) v = diff <= 64.f ? v : -1e30f;
            sc[t][i] = v;
        }
    if (u0 < 64 || u0 + 96 > L) {
#pragma unroll
        for (int t = 0; t < 5; ++t)
#pragma unroll
            for (int i = 0; i < 16; ++i) { const int uk = u0 - 64 + 32 * t + (i & 3) + 8 * (i >> 2) + 4 * hi; if (uk < 0 || uk >= L) sc[t][i] = -1e30f; }
    }
#pragma unroll
    for (int t = 0; t < 5; ++t)
#pragma unroll
        for (int i = 0; i < 16; ++i) mx = fmaxf(mx, sc[t][i]);
    mx = fmaxf(mx, __shfl_xor(mx, 32));
    float l = 0.f;
#pragma unroll
    for (int t = 0; t < 5; ++t)
#pragma unroll
        for (int i = 0; i < 16; ++i) { const float e = __builtin_amdgcn_exp2f(sc[t][i] - mx); sc[t][i] = e; l += e; }
    l += __shfl_xor(l, 32);
    const float il = __builtin_amdgcn_rcpf(l);
    unsigned pf[5][2][4];
#pragma unroll
    for (int t = 0; t < 5; ++t)
#pragma unroll
        for (int s = 0; s < 2; ++s)
#pragma unroll
            for (int w = 0; w < 4; ++w) pf[t][s][w] = cvtpk(sc[t][8 * s + 2 * w], sc[t][8 * s + 2 * w + 1]);
    f32x16 o0 = {}, o1 = {};
    const int i16 = lane & 15, g16 = (lane >> 4) & 1;
    const LAS unsigned char* trb = vt + (4 * hi + (i16 >> 2)) * ATT_VPITCH + (16 * g16 + 4 * (i16 & 3)) * 2;
#pragma unroll
    for (int t = 0; t < 5; ++t) {
#pragma unroll
        for (int i = 0; i < 4; ++i) *(LAS v4u*)(vt + (vrow + 8 * i) * ATT_VPITCH + vch * 16) = vst[t][i];
        asm volatile("" ::: "memory");
        if (t == 0) ATT_VLOAD(2);
        if (t == 1) ATT_VLOAD(3);
        if (t == 2) ATT_VLOAD(4);
#pragma unroll
        for (int s = 0; s < 2; ++s) {
#pragma unroll
            for (int dt = 0; dt < 2; ++dt) {
                const LAS unsigned char* pa = trb + (16 * s) * ATT_VPITCH + dt * 64;
                const v4i16_t lo = __builtin_amdgcn_ds_read_tr16_b64_v4i16((LAS v4i16_t*)pa);
                const v4i16_t hh = __builtin_amdgcn_ds_read_tr16_b64_v4i16((LAS v4i16_t*)(pa + 8 * ATT_VPITCH));
                const bf16x8 vf = (bf16x8){lo[0], lo[1], lo[2], lo[3], hh[0], hh[1], hh[2], hh[3]};
                const v4u pw = (v4u){pf[t][s][0], pf[t][s][1], pf[t][s][2], pf[t][s][3]};
                if (dt == 0) o0 = __builtin_amdgcn_mfma_f32_32x32x16_bf16(vf, __builtin_bit_cast(bf16x8, pw), o0, 0, 0, 0);
                else o1 = __builtin_amdgcn_mfma_f32_32x32x16_bf16(vf, __builtin_bit_cast(bf16x8, pw), o1, 0, 0, 0);
            }
        }
        asm volatile("" ::: "memory");
    }
#undef ATT_VLOAD
    const size_t tok = (size_t)b * SEQ + (size_t)(u0 + lq) * r + c;
    typedef unsigned u32x2 __attribute__((ext_vector_type(2)));
#pragma unroll
    for (int qd = 0; qd < 4; ++qd) {
        *(LAS u32x2*)(vt + lq * ATT_VPITCH + (4 * hi + 8 * qd) * 2) = (u32x2){cvtpk(o0[4 * qd] * il, o0[4 * qd + 1] * il), cvtpk(o0[4 * qd + 2] * il, o0[4 * qd + 3] * il)};
        *(LAS u32x2*)(vt + lq * ATT_VPITCH + (32 + 4 * hi + 8 * qd) * 2) = (u32x2){cvtpk(o1[4 * qd] * il, o1[4 * qd + 1] * il), cvtpk(o1[4 * qd + 2] * il, o1[4 * qd + 3] * il)};
    }
    asm volatile("" ::: "memory");
#pragma unroll
    for (int i = 0; i < 4; ++i) {
        const v4u ov = *(const LAS v4u*)(vt + (vrow + 8 * i) * ATT_VPITCH + vch * 16);
        *(v4u*)(OP + ((size_t)p * M + (size_t)b * SEQ + (size_t)(u0 + vrow + 8 * i) * r + c) * 512 + h * 64 + 8 * vch) = ov;
    }
    asm volatile("" ::: "memory");
    if (hi == 0) LSE[((size_t)p * M + tok) * 8 + h] = (mx + __builtin_amdgcn_logf(l)) * 0.6931471805599453f;
}
__device__ __forceinline__ void attn_phase(const Ptrs& P, LAS unsigned char* lds, int vcu, int G, int wave, int lane, int i0 = 0, int i1 = 1 << 30) {
    const bf16* proj = (const bf16*)(P.ws + WS_PROJ); bf16* OP = (bf16*)(P.ws + WS_OP); float* LSE = (float*)(P.ws + WS_LSE);
    LAS unsigned char* vt = lds + RING_OFF + wave * ATT_WAVE_LDS;
    for (int i = i0, unit = (vcu + i0 * G) * NWAVES + wave; i < i1 && unit < BATCH * 8 * 3 * 128; ++i, unit += G * NWAVES) attn_unit(proj, OP, LSE, vt, unit, lane);
}
__device__ __forceinline__ void merge_attn(const Ptrs& P, int G, int wave, int lane) {
    const bf16* OP = (const bf16*)(P.ws + WS_OP); const float* LSE = (const float*)(P.ws + WS_LSE); bf16* YAB = (bf16*)(P.ws + WS_YAB);
    for (int m = blockIdx.x * NWAVES + wave; m < M; m += G * NWAVES) {
        const int h = lane >> 3;
        const float l0 = LSE[(size_t)m * 8 + h], l1 = LSE[((size_t)M + m) * 8 + h], l2 = LSE[((size_t)2 * M + m) * 8 + h];
        const float mx = fmaxf(l0, fmaxf(l1, l2)), e0 = __expf(l0 - mx), e1 = __expf(l1 - mx), e2 = __expf(l2 - mx), inv = 1.f / (e0 + e1 + e2);
        const float w0 = e0 * inv, w1 = e1 * inv, w2 = e2 * inv;
        const v4u a = *(const v4u*)(OP + (size_t)m * 512 + lane * 8), bb = *(const v4u*)(OP + ((size_t)M + m) * 512 + lane * 8), cc = *(const v4u*)(OP + ((size_t)2 * M + m) * 512 + lane * 8);
        v4u o;
#define MG(x) pk2(w0 * __uint_as_float(a.x << 16) + w1 * __uint_as_float(bb.x << 16) + w2 * __uint_as_float(cc.x << 16), w0 * __uint_as_float(a.x & 0xffff0000u) + w1 * __uint_as_float(bb.x & 0xffff0000u) + w2 * __uint_as_float(cc.x & 0xffff0000u))
        o.x = MG(x); o.y = MG(y); o.z = MG(z); o.w = MG(w);
#undef MG
        *(v4u*)(YAB + (size_t)m * KAB + lane * 8) = o;
    }
}
constexpr int GL_QN = 0, GL_KN = 18432, GL_KT = 36864, GL_VT = 57472;
constexpr int GTS = 2576;
__device__ __forceinline__ constexpr int gl_mat(int d, int which) { return d == 0 ? 78080 + which * 10240 : (which < 2 ? 108800 + which * 10240 : 140800); }
static_assert(GL_VT + 8 * GTS == 78080 && gl_mat(1, 1) + 10240 <= RING_BYTES && GTAB_OFF + 7680 <= 140800 && 140800 + 10240 <= LDS_BYTES, "prep LDS map");
constexpr int GP128 = 288, GP64 = 160;
__device__ __forceinline__ bf16x8 ldfrag(const LAS unsigned char* base, int pitch, int r0, int k0, int lane) { return *(const LAS bf16x8*)(base + (r0 + (lane & 15)) * pitch + (k0 + 8 * (lane >> 4)) * 2); }
typedef unsigned u32x2 __attribute__((ext_vector_type(2)));
#define WG_BAR() do { asm volatile("s_waitcnt lgkmcnt(0)" ::: "memory"); __builtin_amdgcn_s_barrier(); asm volatile("" ::: "memory"); } while (0)
__device__ __forceinline__ float softplusf_(float x) { return x > 20.f ? x : log1pf(__expf(x)); }

struct CvIn { f32x4 v[8]; };
__device__ __forceinline__ void cv_decode(int p, const Ptrs& P, const float*& W, bf16*& WT, int& N, int& k0, int& n0, int& d0) {
    if (p < 32768) { const int e = p >> 10, r = p & 1023, kb = r >> 6, nb = r & 63; N = 2048; k0 = 64 * kb; n0 = 32 * nb;
        W = P.w_gu + (size_t)e * 1024 * 2048; WT = (bf16*)(P.ws + WS_WGU) + (size_t)e * 2048 * 1024;
        d0 = n0 < 1024 ? 256 * (n0 / 128) + (n0 % 128) : 256 * ((n0 - 1024) / 128) + 128 + ((n0 - 1024) % 128);
    } else { const int pp = p - 32768, e = pp >> 9, r = pp & 511, kb = r >> 5, nb = r & 31; N = 1024; k0 = 64 * kb; n0 = 32 * nb;
        W = P.w_d + (size_t)e * 1024 * 1024; WT = (bf16*)(P.ws + WS_WD) + (size_t)e * 1024 * 1024; d0 = n0; }
}
__device__ __forceinline__ void cv_load(CvIn& C, const Ptrs& P, int p, int lane) {
    const float* W; bf16* WT; int N, k0, n0, d0; cv_decode(p, P, W, WT, N, k0, n0, d0);
    const float* src = W + (size_t)(k0 + 4 * (lane >> 3)) * N + n0 + 4 * (lane & 7);
#pragma unroll
    for (int b = 0; b < 2; ++b)
#pragma unroll
        for (int j = 0; j < 4; ++j) C.v[b * 4 + j] = *(const f32x4*)(src + (size_t)(32 * b + j) * N);
}
__device__ __forceinline__ void cv_store(const CvIn& C, const Ptrs& P, int p, int lane, LAS unsigned char* buf) {
    const float* W; bf16* WT; int N, k0, n0, d0; cv_decode(p, P, W, WT, N, k0, n0, d0);
    const int r8 = lane >> 3, c4 = lane & 7;
#pragma unroll
    for (int b = 0; b < 2; ++b)
#pragma unroll
        for (int e = 0; e < 4; ++e)
            *(LAS u32x2*)(buf + (4 * c4 + e) * 128 + 16 * (((r8 >> 1) + 4 * b) ^ c4) + 8 * (r8 & 1)) = (u32x2){pk2(C.v[b * 4][e], C.v[b * 4 + 1][e]), pk2(C.v[b * 4 + 2][e], C.v[b * 4 + 3][e])};
    asm volatile("" ::: "memory");
#pragma unroll
    for (int t = 0; t < 4; ++t) { const int n = 8 * t + r8;
        const v4u d = *(const LAS v4u*)(buf + n * 128 + 16 * (c4 ^ ((n >> 2) & 7)));
        *(v4u*)(WT + (size_t)(d0 + n) * 1024 + k0 + 8 * c4) = d; }
    asm volatile("" ::: "memory");
}
constexpr int CV_PAIRS = 49152;
__device__ __forceinline__ void st_rowmajor(LAS unsigned char* mat, const f32x4& p, int rb, int c) {
#pragma unroll
    for (int rho = 0; rho < 4; ++rho) *(LAS bf16*)(mat + (rb + rho) * GP64 + c * 2) = (bf16)f2bf(p[rho]);
}
__device__ __forceinline__ void gdn_prep_item(const Ptrs& P, LAS unsigned char* lds, int bh, int n, int cvbase, bool has_next, unsigned (&TCH)[4], int tid, int wave, int lane, int pmode = 0) {
    const bool nost = pmode & 1, nold = pmode & 2, junk = pmode & 8;
#define JNK(T, p) (junk ? (T)(P.ws + ((size_t)504 << 20) + ((size_t)((unsigned char*)(p) - P.ws) & (((size_t)64 << 20) - 1))) : (p))
    asm volatile("" : "+v"(tid), "+v"(lane));
    const int b = bh >> 3, h = bh & 7, item = bh * 64 + n; const size_t m0 = (size_t)b * SEQ + n * 64;
    const bf16* proj = (const bf16*)(P.ws + WS_PROJ);
    LAS float* SM = (LAS float*)(lds + ETAB_OFF);
    const LAS float* CW = (const LAS float*)(lds + GTAB_OFF);
    float* EG = (float*)(P.ws + WS_GEG);
    const int rp = tid >> 4, part = tid & 15;
    v4u xn[6];
#pragma unroll
    for (int i = 0; i < 6; ++i) { const int t = n * 64 + 2 * rp + i - 2; xn[i] = (v4u){0u, 0u, 0u, 0u};
        if (t >= 0 && t < SEQ && !nold) xn[i] = *(const v4u*)(proj + ((size_t)b * SEQ + t) * NINP + P_QB + h * 128 + part * 8); }
    asm volatile("" ::: "memory");
    if (wave == 0 && !(pmode & 16)) {
        const bf16* pr = proj + (m0 + lane) * NINP;
        const float gf = -__expf(P.a_log_f[h]) * softplusf_(bf2f(pr[P_AF + h]) + P.dtb_f[h]);
        const float gb = -__expf(P.a_log_b[h]) * softplusf_(bf2f(pr[P_AB + h]) + P.dtb_b[h]);
        float cf = gf, cb = gb;
#pragma unroll
        for (int o = 1; o < 64; o <<= 1) { const float t1 = __shfl_up(cf, o), t2 = __shfl_down(cb, o); if (lane >= o) cf += t1; if (lane + o < 64) cb += t2; }
        SM[lane] = cf; SM[64 + lane] = cb; SM[128 + lane] = 1.f / (1.f + __expf(-bf2f(pr[P_BF + h]))); SM[192 + lane] = 1.f / (1.f + __expf(-bf2f(pr[P_BB + h])));
        const float cfl = __shfl(cf, 63), cb0 = __shfl(cb, 0);
        if (!nost && !junk) { EG[(size_t)item * 64 + lane] = __expf(cf); EG[(size_t)(2048 + item) * 64 + lane] = __expf(cb);
        EG[(size_t)(4096 + item) * 64 + lane] = __expf(cfl - cf); EG[(size_t)(6144 + item) * 64 + lane] = __expf(cb0 - cb); }
    }
    {
        bf16* Qg = (bf16*)(P.ws + WS_GQ);
#pragma unroll
        for (int which = 0; which < 3; ++which) {
            v4u x[6];
#pragma unroll
            for (int i = 0; i < 6; ++i) x[i] = xn[i];
            asm volatile("" ::: "memory");
            if (which < 2) {
#pragma unroll
                for (int i = 0; i < 6; ++i) { const int t = n * 64 + 2 * rp + i - 2; xn[i] = (v4u){0u, 0u, 0u, 0u};
                    if (t >= 0 && t < SEQ && !nold) xn[i] = *(const v4u*)(proj + ((size_t)b * SEQ + t) * NINP + P_QB + (which + 1) * 1024 + h * 128 + part * 8); }
            }
            asm volatile("" ::: "memory");
            float a[2][8];
#pragma unroll
            for (int o = 0; o < 2; ++o)
#pragma unroll
                for (int c = 0; c < 8; ++c) a[o][c] = 0.f;
#pragma unroll
            for (int j = 0; j < 5; ++j) {
                const LAS f32x4* wp = (const LAS f32x4*)(CW + (j * 3 + which) * 128 + part * 8);
                const f32x4 w0 = wp[0], w1 = wp[1];
#pragma unroll
                for (int o = 0; o < 2; ++o) { const v4u xv = x[o + j];
                    a[o][0] += __uint_as_float(xv.x << 16) * w0.x; a[o][1] += __uint_as_float(xv.x & 0xffff0000u) * w0.y; a[o][2] += __uint_as_float(xv.y << 16) * w0.z; a[o][3] += __uint_as_float(xv.y & 0xffff0000u) * w0.w;
                    a[o][4] += __uint_as_float(xv.z << 16) * w1.x; a[o][5] += __uint_as_float(xv.z & 0xffff0000u) * w1.y; a[o][6] += __uint_as_float(xv.w << 16) * w1.z; a[o][7] += __uint_as_float(xv.w & 0xffff0000u) * w1.w; }
            }
#pragma unroll
            for (int o = 0; o < 2; ++o) {
                float ss = 0.f;
#pragma unroll
                for (int c = 0; c < 8; ++c) { a[o][c] = a[o][c] * __builtin_amdgcn_rcpf(1.f + __expf(-a[o][c])); ss += a[o][c] * a[o][c]; }
                if (which < 2) {
                    ss += __shfl_xor(ss, 1); ss += __shfl_xor(ss, 2); ss += __shfl_xor(ss, 4); ss += __shfl_xor(ss, 8);
                    const float rn = rsqrtf(ss + EPS) * (which == 0 ? 0.08838834764831845f : 1.f);
#pragma unroll
                    for (int c = 0; c < 8; ++c) a[o][c] *= rn;
                    v4u ov; ov.x = pk2(a[o][0], a[o][1]); ov.y = pk2(a[o][2], a[o][3]); ov.z = pk2(a[o][4], a[o][5]); ov.w = pk2(a[o][6], a[o][7]);
                    *(LAS v4u*)(lds + (which == 0 ? GL_QN : GL_KN) + (2 * rp + o) * GP128 + part * 16) = ov;
                    if (which == 0 && !nost) *JNK(v4u*, (v4u*)(Qg + (m0 + 2 * rp + o) * 1024 + h * 128 + part * 8)) = ov;
                }
            }
            if (which >= 1) {
                LAS unsigned char* tp = lds + (which == 1 ? GL_KT : GL_VT) + (part >> 1) * GTS + ((part & 1) * 8) * GP64 + (2 * rp) * 2;
#pragma unroll
                for (int c = 0; c < 8; ++c) *(LAS unsigned*)(tp + c * GP64) = pk2(a[0][c], a[1][c]);
            }
        }
    }
    WG_BAR();
    if (has_next && !(pmode & 4)) {
        const bf16* tp_;
        if (tid < 408) { const int row = tid / 6, seg = tid % 6; int t = (n + 1) * 64 + row - 2; t = t < 0 ? 0 : (t > SEQ - 1 ? SEQ - 1 : t);
            tp_ = proj + ((size_t)b * SEQ + t) * NINP + P_QB + (seg >> 1) * 1024 + h * 128 + (seg & 1) * 64; }
        else { const int row = tid < 472 ? tid - 408 : 0; tp_ = proj + ((size_t)b * SEQ + (n + 1) * 64 + row) * NINP + P_AF; }
        asm volatile("global_load_dword %0, %1, off" : "+v"(TCH[0]) : "v"(tp_) : "memory");
    }
#pragma unroll
    for (int i = 0; i < 2; ++i) { const int dk = i * 64 + (tid >> 3), seg = tid & 7;
        const v4u kv = *(const LAS v4u*)(lds + GL_KT + (dk >> 4) * GTS + (dk & 15) * GP64 + seg * 16);
        if (!nost) *JNK(v4u*, (v4u*)((bf16*)(P.ws + WS_GKT) + (size_t)item * 8192 + dk * 64 + seg * 8)) = kv; }
    const int q4 = lane >> 4, l16 = lane & 15;
    f32x4 accR[2][2];
#pragma unroll 1
    for (int rep2_ = 0; rep2_ < ((PREP_PROBE & 6) ? 2 : 1); ++rep2_) {
    if (rep2_ == 1) WG_BAR();
#pragma unroll
    for (int x = 0; x < 2; ++x) {
        const int tl = 2 * wave + x, mi = tl >> 2, nj = tl & 3, c = nj * 16 + l16, rb = mi * 16 + 4 * q4;
        f32x4 g = {0.f, 0.f, 0.f, 0.f}, qk = {0.f, 0.f, 0.f, 0.f};
#pragma unroll
        for (int kk = 0; kk < 4; ++kk) {
            const bf16x8 am = ldfrag(lds + GL_KN, GP128, mi * 16, kk * 32, lane), bn = ldfrag(lds + GL_KN, GP128, nj * 16, kk * 32, lane), qn = ldfrag(lds + GL_QN, GP128, nj * 16, kk * 32, lane);
            g = __builtin_amdgcn_mfma_f32_16x16x32_bf16(am, bn, g, 0, 0, 0);
            qk = __builtin_amdgcn_mfma_f32_16x16x32_bf16(am, qn, qk, 0, 0, 0);
        }
#pragma unroll
        for (int d = 0; d < 2; ++d) {
            const float gcc = SM[64 * d + c], bc = SM[128 + 64 * d + c];
            const f32x4 gcr = *(const LAS f32x4*)(SM + 64 * d + rb), br = *(const LAS f32x4*)(SM + 128 + 64 * d + rb);
            float at[4], am2[4], qv[4];
#pragma unroll
            for (int rho = 0; rho < 4; ++rho) {
                const int rr = rb + rho;
                const bool low = d == 0 ? (rr > c) : (rr < c);
                const bool upp = d == 0 ? (c > rr) : (c < rr);
                const float e1 = __expf(fminf(gcr[rho] - gcc, 0.f)), e2 = __expf(fminf(gcc - gcr[rho], 0.f));
                at[rho] = low ? br[rho] * e1 * g[rho] : 0.f;
                am2[rho] = upp ? bc * e2 * g[rho] : 0.f;
                const bool qm = d == 0 ? (rr <= c) : (rr >= c);
                qv[rho] = qm ? e2 * qk[rho] : 0.f;
                accR[d][x][rho] = (rr == c ? 1.f : 0.f) - at[rho];
            }
            *(LAS u32x2*)(lds + gl_mat(d, 1) + c * GP64 + rb * 2) = (u32x2){pk2(at[0], at[1]), pk2(at[2], at[3])};
            *(LAS u32x2*)(lds + gl_mat(d, 0) + c * GP64 + rb * 2) = (u32x2){pk2(am2[0], am2[1]), pk2(am2[2], am2[3])};
            *(LAS u32x2*)(lds + gl_mat(d, 2) + c * GP64 + rb * 2) = (u32x2){pk2((rb == c ? 1.f : 0.f) - am2[0], (rb + 1 == c ? 1.f : 0.f) - am2[1]), pk2((rb + 2 == c ? 1.f : 0.f) - am2[2], (rb + 3 == c ? 1.f : 0.f) - am2[3])};
            bf16* qg = (bf16*)(P.ws + WS_GQK) + ((size_t)(d * 2048 + item) * 64 + c) * 64 + rb;
            if (!nost) *JNK(u32x2*, (u32x2*)qg) = (u32x2){pk2(qv[0], qv[1]), pk2(qv[2], qv[3])};
        }
    }
    WG_BAR();
    if ((PREP_PROBE & 2) && rep2_ == 0) continue;
    const int cvb = (rep2_ == ((PREP_PROBE & 6) ? 1 : 0)) ? cvbase : -1;
    CvIn CV;
#pragma unroll
    for (int j = 0; j < 8; ++j) CV.v[j] = (f32x4){0.f, 0.f, 0.f, 0.f};
    auto stage = [&](const int s) __attribute__((always_inline)) {
        f32x4 accP[2][2];
#pragma unroll
        for (int d = 0; d < 2; ++d) {
#pragma unroll
            for (int x = 0; x < 2; ++x) {
                const int tl = 2 * wave + x, mi = tl >> 2, nj = tl & 3;
                f32x4 p = {0.f, 0.f, 0.f, 0.f}; f32x4 rr = accR[d][x];
                if (d == 0 ? (mi >= nj) : (mi <= nj))
#pragma unroll
                for (int kk = 0; kk < 2; ++kk) {
                    const bf16x8 pm = ldfrag(lds + gl_mat(d, 0), GP64, mi * 16, kk * 32, lane), pt = ldfrag(lds + gl_mat(d, 1), GP64, nj * 16, kk * 32, lane), rm = ldfrag(lds + gl_mat(d, 2), GP64, mi * 16, kk * 32, lane);
                    p = __builtin_amdgcn_mfma_f32_16x16x32_bf16(pm, pt, p, 0, 0, 0);
                    rr = __builtin_amdgcn_mfma_f32_16x16x32_bf16(rm, pt, rr, 0, 0, 0);
                }
                accP[d][x] = p; if (s >= 2) accR[d][x] = rr;
            }
        }
        WG_BAR();
#pragma unroll
        for (int d = 0; d < 2; ++d) {
#pragma unroll
            for (int x = 0; x < 2; ++x) {
                const int tl = 2 * wave + x, mi = tl >> 2, nj = tl & 3, c = nj * 16 + l16, rb = mi * 16 + 4 * q4;
                if (!(d == 0 ? (mi >= nj) : (mi <= nj))) continue;
                if (s < 6) {
                    const f32x4 p = accP[d][x];
                    *(LAS u32x2*)(lds + gl_mat(d, 1) + c * GP64 + rb * 2) = (u32x2){pk2(p[0], p[1]), pk2(p[2], p[3])};
                    st_rowmajor(lds + gl_mat(d, 0), p, rb, c); st_rowmajor(lds + gl_mat(d, 2), accR[d][x], rb, c);
                } else {
                    const float bc = SM[128 + 64 * d + c], bg = bc * __expf(SM[64 * d + c]);
                    st_rowmajor(lds + gl_mat(d, 2), accR[d][x] * bc, rb, c); st_rowmajor(lds + gl_mat(d, 0), accR[d][x] * bg, rb, c);
                }
            }
        }
        WG_BAR();
    };
#pragma unroll 1
    for (int sp = 0; sp < 3; ++sp) {
        if (cvb >= 0) cv_load(CV, P, cvb + sp * 2048, lane);
        stage(2 * sp + 1); stage(2 * sp + 2);
        asm volatile("" :: "v"(CV.v[0]), "v"(CV.v[1]), "v"(CV.v[2]), "v"(CV.v[3]), "v"(CV.v[4]), "v"(CV.v[5]), "v"(CV.v[6]), "v"(CV.v[7]));
        if (cvb >= 0) cv_store(CV, P, cvb + sp * 2048, lane, lds + GL_QN + wave * 4096);
    }
    }
#pragma unroll 1
    for (int rep3_ = 0; rep3_ < ((PREP_PROBE & 8) ? 2 : 1); ++rep3_)
#pragma unroll
    for (int d = 0; d < 2; ++d) {
        bf16* UTg = (bf16*)(P.ws + WS_GUT) + (size_t)(d * 2048 + item) * 8192; bf16* Wg = (bf16*)(P.ws + WS_GW) + (size_t)(d * 2048 + item) * 8192;
        const int hi_ = l16 >> 3, s_ = 2 * (q4 & 1) + (q4 >> 1);
        v4u PU[2], PW[2];
#pragma unroll
        for (int xp = 0; xp < 2; ++xp) {
            unsigned ua[2][2], wa[2][2];
#pragma unroll
            for (int xx = 0; xx < 2; ++xx) {
                const int x = 2 * xp + xx;
                { const int mi = x, nj = wave;
                  f32x4 u = {0.f, 0.f, 0.f, 0.f};
#pragma unroll
                  for (int kk = 0; kk < 2; ++kk) u = __builtin_amdgcn_mfma_f32_16x16x32_bf16(ldfrag(lds + gl_mat(d, 2), GP64, mi * 16, kk * 32, lane), ldfrag(lds + GL_VT + nj * GTS, GP64, 0, kk * 32, lane), u, 0, 0, 0);
                  ua[xx][0] = pk2(u[0], u[1]); ua[xx][1] = pk2(u[2], u[3]); }
                { const int md = 4 * (wave >> 2) + x, ni = wave & 3;
                  f32x4 w = {0.f, 0.f, 0.f, 0.f};
#pragma unroll
                  for (int kk = 0; kk < 2; ++kk) w = __builtin_amdgcn_mfma_f32_16x16x32_bf16(ldfrag(lds + GL_KT + md * GTS, GP64, 0, kk * 32, lane), ldfrag(lds + gl_mat(d, 0), GP64, ni * 16, kk * 32, lane), w, 0, 0, 0);
                  wa[xx][0] = pk2(w[0], w[1]); wa[xx][1] = pk2(w[2], w[3]); }
            }
            { const auto r0 = __builtin_amdgcn_permlane16_swap(ua[0][0], ua[1][0], false, false), r1 = __builtin_amdgcn_permlane16_swap(ua[0][1], ua[1][1], false, false); PU[xp] = (v4u){r0[0], r1[0], r0[1], r1[1]}; }
            { const auto r0 = __builtin_amdgcn_permlane16_swap(wa[0][0], wa[1][0], false, false), r1 = __builtin_amdgcn_permlane16_swap(wa[0][1], wa[1][1], false, false); PW[xp] = (v4u){r0[0], r1[0], r0[1], r1[1]}; }
        }
        {
            const v4u sd = hi_ ? PU[0] : PU[1]; v4u rc;
            rc.x = __builtin_amdgcn_update_dpp(0, sd.x, 0x128, 0xf, 0xf, false); rc.y = __builtin_amdgcn_update_dpp(0, sd.y, 0x128, 0xf, 0xf, false);
            rc.z = __builtin_amdgcn_update_dpp(0, sd.z, 0x128, 0xf, 0xf, false); rc.w = __builtin_amdgcn_update_dpp(0, sd.w, 0x128, 0xf, 0xf, false);
            bf16* o = UTg + (wave * 16 + (l16 & 7)) * 64 + 8 * (s_ + 4 * hi_);
            if (!nost) { *JNK(v4u*, (v4u*)o) = hi_ ? rc : PU[0]; *JNK(v4u*, (v4u*)(o + 8 * 64)) = hi_ ? PU[1] : rc; }
        }
        {
            const v4u sd = hi_ ? PW[0] : PW[1]; v4u rc;
            rc.x = __builtin_amdgcn_update_dpp(0, sd.x, 0x128, 0xf, 0xf, false); rc.y = __builtin_amdgcn_update_dpp(0, sd.y, 0x128, 0xf, 0xf, false);
            rc.z = __builtin_amdgcn_update_dpp(0, sd.z, 0x128, 0xf, 0xf, false); rc.w = __builtin_amdgcn_update_dpp(0, sd.w, 0x128, 0xf, 0xf, false);
            bf16* o = Wg + ((wave & 3) * 16 + (l16 & 7)) * 128 + 64 * (wave >> 2) + 8 * (s_ + 4 * hi_);
            if (!nost) { *JNK(v4u*, (v4u*)o) = hi_ ? rc : PW[0]; *JNK(v4u*, (v4u*)(o + 8 * 128)) = hi_ ? PW[1] : rc; }
        }
    }
    WG_BAR();
}
__device__ __forceinline__ void gdn_prep_phase(const Ptrs& P, LAS unsigned char* lds, int vcu, int G, int tid, int wave, int lane, bool ride = true, int pmode = 0) {
    unsigned TCH[4] = {0u, 0u, 0u, 0u};
    for (int it = vcu * 8; it < 2048; it += G * 8) {
        const int bh = it >> 6;
        LAS float* CW = (LAS float*)(lds + GTAB_OFF); const int h = bh & 7;
        __syncthreads();
        for (int i = tid; i < 5 * 3 * 128; i += 512) { const int j = i / 384, rem = i % 384, which = rem >> 7, ch = rem & 127; CW[i] = P.conv_w[j * 3072 + which * 1024 + h * 128 + ch]; }
        WG_BAR();
        for (int k = 0; k < 8; ++k) gdn_prep_item(P, lds, bh, (it & 63) + k, (G == 256 && ride) ? k * 3 * 2048 + vcu * 8 + wave : -1, k < 7, TCH, tid, wave, lane, pmode);
    }
    asm volatile("s_waitcnt vmcnt(0)" : "+v"(TCH[0]), "+v"(TCH[1]), "+v"(TCH[2]), "+v"(TCH[3]) :: "memory");
}

template <int MODE>
__device__ __forceinline__ void store_probe(const Ptrs& P, int vcu, int wave, int lane) {
    unsigned char* junk = P.ws + ((size_t)504 << 20);
    const int q4 = lane >> 4, l16 = lane & 15;
    v4u val = {(unsigned)lane, 1u, 2u, 3u};
#pragma unroll 1
    for (int rep = 0; rep < 4; ++rep)
#pragma unroll 1
    for (int k = 0; k < 8; ++k) {
        const size_t ibase = (((size_t)((rep * 8 + k) * 256 + vcu)) * 65536) & (((size_t)64 << 20) - 1);
        asm volatile("" : "+v"(val));
        if (MODE == 1) {
#pragma unroll
            for (int j = 0; j < 8; ++j) { const int jj = (wave * 8 + j) >> 1; *(v4u*)(junk + ibase + (size_t)(jj * 16 + l16) * 128 + (j & 1) * 64 + q4 * 16) = val; }
        } else if (MODE == 2) {
#pragma unroll
            for (int j = 0; j < 8; ++j) *(v4u*)(junk + ibase + (size_t)((wave * 8 + j) * 8 + (lane >> 3)) * 128 + (lane & 7) * 16) = val;
        } else if (MODE == 3) {
#pragma unroll
            for (int j = 0; j < 16; ++j) { const int jj = (wave * 16 + j) >> 2; *(u32x2*)(junk + ibase + (size_t)(jj * 16 + l16) * 128 + (j & 3) * 32 + q4 * 8) = (u32x2){val.x, val.y}; }
        } else if (MODE == 4) {
#pragma unroll
            for (int j = 0; j < 8; ++j) { const int row = (wave * 4 + (j >> 1)) * 32 + (lane & 31); *(v4u*)(junk + ((ibase * 4) & (((size_t)64 << 20) - 1)) + (size_t)row * 2048 / 8 * 8 + (lane >> 5) * 32 + (j & 1) * 16) = val; }
        }
    }
}
constexpr int SC_SLOT = 62464, SC_W = 0, SC_Q = 16384, SC_KT = 32768, SC_QK = 49152, SC_UT = 57344, SC_EG = 61440;
constexpr int SL_ST = GTAB_OFF, SL_VN = SL_ST + 32 * GP128, SL_VS = SL_VN + 32 * GP64;
static_assert(2 * SC_SLOT <= RING_BYTES && SL_VS + 32 * GP64 <= LDS_BYTES, "scan LDS map");
#define SC_GLDS(src, dst) __builtin_amdgcn_global_load_lds((const unsigned*)(src), (LAS unsigned*)(dst), 16, 0, 0)
__device__ __forceinline__ void scan_issue(const Ptrs& P, LAS unsigned char* lds, int slot, int bh, int d, int sl, int n, int wave, int lane) {
    if (wave >= 7) return;
    const int item = bh * 64 + n, b = bh >> 3, h = bh & 7;
    const char* Wb = (const char*)(P.ws + WS_GW) + ((size_t)(d * 2048 + item) * 8192) * 2;
    const char* Qb = (const char*)(P.ws + WS_GQ) + (((size_t)b * SEQ + n * 64) * 1024 + h * 128) * 2;
    const char* KTb = (const char*)(P.ws + WS_GKT) + ((size_t)item * 8192) * 2;
    const char* QKb = (const char*)(P.ws + WS_GQK) + ((size_t)(d * 2048 + item) * 4096) * 2;
    const char* UTb = (const char*)(P.ws + WS_GUT) + ((size_t)(d * 2048 + item) * 8192 + (sl * 32) * 64) * 2;
    LAS unsigned char* sb = lds + slot * SC_SLOT;
    const int r4 = lane >> 4, s16 = lane & 15, r8 = lane >> 3, s8 = lane & 7;
#pragma unroll
    for (int i = 0; i < 9; ++i) {
        const int pc = wave + 7 * i;
        if (pc < 32) {
            const int pp = pc & 15, row = pp * 4 + r4, c = (s16 - row) & 15;
            if (pc < 16) SC_GLDS(Wb + row * 256 + c * 16, sb + SC_W + pp * 1024); else SC_GLDS(Qb + (size_t)row * 2048 + c * 16, sb + SC_Q + pp * 1024);
        } else if (pc < 60) {
            const int pp = pc < 48 ? pc - 32 : (pc < 56 ? pc - 48 : pc - 56), row = pp * 8 + r8, c = (s8 - (row >> 1)) & 7;
            const char* src = (pc < 48 ? KTb : (pc < 56 ? QKb : UTb)) + row * 128 + c * 16;
            SC_GLDS(src, sb + (pc < 48 ? SC_KT : (pc < 56 ? SC_QK : SC_UT)) + pp * 1024);
        } else if (pc == 60) { const char* EGb = (const char*)(P.ws + WS_GEG) + ((size_t)((lane & 16 ? 2 + d : d) * 2048 + item) * 64) * 4 + (lane & 15) * 16; SC_GLDS(EGb, sb + SC_EG); }
    }
}
__device__ __forceinline__ bf16x8 frag256(const LAS unsigned char* t, int row, int c) { return *(const LAS bf16x8*)(t + row * 256 + (((c + row) & 15) << 4)); }
__device__ __forceinline__ bf16x8 frag128(const LAS unsigned char* t, int row, int c) { return *(const LAS bf16x8*)(t + row * 128 + (((c + (row >> 1)) & 7) << 4)); }
template <int VAR> __device__ __forceinline__ void scan_step(f32x4 (&accS)[2], f32x4& opend, const Ptrs& P, LAS unsigned char* lds, int slot, int d, int wave, int lane) {
    const int mi = wave >> 1, nj = wave & 1, l16 = lane & 15, q4 = lane >> 4;
    const LAS unsigned char* sb = lds + slot * SC_SLOT;
    const f32x4 r_eg = *(const LAS f32x4*)(sb + SC_EG + (mi * 16 + 4 * q4) * 4), r_ek = *(const LAS f32x4*)(sb + SC_EG + 256 + (mi * 16 + 4 * q4) * 4); const float r_gl = *(const LAS float*)(sb + SC_EG + (d == 0 ? 63 : 0) * 4);
    f32x4 x = {0.f, 0.f, 0.f, 0.f}, oa = {0.f, 0.f, 0.f, 0.f};
#pragma unroll
    for (int kk = 0; kk < 4; ++kk) { const bf16x8 bs = ldfrag(lds + SL_ST, GP128, nj * 16, kk * 32, lane);
        x = __builtin_amdgcn_mfma_f32_16x16x32_bf16(frag256(sb + SC_W, mi * 16 + l16, kk * 4 + q4), bs, x, 0, 0, 0);
        oa = __builtin_amdgcn_mfma_f32_16x16x32_bf16(frag256(sb + SC_Q, mi * 16 + l16, kk * 4 + q4), bs, oa, 0, 0, 0); }
    const int ur = nj * 16 + l16;
    const u32x2 u = *(const LAS u32x2*)(sb + SC_UT + ur * 128 + (((mi * 2 + (q4 >> 1) + (ur >> 1)) & 7) << 4) + (q4 & 1) * 8);
    f32x4 vn; vn[0] = __uint_as_float(u.x << 16) - x[0]; vn[1] = __uint_as_float(u.x & 0xffff0000u) - x[1]; vn[2] = __uint_as_float(u.y << 16) - x[2]; vn[3] = __uint_as_float(u.y & 0xffff0000u) - x[3];
    const int vo = (nj * 16 + l16) * GP64 + (mi * 16 + 4 * q4) * 2;
    *(LAS u32x2*)(lds + SL_VN + vo) = (u32x2){pk2(vn[0], vn[1]), pk2(vn[2], vn[3])};
    *(LAS u32x2*)(lds + SL_VS + vo) = (u32x2){pk2(vn[0] * r_ek[0], vn[1] * r_ek[1]), pk2(vn[2] * r_ek[2], vn[3] * r_ek[3])};
    WG_BAR();
    f32x4 o = oa * r_eg;
#pragma unroll
    for (int kk = 0; kk < 2; ++kk) o = __builtin_amdgcn_mfma_f32_16x16x32_bf16(frag128(sb + SC_QK, mi * 16 + l16, kk * 4 + q4), ldfrag(lds + SL_VN, GP64, nj * 16, kk * 32, lane), o, 0, 0, 0);
    opend = o;
#pragma unroll
    for (int n2 = 0; n2 < 2; ++n2) {
        f32x4 s = accS[n2] * r_gl;
#pragma unroll
        for (int kk = 0; kk < 2; ++kk) s = __builtin_amdgcn_mfma_f32_16x16x32_bf16(frag128(sb + SC_KT, wave * 16 + l16, kk * 4 + q4), ldfrag(lds + SL_VS, GP64, n2 * 16, kk * 32, lane), s, 0, 0, 0);
        accS[n2] = s;
        *(LAS u32x2*)(lds + SL_ST + (n2 * 16 + l16) * GP128 + (wave * 16 + 4 * q4) * 2) = (u32x2){pk2(s[0], s[1]), pk2(s[2], s[3])};
    }
    if (wave < 7) asm volatile("s_waitcnt vmcnt(0)" ::: "memory");
    WG_BAR();
}
template <int VAR> __device__ __forceinline__ void scan_store(const f32x4& o, const Ptrs& P, int bh, int d, int sl, int n, int wave, int lane) {
    if constexpr (!(VAR & 2)) {
        const int b = bh >> 3, h = bh & 7, mi = wave >> 1, nj = wave & 1, l16 = lane & 15, q4 = lane >> 4;
        bf16* Og = (bf16*)(P.ws + ((VAR & 4) ? WS_MERGED : (d == 0 ? WS_OF : WS_OB))) + ((size_t)b * SEQ + n * 64 + mi * 16 + 4 * q4) * 1024 + h * 128 + sl * 32 + nj * 16 + l16;
#pragma unroll
        for (int rho = 0; rho < 4; ++rho) Og[rho * 1024] = (bf16)f2bf(o[rho]);
    }
}
__device__ __forceinline__ const char* scan_touch(const Ptrs& P, int bh, int d, int sl, int n, int j, int lane) {
    const int item = bh * 64 + n, b = bh >> 3, h = bh & 7;
    int id = j * 64 + lane; id = id < 144 ? id : 143;
    const char* p;
    if (id < 112) { const int L = 4 * id + sl;
        if (L < 128) p = (const char*)(P.ws + WS_GW) + ((size_t)(d * 2048 + item) * 8192) * 2 + L * 128;
        else if (L < 256) p = (const char*)(P.ws + WS_GKT) + ((size_t)item * 8192) * 2 + (L - 128) * 128;
        else if (L < 320) p = (const char*)(P.ws + WS_GQK) + ((size_t)(d * 2048 + item) * 4096) * 2 + (L - 256) * 128;
        else { const int idx = L - 320; p = (const char*)(P.ws + WS_GQ) + (((size_t)b * SEQ + n * 64 + (idx >> 1)) * 1024 + h * 128) * 2 + (idx & 1) * 128; }
    } else p = (const char*)(P.ws + WS_GUT) + ((size_t)(d * 2048 + item) * 8192 + (sl * 32) * 64) * 2 + (id - 112) * 128;
    return p;
}
template <int VAR> __device__ __forceinline__ void gdn_scan_phase(const Ptrs& P, LAS unsigned char* lds, int vcu, int G, int tid, int wave, int lane) {
    for (int wk = vcu; wk < 256; wk += G) {
        const int sl = wk & 3, d = (wk >> 2) & 1, bh = wk >> 3;
        __syncthreads();
        for (int i = tid; i < 32 * GP128 / 4; i += 512) ((LAS unsigned*)(lds + SL_ST))[i] = 0u;
        f32x4 accS[2] = {{0.f, 0.f, 0.f, 0.f}, {0.f, 0.f, 0.f, 0.f}};
        f32x4 opend = {0.f, 0.f, 0.f, 0.f};
#define SCN(s) (d == 0 ? (s) : 63 - (s))
#define SCT(s) ((s) + 4 < 64 ? (s) + 4 : 63)
#define TOUCH_LD(T, n_) do { if (wave == 7) { _Pragma("unroll") for (int j_ = 0; j_ < 3; ++j_) { const char* tp_ = scan_touch(P, bh, d, sl, (n_), j_, lane); asm volatile("global_load_dword %0, %1, off" : "+v"(T[j_]) : "v"(tp_) : "memory"); } } } while (0)
        unsigned T0[3] = {0u, 0u, 0u}, T1[3] = {0u, 0u, 0u}, T2[3] = {0u, 0u, 0u}, T3[3] = {0u, 0u, 0u};
        TOUCH_LD(T0, SCN(1)); TOUCH_LD(T1, SCN(2)); TOUCH_LD(T2, SCN(3));
        scan_issue(P, lds, 0, bh, d, sl, SCN(0), wave, lane);
        asm volatile("s_waitcnt vmcnt(0)" ::: "memory"); WG_BAR();
#define SC_STEP(s, T) do { if ((s) > 0) scan_store<VAR>(opend, P, bh, d, sl, SCN((s) - 1), wave, lane); \
            if (!(VAR & 1)) scan_issue(P, lds, ((s) + 1) & 1, bh, d, sl, SCN((s) + 1 < 64 ? (s) + 1 : 63), wave, lane); \
            asm volatile("" ::: "memory"); TOUCH_LD(T, SCN(SCT(s))); \
            scan_step<VAR>(accS, opend, P, lds, (s) & 1, d, wave, lane); } while (0)
#pragma unroll 1
        for (int st = 0; st < 64; st += 4) { SC_STEP(st, T3); SC_STEP(st + 1, T0); SC_STEP(st + 2, T1); SC_STEP(st + 3, T2); }
        scan_store<VAR>(opend, P, bh, d, sl, SCN(63), wave, lane);
        asm volatile("s_waitcnt vmcnt(0)" : "+v"(T0[0]), "+v"(T0[1]), "+v"(T0[2]), "+v"(T1[0]), "+v"(T1[1]), "+v"(T1[2]), "+v"(T2[0]), "+v"(T2[1]), "+v"(T2[2]), "+v"(T3[0]), "+v"(T3[1]), "+v"(T3[2]) :: "memory"); asm volatile("" :: "v"(accS[0]), "v"(accS[1]));
#undef SC_STEP
#undef TOUCH_LD
#undef SCT
#undef SCN
    }
}
__device__ __forceinline__ void gdn_out_phase(const Ptrs& P, int G, int wave, int lane) {
    const bf16* OF = (const bf16*)(P.ws + WS_OF); const bf16* OB = (const bf16*)(P.ws + WS_OB); const bf16* proj = (const bf16*)(P.ws + WS_PROJ); bf16* YAB = (bf16*)(P.ws + WS_YAB);
    float nw[16];
#pragma unroll
    for (int c = 0; c < 16; ++c) nw[c] = P.gdn_nw[(lane & 7) * 16 + c];
    for (int m = blockIdx.x * NWAVES + wave; m < M; m += G * NWAVES) {
        const v4u a0 = *(const v4u*)(OF + (size_t)m * 1024 + lane * 16), a1 = *(const v4u*)(OF + (size_t)m * 1024 + lane * 16 + 8);
        const v4u b0 = *(const v4u*)(OB + (size_t)m * 1024 + lane * 16), b1 = *(const v4u*)(OB + (size_t)m * 1024 + lane * 16 + 8);
        const v4u z0 = *(const v4u*)(proj + (size_t)m * NINP + P_ZB + lane * 16), z1 = *(const v4u*)(proj + (size_t)m * NINP + P_ZB + lane * 16 + 8);
        float v[16], z[16];
#define UNP(dst, s0, s1, op, t0, t1) dst[0] op (__uint_as_float(s0.x << 16) + __uint_as_float(t0.x << 16)); dst[1] op (__uint_as_float(s0.x & 0xffff0000u) + __uint_as_float(t0.x & 0xffff0000u)); \
        dst[2] op (__uint_as_float(s0.y << 16) + __uint_as_float(t0.y << 16)); dst[3] op (__uint_as_float(s0.y & 0xffff0000u) + __uint_as_float(t0.y & 0xffff0000u)); \
        dst[4] op (__uint_as_float(s0.z << 16) + __uint_as_float(t0.z << 16)); dst[5] op (__uint_as_float(s0.z & 0xffff0000u) + __uint_as_float(t0.z & 0xffff0000u)); \
        dst[6] op (__uint_as_float(s0.w << 16) + __uint_as_float(t0.w << 16)); dst[7] op (__uint_as_float(s0.w & 0xffff0000u) + __uint_as_float(t0.w & 0xffff0000u)); \
        dst[8] op (__uint_as_float(s1.x << 16) + __uint_as_float(t1.x << 16)); dst[9] op (__uint_as_float(s1.x & 0xffff0000u) + __uint_as_float(t1.x & 0xffff0000u)); \
        dst[10] op (__uint_as_float(s1.y << 16) + __uint_as_float(t1.y << 16)); dst[11] op (__uint_as_float(s1.y & 0xffff0000u) + __uint_as_float(t1.y & 0xffff0000u)); \
        dst[12] op (__uint_as_float(s1.z << 16) + __uint_as_float(t1.z << 16)); dst[13] op (__uint_as_float(s1.z & 0xffff0000u) + __uint_as_float(t1.z & 0xffff0000u)); \
        dst[14] op (__uint_as_float(s1.w << 16) + __uint_as_float(t1.w << 16)); dst[15] op (__uint_as_float(s1.w & 0xffff0000u) + __uint_as_float(t1.w & 0xffff0000u));
        const v4u zz = {0u, 0u, 0u, 0u};
        UNP(v, a0, a1, =, b0, b1)
        UNP(z, z0, z1, =, zz, zz)
#undef UNP
        float ss = 0.f;
#pragma unroll
        for (int c = 0; c < 16; ++c) ss += v[c] * v[c];
        ss += __shfl_xor(ss, 1); ss += __shfl_xor(ss, 2); ss += __shfl_xor(ss, 4);
        const float r = rsqrtf(ss * (1.f / 128.f) + EPS);
        float o[16];
#pragma unroll
        for (int c = 0; c < 16; ++c) o[c] = v[c] * r * nw[c] * z[c] * __builtin_amdgcn_rcpf(1.f + __expf(-z[c]));
        v4u o0, o1;
        o0.x = pk2(o[0], o[1]); o0.y = pk2(o[2], o[3]); o0.z = pk2(o[4], o[5]); o0.w = pk2(o[6], o[7]); o1.x = pk2(o[8], o[9]); o1.y = pk2(o[10], o[11]); o1.z = pk2(o[12], o[13]); o1.w = pk2(o[14], o[15]);
        *(v4u*)(YAB + (size_t)m * KAB + 512 + lane * 16) = o0; *(v4u*)(YAB + (size_t)m * KAB + 512 + lane * 16 + 8) = o1;
    }
}
__global__ void __launch_bounds__(NWAVES * 64, 2) mega_fwd(Args args) {
    extern __shared__ __attribute__((aligned(16))) unsigned char lds_raw[];
    LAS unsigned char* lds = (LAS unsigned char*)lds_raw;
    const Ptrs& P = args.p;
    const int tid = threadIdx.x, lane = tid & 63, wave = __builtin_amdgcn_readfirstlane(tid >> 6);
    const int G = gridDim.x; const int bx = blockIdx.x; const int vcu = (G % 8 == 0) ? (bx % 8) * (G / 8) + bx / 8 : bx;
    gu32* ctl = (gu32*)(P.ws + WS_CTL);
    for (int u = tid; u < (GTAB_OFF - LDSCTL_OFF) / 4; u += NWAVES * 64) ((LAS unsigned*)(lds + LDSCTL_OFF))[u] = 0u;
    __syncthreads();
    XcdBarrier bar = xcd_barrier_post((unsigned*)(ctl + CW_BAR) + args.li * XCD_BAR_WORDS, (volatile LAS unsigned*)(lds + MISC_OFF) + 8);
    const int lo = args.ph_lo, hi = args.ph_hi;
#ifndef PH_MASK
#define PH_MASK 0xffff
#endif
#define IN(k) (((PH_MASK >> (k)) & 1) && lo <= (k) && (k) < hi)
#define BOTH(k) (IN(k) && IN((k) + 1))
#ifndef PH_TWICE
#define PH_TWICE 0
#endif
#define REP(k) for (int rep_ = 0; rep_ < (((PH_TWICE >> (k)) & 1) ? 2 : 1); ++rep_)
#ifndef PH_AGAIN
#define PH_AGAIN 0
#endif
#define AGAIN(k) if ((PH_AGAIN >> (k)) & 1)
    LAS unsigned* gtab = (LAS unsigned*)(lds + GTAB_OFF);
    LAS int* etab = (LAS int*)(lds + ETAB_OFF);

    if (IN(0)) { REP(0) p0_prologue(P, lds, vcu, G, wave, lane); if (BOTH(0)) xcd_barrier(bar); }

    if (IN(1)) {
        pg8::DenseOrder S; S.so.init(M, NINP, G, bx); S.A = (const char*)(P.ws + WS_XN); S.Bt = (const char*)(P.ws + WS_WIN); S.tstep = (size_t)256 * 1024 * 2;
        pg8::EpiBf16<0> E{(pg8::bf16_t*)(P.ws + WS_PROJ), NINP, nullptr, 0, 0, 1.f};
        pg8::gemm_phase<pg8::EpiBf16<0>, pg8::DenseOrder, true, true>(lds + RING_OFF, 1024, S, E, gtab);
        AGAIN(1) pg8::gemm_phase<pg8::EpiBf16<0>, pg8::DenseOrder, true, true>(lds + RING_OFF, 1024, S, E, gtab);
        if (BOTH(1)) xcd_barrier(bar);
    }
    if (IN(2)) {
        const int pre_ = (vcu & 1) ? STAG_PRE : 1 << 30;
#pragma unroll 1
        for (int part_ = 0; part_ < 2; ++part_) {
            attn_phase(P, lds, vcu, G, wave, lane, part_ == 0 ? 0 : pre_, part_ == 0 ? pre_ : 1 << 30);
            if (part_ == 0) gdn_prep_phase(P, lds, vcu, G, tid, wave, lane, !RIDE_OFF);
        }
#if STORE_PROBE
        store_probe<STORE_PROBE>(P, vcu, wave, lane);
#endif
        AGAIN(12) gdn_prep_phase(P, lds, vcu, G, tid, wave, lane, !((PH_AGAIN >> 13) & 1), PMODE); if (BOTH(2)) xcd_barrier(bar); }
    #ifndef SCAN_PROBE
#define SCAN_PROBE 0
#endif
    if (IN(3)) { gdn_scan_phase<0>(P, lds, vcu, G, tid, wave, lane); AGAIN(3) gdn_scan_phase<0>(P, lds, vcu, G, tid, wave, lane); if (SCAN_PROBE) gdn_scan_phase<SCAN_PROBE>(P, lds, vcu, G, tid, wave, lane); if (BOTH(3)) xcd_barrier(bar); }
    if (IN(4)) { REP(4) { merge_attn(P, G, wave, lane); gdn_out_phase(P, G, wave, lane); } if (BOTH(4)) xcd_barrier(bar); }

    if (IN(5)) {
        pg8::DenseOrder S; S.so.init(M, 1024, G, bx); S.A = (const char*)(P.ws + WS_YAB); S.Bt = (const char*)(P.ws + WS_WAB); S.tstep = (size_t)256 * KAB * 2;
        pg8::EpiMerged E{(const pg8::bf16_t*)(P.ws + WS_PROJ), (pg8::bf16_t*)(P.ws + WS_MERGED), NINP, P_GA, P_GB};
        pg8::gemm_phase<pg8::EpiMerged, pg8::DenseOrder, true, true>(lds + RING_OFF, KAB, S, E, gtab);
        AGAIN(5) pg8::gemm_phase<pg8::EpiMerged, pg8::DenseOrder, true, true>(lds + RING_OFF, KAB, S, E, gtab);
        if (BOTH(5)) xcd_barrier(bar);
    }
    if (IN(6)) {
        pg8::DenseOrder S; S.so.init(M, 1024, G, bx); S.A = (const char*)(P.ws + WS_MERGED); S.Bt = (const char*)(P.ws + WS_WOUT); S.tstep = (size_t)256 * 1024 * 2;
        pg8::EpiResid E{P.x, P.out};
        pg8::gemm_phase<pg8::EpiResid, pg8::DenseOrder, true, true>(lds + RING_OFF, 1024, S, E, gtab);
        AGAIN(6) pg8::gemm_phase<pg8::EpiResid, pg8::DenseOrder, true, true>(lds + RING_OFF, 1024, S, E, gtab);
        if (BOTH(6)) xcd_barrier(bar);
    }
    if (IN(7)) { p7_router<0>(P, lds, G, tid, wave, lane); AGAIN(7) { __syncthreads(); p7_router<1>(P, lds, G, tid, wave, lane); } if (BOTH(7)) xcd_barrier(bar); }
    if (IN(8)) {
        build_etab((const unsigned*)(ctl + CW_CNT), etab, tid);
        pg8::MoeOrder<8, true> S; S.etab = etab; S.G = G; S.c = bx; S.K = 1024; S.A = (const char*)(P.ws + WS_XN); S.W = (const char*)(P.ws + WS_WGU); S.wstride = (size_t)2048 * 1024 * 2; S.list = (const int*)(P.ws + WS_LIST);
        pg8::EpiSwiglu E{(pg8::bf16_t*)(P.ws + WS_ACT), P.b_gu};
        REP(8) pg8::gemm_phase<pg8::EpiSwiglu, pg8::MoeOrder<8, true>, true, true>(lds + RING_OFF, 1024, S, E, gtab);
        if (BOTH(8)) xcd_barrier(bar);
    }
    if (IN(9)) {
        build_etab((const unsigned*)(ctl + CW_CNT), etab, tid);
        pg8::MoeOrder<4, false> S; S.etab = etab; S.G = G; S.c = bx; S.K = 1024; S.A = (const char*)(P.ws + WS_ACT); S.W = (const char*)(P.ws + WS_WD); S.wstride = (size_t)1024 * 1024 * 2; S.list = (const int*)(P.ws + WS_LIST);
        pg8::EpiDown E{(pg8::bf16_t*)(P.ws + WS_YEXP), P.b_d, (const float*)(P.ws + WS_GATEL)};
        REP(9) pg8::gemm_phase<pg8::EpiDown, pg8::MoeOrder<4, false>, true, true>(lds + RING_OFF, 1024, S, E, gtab);
        if (BOTH(9)) xcd_barrier(bar);
    }
    if (IN(10)) { p10_final<0>(P, lds, G, tid, wave, lane); AGAIN(10) { __syncthreads(); p10_final<1>(P, lds, G, tid, wave, lane); } }
#undef IN
#undef BOTH
}

extern "C" void kernel_launch(void* const* d_in, const int* in_sizes, int n_in, void* d_out, int out_size, void* d_ws, size_t ws_size, hipStream_t stream) {
    static int grid = 0;
    if (grid == 0) {
        if (n_in != 20 || out_size != M * DM || ws_size < WS_END) { fprintf(stderr, "kernel_launch: unexpected shapes (n_in %d out %d ws %zu)\n", n_in, out_size, ws_size); grid = -1; return; }
        int dev = 0, cus = 0;
        if (hipGetDevice(&dev) != hipSuccess || hipDeviceGetAttribute(&cus, hipDeviceAttributeMultiprocessorCount, dev) != hipSuccess) { grid = -1; return; }
        if (hipFuncSetAttribute((const void*)mega_fwd, hipFuncAttributeMaxDynamicSharedMemorySize, LDS_BYTES) != hipSuccess) { fprintf(stderr, "kernel_launch: hipFuncSetAttribute failed\n"); grid = -1; return; }
        (void)hipGetLastError();
        grid = cus;
    }
    if (grid < 0) return;
    (void)hipMemsetAsync((char*)d_ws + WS_CTL, 0, CTL_ZERO_BYTES, stream);
    Args a{};
    const float** pp = (const float**)&a.p;
    for (int i = 0; i < 20; ++i) pp[i] = (const float*)d_in[i];
    a.p.out = (float*)d_out; a.p.ws = (unsigned char*)d_ws;
    a.ph_lo = 0; a.ph_hi = 11; a.li = 0;
    hipLaunchKernelGGL(mega_fwd, dim3(grid), dim3(NWAVES * 64), LDS_BYTES, stream, a);
}
```

```cpp
#include <hip/hip_runtime.h>
#include <cstdint>
#include <cstdio>

constexpr int BATCH = 4, SEQ = 4096, DM = 1024, M = BATCH * SEQ;
constexpr int NIN = 7712;
constexpr int NINP = 7936;
constexpr int P_QA = 0, P_KA = 512, P_VA = 1024, P_QB = 1536, P_ZB = 4608, P_GA = 5632, P_GB = 6656, P_AF = 7680, P_AB = 7688, P_BF = 7696, P_BB = 7704;
constexpr int NE = 32, DFF = 1024;
constexpr float EPS = 1e-6f;
constexpr int KAB = 1536;
constexpr int MAXBLK = 288;


#define PREP_PROBE 0
#define RIDE_OFF 0
#define PMODE 0
#define STAG_PRE 3
#define STORE_PROBE 0
namespace pg8 {
#define PG8_LAS __attribute__((address_space(3)))
typedef unsigned short bf16_t;
typedef short bf16x8 __attribute__((ext_vector_type(8)));
typedef float f32x4 __attribute__((ext_vector_type(4)));
typedef unsigned u32x4 __attribute__((ext_vector_type(4)));
constexpr int BM = 256, BK = 64, HALF = 128, HTB = HALF * BK * 2  , STAGE_BYTES = 8 * HTB, NXCD = 8, WGM = 8;

__host__ __device__ __forceinline__ int lds_byte(int r, int c) { const int st = (r >> 4) * 2 + (c >> 5), rr = r & 15, cc = c & 31, ob = rr * 64 + cc * 2; return st * 1024 + (ob ^ (((ob >> 9) & 1) << 5)); }
__host__ __device__ __forceinline__ void stage_rc(int b, int& R, int& C) { const int st = b / 1024, sb = b % 1024, swz = sb ^ (((sb >> 9) & 1) << 5); R = (st >> 1) * 16 + swz / 64; C = (st & 1) * 32 + (swz % 64) / 2; }
__host__ __device__ __forceinline__ int perm32(int rho) { const int n = rho >> 4, i = rho & 15; return 8 * (i >> 2) + 4 * n + (i & 3); }

struct Unit { int pm, pn; };
struct Gemm { const bf16_t* A; const bf16_t* Bt; int M, N, K; };

struct StaticOrder {
    int nM, nN, nwg, G, c;
    __host__ __device__ void init(int M, int N, int G_, int c_) { nM = M / BM; nN = N / BM; nwg = nM * nN; G = G_; c = c_; }
    __host__ __device__ bool next(int i, Unit& u) const {
        const long L = (long)i * G + c; if (L >= nwg) return false;
        int wgid = (int)L; { const int q = nwg / NXCD, r = nwg % NXCD, xcd = wgid % NXCD, off = wgid / NXCD; wgid = (xcd < r ? xcd * (q + 1) : r * (q + 1) + (xcd - r) * q) + off; }
        const int nig = WGM * nN, gid = wgid / nig, fm = gid * WGM, gsz = (nM - fm) < WGM ? (nM - fm) : WGM;
        u.pm = fm + ((wgid % nig) % gsz); u.pn = (wgid % nig) / gsz; return true;
    }
    __device__ __forceinline__ void a_ready(const Unit&) const {}
    __device__ __forceinline__ void done(const Unit&) const {}
};

__device__ __forceinline__ unsigned cvt_pk_bf16(float lo, float hi) { unsigned r; asm volatile("v_cvt_pk_bf16_f32 %0, %1, %2" : "=v"(r) : "v"(lo), "v"(hi)); return r; }
typedef float f32x2 __attribute__((ext_vector_type(2)));
__device__ __forceinline__ f32x2 gelu_pk(f32x2 v) {
    const f32x2 av = __builtin_elementwise_abs(v), d = av * 0.2316418882f + 1.0f;
    f32x2 t; t.x = __builtin_amdgcn_rcpf(d.x); t.y = __builtin_amdgcn_rcpf(d.y);
    f32x2 q = t * 0.5307027145f + (-0.7265760135f); q = q * t + 0.7107068705f; q = q * t + (-0.142248368f); q = q * t + 0.127414796f; q = q * t;
    const f32x2 s = (v * v) * (-0.72134752044f);
    f32x2 e; e.x = __builtin_amdgcn_exp2f(s.x); e.y = __builtin_amdgcn_exp2f(s.y);
    const f32x2 m = v * (q * e), r = v - m;
    f32x2 o; o.x = v.x < 0.f ? m.x : r.x; o.y = v.y < 0.f ? m.y : r.y; return o;
}

template <int ACT  > struct EpiBf16 {
    static constexpr bool PERM = true, AFTER_DRAIN = false, HAS_MID = false; static_assert(ACT == 0 || ACT == 1, "EpiBf16: ACT is 0 (none) or 1 (gelu_pk)");
    bf16_t* O; int ldc; const float* bias; int split_cols; size_t split_stride; float scale0;
    __device__ __forceinline__ void operator()(const f32x4 (&acc)[2][2][4][2], const Unit& u, int wr, int wc, int fr, int fq) const {
        const int row0 = u.pm * BM + wr * 64 + fr; int colt = u.pn * BM; bf16_t* base = O;
        float sc = 1.f; if (split_cols) { const int t = colt / split_cols; base += (size_t)t * split_stride; colt -= t * split_cols; if (t == 0) sc = scale0; }
        const int col0 = colt + wc * 32 + 8 * fq, bcol0 = u.pn * BM + wc * 32 + 8 * fq;
        f32x4 bv[2][2];
#pragma unroll
        for (int bj = 0; bj < 2; ++bj)
#pragma unroll
            for (int n = 0; n < 2; ++n) bv[bj][n] = bias ? *(const f32x4*)(bias + bcol0 + bj * HALF + 4 * n) : (f32x4){0.f, 0.f, 0.f, 0.f};
#pragma unroll
        for (int ai = 0; ai < 2; ++ai)
#pragma unroll
            for (int m = 0; m < 4; ++m) { bf16_t* rowp = base + (size_t)(row0 + ai * HALF + m * 16) * ldc + col0;
#pragma unroll
                for (int bj = 0; bj < 2; ++bj) { f32x4 v0 = acc[ai][bj][m][0] + bv[bj][0], v1 = acc[ai][bj][m][1] + bv[bj][1];
                    if (ACT == 1) { f32x2 a = gelu_pk((f32x2){v0[0], v0[1]}), b = gelu_pk((f32x2){v0[2], v0[3]}), c = gelu_pk((f32x2){v1[0], v1[1]}), d = gelu_pk((f32x2){v1[2], v1[3]});
                        v0 = (f32x4){a.x, a.y, b.x, b.y}; v1 = (f32x4){c.x, c.y, d.x, d.y}; }
                    v0 = v0 * sc; v1 = v1 * sc; u32x4 w; w.x = cvt_pk_bf16(v0[0], v0[1]); w.y = cvt_pk_bf16(v0[2], v0[3]); w.z = cvt_pk_bf16(v1[0], v1[1]); w.w = cvt_pk_bf16(v1[2], v1[3]);
                    *(u32x4*)(rowp + bj * HALF) = w; } }
    }
};
__device__ __forceinline__ float bflo(unsigned w) { return __uint_as_float(w << 16); }
__device__ __forceinline__ float bfhi(unsigned w) { return __uint_as_float(w & 0xffff0000u); }
__device__ __forceinline__ float sigm(float x) { return __builtin_amdgcn_rcpf(1.0f + __expf(-fmaxf(x, -30.0f))); }

struct DenseOrder {
    typedef Unit UnitT; static constexpr bool GATHER = false;
    StaticOrder so; const char* A; const char* Bt; size_t tstep;
    __device__ __forceinline__ bool next(int i, Unit& u) const { return so.next(i, u); }
    __device__ __forceinline__ const char* ptrA(const Unit& u) const { return A + (size_t)u.pm * tstep; }
    __device__ __forceinline__ const char* ptrB(const Unit& u) const { return Bt + (size_t)u.pn * tstep; }
    __device__ __forceinline__ unsigned rowoff(const Unit&, int) const { return 0u; }
    __device__ __forceinline__ void a_ready(const Unit&) const {}
    __device__ __forceinline__ void done(const Unit&) const {}
};
struct MUnit { int pm, pn, e, j, rows, slot0; };
template <int NT, bool GATHER_> struct MoeOrder {
    typedef MUnit UnitT; static constexpr bool GATHER = GATHER_;
    const PG8_LAS int* etab; int G, c, K; const char* A; const char* W; size_t wstride; const int* list;
    __device__ __forceinline__ bool next(int i, MUnit& u) const {
        const int L = i * G + c; if (L >= etab[32] * NT) return false;
        const int blk = L / NT; int e = 0;
#pragma unroll
        for (int q = 1; q < 32; ++q) e += (etab[q] <= blk) ? 1 : 0;
        u.e = e; u.j = blk - etab[e]; u.pm = blk; u.pn = L % NT; const int left = etab[40 + e] - 256 * u.j; u.rows = left < 256 ? left : 256; u.slot0 = blk * 256; return true;
    }
    __device__ __forceinline__ const char* ptrA(const MUnit& u) const { return GATHER_ ? A : A + (size_t)u.slot0 * K * 2; }
    __device__ __forceinline__ const char* ptrB(const MUnit& u) const { return W + (size_t)u.e * wstride + (size_t)u.pn * 256 * K * 2; }
    __device__ __forceinline__ unsigned rowoff(const MUnit& u, int r) const { const int pos = u.j * 256 + r; const int tok = list[(size_t)u.e * 16384 + (pos < etab[40 + u.e] ? pos : 0)]; return (unsigned)tok * (unsigned)K * 2u; }
    __device__ __forceinline__ void a_ready(const MUnit&) const {}
    __device__ __forceinline__ void done(const MUnit&) const {}
};

struct EpiMerged {
    static constexpr bool PERM = true, AFTER_DRAIN = false, HAS_MID = true; static constexpr int TMID = 8;
    const bf16_t* proj; bf16_t* out; int ld, ga_off, gb_off;
    __device__ __forceinline__ void mid(f32x4 (&acc)[2][2][4][2], const Unit& u, int wr, int wc, int fr, int fq) const {
        int row0 = u.pm * BM + wr * 64 + fr, c0 = u.pn * BM + wc * 32 + 8 * fq;
        asm volatile("" : "+v"(row0), "+v"(c0));
#pragma unroll
        for (int ai = 0; ai < 2; ++ai)
#pragma unroll
            for (int mp = 0; mp < 2; ++mp) {
                u32x4 gav[2][2], gbv[2][2];
#pragma unroll
                for (int mm = 0; mm < 2; ++mm) { const bf16_t* rp = proj + (size_t)(row0 + ai * HALF + (2 * mp + mm) * 16) * ld + c0;
#pragma unroll
                    for (int bj = 0; bj < 2; ++bj) { gav[mm][bj] = *(const u32x4*)(rp + ga_off + bj * HALF); gbv[mm][bj] = *(const u32x4*)(rp + gb_off + bj * HALF); } }
#pragma unroll
                for (int mm = 0; mm < 2; ++mm) { const int m = 2 * mp + mm;
#pragma unroll
                    for (int bj = 0; bj < 2; ++bj) { const u32x4 ga = gav[mm][bj], gb = gbv[mm][bj];
#define EM_R(a, b) ((1.0f + __expf(-fmaxf((b), -30.0f))) * __builtin_amdgcn_rcpf(1.0f + __expf(-fmaxf((a), -30.0f))))
                        acc[ai][bj][m][0][0] *= EM_R(bflo(ga.x), bflo(gb.x)); acc[ai][bj][m][0][1] *= EM_R(bfhi(ga.x), bfhi(gb.x));
                        acc[ai][bj][m][0][2] *= EM_R(bflo(ga.y), bflo(gb.y)); acc[ai][bj][m][0][3] *= EM_R(bfhi(ga.y), bfhi(gb.y));
                        acc[ai][bj][m][1][0] *= EM_R(bflo(ga.z), bflo(gb.z)); acc[ai][bj][m][1][1] *= EM_R(bfhi(ga.z), bfhi(gb.z));
                        acc[ai][bj][m][1][2] *= EM_R(bflo(ga.w), bflo(gb.w)); acc[ai][bj][m][1][3] *= EM_R(bfhi(ga.w), bfhi(gb.w));
#undef EM_R
                    }
                    asm volatile("" : "+v"(acc[ai][0][m][0]), "+v"(acc[ai][0][m][1]), "+v"(acc[ai][1][m][0]), "+v"(acc[ai][1][m][1])); }
                asm volatile("" ::: "memory"); }
    }
    __device__ __forceinline__ void operator()(const f32x4 (&acc)[2][2][4][2], const Unit& u, int wr, int wc, int fr, int fq) const {
        const int row0 = u.pm * BM + wr * 64 + fr, c0 = u.pn * BM + wc * 32 + 8 * fq;
#pragma unroll
        for (int ai = 0; ai < 2; ++ai) {
            u32x4 gbv[4][2];
#pragma unroll
            for (int m = 0; m < 4; ++m)
#pragma unroll
                for (int bj = 0; bj < 2; ++bj) gbv[m][bj] = *(const u32x4*)(proj + (size_t)(row0 + ai * HALF + m * 16) * ld + gb_off + c0 + bj * HALF);
#pragma unroll
            for (int m = 0; m < 4; ++m) { const size_t row = (size_t)(row0 + ai * HALF + m * 16);
#pragma unroll
                for (int bj = 0; bj < 2; ++bj) { const u32x4 gb = gbv[m][bj];
                    const f32x4 v0 = acc[ai][bj][m][0], v1 = acc[ai][bj][m][1]; u32x4 w;
                    w.x = cvt_pk_bf16(v0[0] * sigm(bflo(gb.x)), v0[1] * sigm(bfhi(gb.x))); w.y = cvt_pk_bf16(v0[2] * sigm(bflo(gb.y)), v0[3] * sigm(bfhi(gb.y)));
                    w.z = cvt_pk_bf16(v1[0] * sigm(bflo(gb.z)), v1[1] * sigm(bfhi(gb.z))); w.w = cvt_pk_bf16(v1[2] * sigm(bflo(gb.w)), v1[3] * sigm(bfhi(gb.w)));
                    *(u32x4*)(out + row * 1024 + c0 + bj * HALF) = w; } }
            asm volatile("" ::: "memory"); }
    }
};
struct EpiResid {
    static constexpr bool PERM = false, AFTER_DRAIN = false, HAS_MID = false;
    const float* base; float* out;
    __device__ __forceinline__ void operator()(const f32x4 (&acc)[2][2][4][2], const Unit& u, int wr, int wc, int fr, int fq) const {
        const int row0 = u.pm * BM + wr * 64 + fr, col0 = u.pn * BM + wc * 32 + 4 * fq;
#pragma unroll
        for (int ai = 0; ai < 2; ++ai)
#pragma unroll
            for (int m = 0; m < 4; ++m) { const size_t off = (size_t)(row0 + ai * HALF + m * 16) * 1024 + col0;
#pragma unroll
                for (int bj = 0; bj < 2; ++bj)
#pragma unroll
                    for (int n = 0; n < 2; ++n) { const size_t o = off + bj * HALF + n * 16; *(f32x4*)(out + o) = *(const f32x4*)(base + o) + acc[ai][bj][m][n]; } }
    }
};
struct EpiSwiglu {
    static constexpr bool PERM = true, AFTER_DRAIN = false, HAS_MID = false;
    bf16_t* act; const float* bgu;
    __device__ __forceinline__ void operator()(const f32x4 (&acc)[2][2][4][2], const MUnit& u, int wr, int wc, int fr, int fq) const {
        const int r0 = wr * 64 + fr, j0 = u.pn * HALF + wc * 32 + 8 * fq;
        const float* bp = bgu + (size_t)u.e * 2048 + j0;
        const f32x4 bg0 = *(const f32x4*)(bp), bg1 = *(const f32x4*)(bp + 4), bl0 = *(const f32x4*)(bp + 1024), bl1 = *(const f32x4*)(bp + 1028);
#pragma unroll
        for (int ai = 0; ai < 2; ++ai)
#pragma unroll
            for (int m = 0; m < 4; ++m) { const int r = r0 + ai * HALF + m * 16;
                if (r < u.rows) {
                    const f32x4 g0 = acc[ai][0][m][0] + bg0, g1 = acc[ai][0][m][1] + bg1, l0 = acc[ai][1][m][0] + bl0, l1 = acc[ai][1][m][1] + bl1;
                    float o[8];
#pragma unroll
                    for (int i = 0; i < 4; ++i) { const float g = fminf(g0[i], 7.0f), l = fminf(fmaxf(l0[i], -7.0f), 7.0f); o[i] = g * sigm(1.702f * g) * (l + 1.0f); }
#pragma unroll
                    for (int i = 0; i < 4; ++i) { const float g = fminf(g1[i], 7.0f), l = fminf(fmaxf(l1[i], -7.0f), 7.0f); o[4 + i] = g * sigm(1.702f * g) * (l + 1.0f); }
                    u32x4 w; w.x = cvt_pk_bf16(o[0], o[1]); w.y = cvt_pk_bf16(o[2], o[3]); w.z = cvt_pk_bf16(o[4], o[5]); w.w = cvt_pk_bf16(o[6], o[7]);
                    *(u32x4*)(act + (size_t)(u.slot0 + r) * 1024 + j0) = w; } }
    }
};
struct EpiDown {
    static constexpr bool PERM = true, AFTER_DRAIN = false, HAS_MID = false;
    bf16_t* yexp; const float* bd; const float* gatel;
    __device__ __forceinline__ void operator()(const f32x4 (&acc)[2][2][4][2], const MUnit& u, int wr, int wc, int fr, int fq) const {
        const int r0 = wr * 64 + fr, c0 = u.pn * BM + wc * 32 + 8 * fq;
        f32x4 bv[2][2];
#pragma unroll
        for (int bj = 0; bj < 2; ++bj)
#pragma unroll
            for (int n = 0; n < 2; ++n) bv[bj][n] = *(const f32x4*)(bd + (size_t)u.e * 1024 + c0 + bj * HALF + 4 * n);
        float gv[2][4];
#pragma unroll
        for (int ai = 0; ai < 2; ++ai)
#pragma unroll
            for (int m = 0; m < 4; ++m) gv[ai][m] = gatel[(size_t)u.e * 16384 + u.j * 256 + r0 + ai * HALF + m * 16];
#pragma unroll
        for (int ai = 0; ai < 2; ++ai)
#pragma unroll
            for (int m = 0; m < 4; ++m) { const int r = r0 + ai * HALF + m * 16;
                if (r < u.rows) { const float g = gv[ai][m];
#pragma unroll
                    for (int bj = 0; bj < 2; ++bj) { const f32x4 v0 = (acc[ai][bj][m][0] + bv[bj][0]) * g, v1 = (acc[ai][bj][m][1] + bv[bj][1]) * g;
                        u32x4 w; w.x = cvt_pk_bf16(v0[0], v0[1]); w.y = cvt_pk_bf16(v0[2], v0[3]); w.z = cvt_pk_bf16(v1[0], v1[1]); w.w = cvt_pk_bf16(v1[2], v1[3]);
                        *(u32x4*)(yexp + (size_t)(u.slot0 + r) * 1024 + c0 + bj * HALF) = w; } } }
    }
};

template <class Epi, class Sched, bool ALIGN_EPI = false, bool SP2 = false>
__device__ __forceinline__ void gemm_phase(PG8_LAS unsigned char* lds, const int K, const Sched& S, const Epi& E, PG8_LAS unsigned* gtab) {
    const int tid = threadIdx.x, wid = __builtin_amdgcn_readfirstlane(tid >> 6), lane = tid & 63, wr = wid >> 2, wc = wid & 3, fr = lane & 15, fq = lane >> 4;
    const int nt = K / BK;
    unsigned voffA[2], voffB[2]; unsigned voffG[2][2] = {{0u, 0u}, {0u, 0u}}; int gR[2]; unsigned gC2[2];
#pragma unroll
    for (int i = 0; i < 2; ++i) { int R, C; stage_rc(tid * 16 + i * 8192, R, C); const int Rb = Epi::PERM ? ((R & ~31) + perm32(R & 31)) : R;
        gR[i] = R; gC2[i] = (unsigned)C * 2u; voffA[i] = (unsigned)(R * K + C) * 2u; voffB[i] = (unsigned)(Rb * K + C) * 2u; }
    const size_t kstep = (size_t)(BK * 2);
    const size_t hstep = (size_t)HALF * K * 2;
    const size_t tstep = 2 * hstep;
    const unsigned ldsw = (unsigned)wid * 1024u;
    const int aoff = lds_byte(wr * 64 + fr, fq * 8), boff = lds_byte(wc * 32 + fr, fq * 8);
#define PG8_SA(b, h) (((b) * 2 + (h)) * HTB)
#define PG8_SB(b, h) ((4 + (b) * 2 + (h)) * HTB)
#define PG8_STAGE(bufoff, gbase, voff) do { _Pragma("unroll") for (int _i = 0; _i < 2; ++_i) \
        __builtin_amdgcn_global_load_lds((const unsigned*)((const char*)(gbase) + (voff)[_i]), (PG8_LAS unsigned*)(lds + (bufoff) + ldsw + _i * 8192), 16, 0, 0); } while (0)
#define PG8_STAGE_A(bufoff, gbase, h) do { _Pragma("unroll") for (int _i = 0; _i < 2; ++_i) { const char* _src; \
        if constexpr (Sched::GATHER) _src = (const char*)(gbase) + voffG[h][_i]; else _src = (const char*)(gbase) + (size_t)(h) * hstep + voffA[_i]; \
        __builtin_amdgcn_global_load_lds((const unsigned*)_src, (PG8_LAS unsigned*)(lds + (bufoff) + ldsw + _i * 8192), 16, 0, 0); } } while (0)
#define PG8_LOADG(uidx) do { _Pragma("unroll") for (int _h = 0; _h < 2; ++_h) _Pragma("unroll") for (int _i = 0; _i < 2; ++_i) voffG[_h][_i] = gtab[(uidx) * 256 + _h * 128 + gR[_i]] + gC2[_i]; } while (0)
#define PG8_GSWITCH do { if constexpr (Sched::GATHER) { if (last && has_next) PG8_LOADG(ui + 1); } } while (0)
#define PG8_LDA(dst, b, h) do { _Pragma("unroll") for (int m = 0; m < 4; ++m) _Pragma("unroll") for (int k = 0; k < 2; ++k) dst[m][k] = *(const PG8_LAS bf16x8*)(lds + PG8_SA(b, h) + aoff + m * 2048 + k * 1024); } while (0)
#define PG8_LDB(dst, b, h) do { _Pragma("unroll") for (int n = 0; n < 2; ++n) _Pragma("unroll") for (int k = 0; k < 2; ++k) dst[n][k] = *(const PG8_LAS bf16x8*)(lds + PG8_SB(b, h) + boff + n * 2048 + k * 1024); } while (0)
#define PG8_MMA(ai, bj, At, Bt) do { __builtin_amdgcn_s_setprio(1); _Pragma("unroll") for (int m = 0; m < 4; ++m) _Pragma("unroll") for (int n = 0; n < 2; ++n) _Pragma("unroll") for (int k = 0; k < 2; ++k) \
        acc[ai][bj][m][n] = __builtin_amdgcn_mfma_f32_16x16x32_bf16(Bt[n][k], At[m][k], acc[ai][bj][m][n], 0, 0, 0); __builtin_amdgcn_s_setprio(0); } while (0)
#define PG8_WAIT_V(n) asm volatile("s_waitcnt vmcnt(" #n ")" ::: "memory")
#define PG8_WAIT_L(n) asm volatile("s_waitcnt lgkmcnt(" #n ")" ::: "memory")
#define PG8_BAR __builtin_amdgcn_s_barrier()
#define PG8_SCHED __builtin_amdgcn_sched_barrier(0)
    typename Sched::UnitT cur, nxt; int ui = 0;
    if (!S.next(0, cur)) return;
    f32x4 acc[2][2][4][2];
#pragma unroll
    for (int a = 0; a < 2; ++a)
#pragma unroll
        for (int b = 0; b < 2; ++b)
#pragma unroll
            for (int m = 0; m < 4; ++m)
#pragma unroll
                for (int n = 0; n < 2; ++n) acc[a][b][m][n] = (f32x4){0.f, 0.f, 0.f, 0.f};
    bf16x8 At[4][2], B0[2][2], B1[2][2];
    const char* cA = S.ptrA(cur); const char* cB = S.ptrB(cur);
    if constexpr (Sched::GATHER) {
        typename Sched::UnitT gu; for (int i = 0; S.next(i, gu); ++i) { if (tid < 256) gtab[i * 256 + tid] = S.rowoff(gu, tid); }
        asm volatile("s_waitcnt vmcnt(0) lgkmcnt(0)" ::: "memory"); __builtin_amdgcn_s_barrier(); asm volatile("" ::: "memory");
        PG8_LOADG(0);
    }
    S.a_ready(cur);
    if constexpr (SP2) {
        PG8_STAGE(PG8_SB(0, 0), cB, voffB); PG8_STAGE(PG8_SB(0, 1), cB + hstep, voffB); PG8_STAGE_A(PG8_SA(0, 0), cA, 0); PG8_STAGE_A(PG8_SA(0, 1), cA, 1);
        if (wr == 1) PG8_BAR;
        PG8_WAIT_V(2); PG8_BAR;
        PG8_STAGE(PG8_SB(1, 0), cB + kstep, voffB); PG8_STAGE_A(PG8_SA(1, 0), cA + kstep, 0); PG8_STAGE(PG8_SB(1, 1), cB + hstep + kstep, voffB);
        PG8_WAIT_V(6); PG8_BAR;
    } else {
        PG8_STAGE(PG8_SB(0, 0), cB, voffB); PG8_STAGE_A(PG8_SA(0, 0), cA, 0); PG8_STAGE(PG8_SB(0, 1), cB + hstep, voffB); PG8_STAGE_A(PG8_SA(0, 1), cA, 1);
        if (wr == 1) PG8_BAR;
        PG8_WAIT_V(4); PG8_BAR;
        PG8_STAGE(PG8_SB(1, 0), cB + kstep, voffB); PG8_STAGE_A(PG8_SA(1, 0), cA + kstep, 0); PG8_STAGE(PG8_SB(1, 1), cB + hstep + kstep, voffB);
        PG8_WAIT_V(6); PG8_BAR;
    }
    for (;;) {
        const bool has_next = S.next(ui + 1, nxt);
        const char* nA = has_next ? S.ptrA(nxt) : cA; const char* nB = has_next ? S.ptrB(nxt) : cB;
        for (int t = 0; t < nt; t += 2) {
            if constexpr (Epi::HAS_MID) { if (t == Epi::TMID) E.mid(acc, cur, wr, wc, fr, fq); }
            const bool last = (t == nt - 2);
            const char* a1 = cA + (size_t)(t + 1) * kstep;
            const char* a2 = last ? nA : cA + (size_t)(t + 2) * kstep; const char* b2 = last ? nB : cB + (size_t)(t + 2) * kstep;
            const char* a3 = a2 + kstep; const char* b3 = b2 + kstep;
            if (last && has_next) S.a_ready(nxt);
            if constexpr (SP2) {
            PG8_LDB(B0, 0, 0); PG8_LDB(B1, 0, 1); PG8_SCHED; PG8_LDA(At, 0, 0); PG8_STAGE_A(PG8_SA(1, 1), a1, 1); PG8_GSWITCH;
            PG8_WAIT_V(8); PG8_WAIT_L(0); PG8_BAR; PG8_MMA(0, 0, At, B0); PG8_MMA(0, 1, At, B1); PG8_BAR; PG8_SCHED;
            PG8_LDA(At, 0, 1); PG8_STAGE(PG8_SB(0, 0), b2, voffB); PG8_STAGE(PG8_SB(0, 1), b2 + hstep, voffB); PG8_STAGE_A(PG8_SA(0, 0), a2, 0);
            PG8_WAIT_V(8); PG8_WAIT_L(0); PG8_BAR; PG8_MMA(1, 0, At, B0); PG8_MMA(1, 1, At, B1); PG8_BAR; PG8_SCHED;
            PG8_LDB(B0, 1, 0); PG8_LDB(B1, 1, 1); PG8_SCHED; PG8_LDA(At, 1, 0); PG8_STAGE_A(PG8_SA(0, 1), a2, 1);
            PG8_WAIT_V(8); PG8_WAIT_L(0); PG8_BAR; PG8_MMA(0, 0, At, B0); PG8_MMA(0, 1, At, B1); PG8_BAR; PG8_SCHED;
            PG8_LDA(At, 1, 1); PG8_STAGE(PG8_SB(1, 0), b3, voffB); PG8_STAGE(PG8_SB(1, 1), b3 + hstep, voffB); PG8_STAGE_A(PG8_SA(1, 0), a3, 0);
            PG8_WAIT_V(8); PG8_WAIT_L(0); PG8_BAR; PG8_MMA(1, 0, At, B0); PG8_MMA(1, 1, At, B1); PG8_BAR; PG8_SCHED;
            } else {
            PG8_LDB(B0, 0, 0); PG8_SCHED; PG8_LDA(At, 0, 0); PG8_STAGE_A(PG8_SA(1, 1), a1, 1); PG8_GSWITCH;
            PG8_WAIT_L(8); PG8_BAR; PG8_WAIT_L(0); PG8_MMA(0, 0, At, B0); PG8_BAR; PG8_SCHED;
            PG8_LDB(B1, 0, 1); PG8_STAGE(PG8_SB(0, 0), b2, voffB);
            PG8_BAR; PG8_WAIT_L(0); PG8_MMA(0, 1, At, B1); PG8_BAR;
            PG8_LDA(At, 0, 1); PG8_STAGE_A(PG8_SA(0, 0), a2, 0);
            PG8_BAR; PG8_WAIT_L(0); PG8_MMA(1, 0, At, B0); PG8_BAR; PG8_SCHED;
            PG8_STAGE(PG8_SB(0, 1), b2 + hstep, voffB);
            PG8_WAIT_V(6); PG8_BAR; PG8_MMA(1, 1, At, B1); PG8_BAR;
            PG8_LDB(B0, 1, 0); PG8_SCHED; PG8_LDA(At, 1, 0); PG8_STAGE_A(PG8_SA(0, 1), a2, 1);
            PG8_WAIT_L(8); PG8_BAR; PG8_WAIT_L(0); PG8_MMA(0, 0, At, B0); PG8_BAR; PG8_SCHED;
            PG8_LDB(B1, 1, 1); PG8_STAGE(PG8_SB(1, 0), b3, voffB);
            PG8_BAR; PG8_WAIT_L(0); PG8_MMA(0, 1, At, B1); PG8_BAR;
            PG8_LDA(At, 1, 1); PG8_STAGE_A(PG8_SA(1, 0), a3, 0);
            PG8_BAR; PG8_WAIT_L(0); PG8_MMA(1, 0, At, B0); PG8_BAR; PG8_SCHED;
            PG8_STAGE(PG8_SB(1, 1), b3 + hstep, voffB);
            PG8_WAIT_V(6); PG8_BAR; PG8_MMA(1, 1, At, B1); PG8_BAR;
            }
        }
        if constexpr (ALIGN_EPI) { if (wr == 0) PG8_BAR; }
        if constexpr (!Epi::AFTER_DRAIN) { E(acc, cur, wr, wc, fr, fq); S.done(cur); }
        if (!has_next) break;
#pragma unroll
        for (int a = 0; a < 2; ++a)
#pragma unroll
            for (int b = 0; b < 2; ++b)
#pragma unroll
                for (int m = 0; m < 4; ++m)
#pragma unroll
                    for (int n = 0; n < 2; ++n) acc[a][b][m][n] = (f32x4){0.f, 0.f, 0.f, 0.f};
        cur = nxt; cA = nA; cB = nB; ++ui;
        if constexpr (ALIGN_EPI) { if (wr == 1) PG8_BAR; }
    }
    PG8_WAIT_V(0);
    if constexpr (!ALIGN_EPI) { if (wr == 0) PG8_BAR; }
    PG8_BAR;
    if constexpr (Epi::AFTER_DRAIN) { E.fused(acc, cur, wr, wc, fr, fq, lds, wid, lane); S.done(cur); }
#undef PG8_SA
#undef PG8_SB
#undef PG8_STAGE
#undef PG8_STAGE_A
#undef PG8_LOADG
#undef PG8_GSWITCH
#undef PG8_LDA
#undef PG8_LDB
#undef PG8_MMA
#undef PG8_WAIT_V
#undef PG8_WAIT_L
#undef PG8_BAR
#undef PG8_SCHED
}
}
constexpr size_t MiB = 1u << 20;
constexpr size_t WS_CTL = 0, CTL_ZERO_BYTES = 128 * 1024;
constexpr size_t WS_WIN = 2 * MiB;
constexpr size_t WS_WAB = 18 * MiB;
constexpr size_t WS_WOUT = 21 * MiB;
constexpr size_t WS_GATEL = 23 * MiB;
constexpr size_t WS_LIST = 25 * MiB;
constexpr size_t WS_ASG = 27 * MiB;
constexpr size_t WS_WGU = 32 * MiB;
constexpr size_t WS_WD = 160 * MiB;
constexpr size_t WS_XN = 224 * MiB;
constexpr size_t WS_PROJ = 256 * MiB;
constexpr size_t WS_YAB = 504 * MiB;
constexpr size_t WS_MERGED = 552 * MiB;
constexpr size_t WS_ACT = 256 * MiB;
constexpr size_t WS_GQ = 584 * MiB;
constexpr size_t WS_GKT = 616 * MiB;
constexpr size_t WS_GUT = 648 * MiB;
constexpr size_t WS_GW = 712 * MiB;
constexpr size_t WS_GQK = 776 * MiB;
constexpr size_t WS_GEG = 808 * MiB;
constexpr size_t WS_OF = 890 * MiB;
constexpr size_t WS_OB = 922 * MiB;
constexpr size_t WS_YEXP = 840 * MiB;
constexpr size_t WS_OP = 840 * MiB;
constexpr size_t WS_LSE = 888 * MiB;
constexpr size_t WS_END = 984 * MiB;
constexpr int CW_TMO = 0, CW_CODE = 1, CW_BAR = 4096, CW_CNT = 16384;
constexpr int N_BAR_REGIONS = 3;
static_assert((CW_CNT + 64) * 4 <= (int)CTL_ZERO_BYTES && (CW_BAR + 3 * 3456) * 4 <= CW_CNT * 4, "control words inside the per-call memset");

constexpr int RING_OFF = 0, RING_BYTES = 131072;
constexpr int LDSCTL_OFF = RING_BYTES, MISC_OFF = LDSCTL_OFF + 320;
constexpr int ETAB_OFF = LDSCTL_OFF + 1024;
constexpr int GTAB_OFF = LDSCTL_OFF + 2048;
constexpr int LDS_BYTES = 163840;
static_assert(GTAB_OFF + 16 * 1024 <= LDS_BYTES, "LDS map");
constexpr int NWAVES = 8;

#define GAS __attribute__((address_space(1)))
#define LAS __attribute__((address_space(3)))
typedef unsigned short bf16;
typedef unsigned v4u __attribute__((ext_vector_type(4)));
typedef float f32x4 __attribute__((ext_vector_type(4)));
typedef short bf16x8 __attribute__((ext_vector_type(8)));
typedef GAS unsigned gu32;
typedef GAS unsigned long long gu64;
#define RLX_AGENT __ATOMIC_RELAXED, __HIP_MEMORY_SCOPE_AGENT
#define LDS_WAIT() asm volatile("s_waitcnt lgkmcnt(0)" ::: "memory")
#define VM_WAIT() asm volatile("s_waitcnt vmcnt(0)" ::: "memory")
__device__ __forceinline__ unsigned long long rt() { return __builtin_amdgcn_s_memrealtime(); }
typedef float pk_f32x2_t __attribute__((ext_vector_type(2))); typedef __bf16 pk_bf16x2_t __attribute__((ext_vector_type(2)));
__device__ __forceinline__ unsigned pk2(float lo, float hi) { pk_f32x2_t v = {lo, hi}; pk_bf16x2_t b = __builtin_convertvector(v, pk_bf16x2_t); return __builtin_bit_cast(unsigned, b); }
__device__ __forceinline__ unsigned f2bf(float f) { return pk2(f, 0.f) & 0xffffu; }

#define XB_TMO      128
#define XB_XCNT(j)  (256  + 64 * (j))
#define XB_XSUB(j)  (1280 + 64 * (j))
#define XB_XGEN(j)  (2304 + 64 * (j))
#define XB_TOP      3328
#define XB_TOPGEN   3392
#define XCD_BAR_WORDS 3456
#define XB_SPIN_CAP (1u << 18)

__device__ __forceinline__ unsigned xb_ld(unsigned* p)              { return __hip_atomic_load(p, __ATOMIC_RELAXED, __HIP_MEMORY_SCOPE_AGENT); }
__device__ __forceinline__ unsigned xb_add(unsigned* p, unsigned v) { return __hip_atomic_fetch_add(p, v, __ATOMIC_RELAXED, __HIP_MEMORY_SCOPE_AGENT); }
__device__ __forceinline__ unsigned xb_xcc_id() { return (unsigned)__builtin_amdgcn_s_getreg((3 << 11) | 20) & 0xFu; }
#define XB_SPIN(cond, bar) do { unsigned _sp = 0; while (cond) { __builtin_amdgcn_s_sleep(1); \
    if ((++_sp & 255u) == 0u) { if (xb_ld(&(bar)[XB_TMO])) break; if (_sp > XB_SPIN_CAP) { atomicAdd(&(bar)[XB_TMO], 1u); break; } } } } while (0)

struct XcdBarrier {
    unsigned* bar; unsigned x;
    volatile LAS unsigned* st;
};

__device__ __forceinline__ XcdBarrier xcd_barrier_post(unsigned* bar, volatile LAS unsigned* st) {
    XcdBarrier b; b.bar = bar; b.x = xb_xcc_id(); b.st = st;
    if (threadIdx.x == 0) (void)xb_add(&bar[XB_XCNT(b.x)], 1u);
    return b;
}
__device__ __forceinline__ void xcd_barrier_complete(unsigned* bar, unsigned x, unsigned& nloc, unsigned& nx) {
    const unsigned G = gridDim.x * gridDim.y * gridDim.z;
    unsigned sum, cnt, mine, sp = 0u;
    for (;;) {
        sum = 0u; cnt = 0u; mine = 0u;
#pragma unroll
        for (unsigned j = 0; j < 16; ++j) { const unsigned c = xb_ld(&bar[XB_XCNT(j)]); sum += c; cnt += (c > 0u) ? 1u : 0u; mine = (j == x) ? c : mine; }
        if (sum == G) break;
        __builtin_amdgcn_s_sleep(1);
        if ((++sp & 255u) == 0u) { if (xb_ld(&bar[XB_TMO])) break; if (sp > XB_SPIN_CAP) { atomicAdd(&bar[XB_TMO], 1u); break; } }
    }
    nloc = mine > 0u ? mine : 1u; nx = cnt > 0u ? cnt : 1u;
}

__device__ __forceinline__ void xcd_barrier(const XcdBarrier& b) {
    asm volatile("s_waitcnt vmcnt(0)" ::: "memory");
    __syncthreads();
    if (threadIdx.x == 0) {
        unsigned* bar = b.bar;
        __builtin_amdgcn_s_waitcnt(0);
        unsigned nloc = b.st[0], nx = b.st[1];
        if (nloc == 0u) { xcd_barrier_complete(bar, b.x, nloc, nx); b.st[0] = nloc; b.st[1] = nx; }
        const unsigned old = xb_add(&bar[XB_XSUB(b.x)], 1u);
        const unsigned gen = old / nloc;
        if (old + 1u == (gen + 1u) * nloc) {
            __builtin_amdgcn_fence(__ATOMIC_RELEASE, "agent");
            asm volatile("s_waitcnt vmcnt(0)" ::: "memory");
            const unsigned og = xb_add(&bar[XB_TOP], 1u);
            const unsigned tg = og / nx;
            if (og + 1u == (tg + 1u) * nx) xb_add(&bar[XB_TOPGEN], 1u);
            else XB_SPIN(xb_ld(&bar[XB_TOPGEN]) == tg, bar);
            __builtin_amdgcn_fence(__ATOMIC_ACQUIRE, "agent");
            xb_add(&bar[XB_XGEN(b.x)], 1u);
            asm volatile("s_waitcnt vmcnt(0)" ::: "memory");
        } else {
            XB_SPIN(xb_ld(&bar[XB_XGEN(b.x)]) == gen, bar);
            __builtin_amdgcn_fence(__ATOMIC_ACQUIRE, "agent");
            asm volatile("s_waitcnt vmcnt(0)" ::: "memory");
        }
    }
    __syncthreads();
}
__device__ __forceinline__ float wave_sum(float v) {
#pragma unroll
    for (int o = 1; o < 64; o <<= 1) v += __shfl_xor(v, o);
    return v;
}
__device__ __forceinline__ float bf2f(unsigned short b) { return __uint_as_float((unsigned)b << 16); }

__device__ __forceinline__ void tr_item(const float* W, int N, bf16* WT, int pitch, int kcol0, int k0, int n0, int drow0, LAS float* scr, int lane) {
#pragma unroll 8
    for (int i = 0; i < 32; ++i) { const int kk = 2 * i + (lane >> 5); scr[kk * 33 + (lane & 31)] = W[(size_t)(k0 + kk) * N + n0 + (lane & 31)]; }
    LDS_WAIT(); asm volatile("" ::: "memory");
    const int c = lane & 7;
#pragma unroll
    for (int j = 0; j < 4; ++j) { const int n = (lane >> 3) + 8 * j; const LAS float* s = scr + (8 * c) * 33 + n;
        v4u o; o.x = pk2(s[0 * 33], s[1 * 33]); o.y = pk2(s[2 * 33], s[3 * 33]); o.z = pk2(s[4 * 33], s[5 * 33]); o.w = pk2(s[6 * 33], s[7 * 33]);
        *(GAS v4u*)(WT + (size_t)(drow0 + n) * pitch + kcol0 + k0 + 8 * c) = o; }
    LDS_WAIT(); asm volatile("" ::: "memory");
}

struct Ptrs {
    const float *x, *norm1_w, *w_in, *conv_w, *a_log_f, *a_log_b, *dtb_f, *dtb_b, *gdn_nw, *w_ba, *w_bb, *w_out, *norm2_w, *router_w, *router_b, *w_gu, *b_gu, *w_d, *b_d, *normf_w;
    float* out; unsigned char* ws;
};
struct Args { Ptrs p; int ph_lo, ph_hi, li, pad; };

__device__ __forceinline__ void p0_prologue(const Ptrs& P, LAS unsigned char* lds, int vcu, int G, int wave, int lane) {
    LAS float* scr = (LAS float*)(lds + RING_OFF + wave * 16384);
    const int gw = vcu * NWAVES + wave, NGW = G * NWAVES;
    bf16* WIN = (bf16*)(P.ws + WS_WIN); bf16* WAB = (bf16*)(P.ws + WS_WAB); bf16* WOUT = (bf16*)(P.ws + WS_WOUT); bf16* WGU = (bf16*)(P.ws + WS_WGU); bf16* WD = (bf16*)(P.ws + WS_WD);
    constexpr int I_IN = 16 * 241, I_BA = 8 * 32, I_BB = 16 * 32, I_OUT = 16 * 32, I_GU = 32 * 16 * 64, I_D = 32 * 16 * 32;
    constexpr int NITEMS = I_IN + I_BA + I_BB + I_OUT + I_GU + I_D;
    const int nitems = (G == 256 && !RIDE_OFF) ? I_IN + I_BA + I_BB + I_OUT : NITEMS;
    for (int it = gw; it < nitems; it += NGW) {
        int r = it;
        if (r < I_IN) { const int kb = r / 241, nb = r % 241, n0 = 32 * nb;
            const int d0 = n0 < 5632 ? n0 : (n0 < 5664 ? P_AF + (n0 - 5632) : P_GA + (n0 - 5664));
            tr_item(P.w_in, NIN, WIN, 1024, 0, 64 * kb, n0, d0, scr, lane); continue; } r -= I_IN;
        if (r < I_BA) { tr_item(P.w_ba, 1024, WAB, KAB, 0, 64 * (r / 32), 32 * (r % 32), 32 * (r % 32), scr, lane); continue; } r -= I_BA;
        if (r < I_BB) { tr_item(P.w_bb, 1024, WAB, KAB, 512, 64 * (r / 32), 32 * (r % 32), 32 * (r % 32), scr, lane); continue; } r -= I_BB;
        if (r < I_OUT) { tr_item(P.w_out, 1024, WOUT, 1024, 0, 64 * (r / 32), 32 * (r % 32), 32 * (r % 32), scr, lane); continue; } r -= I_OUT;
        if (r < I_GU) { const int e = r / 1024, q = r % 1024, kb = q / 64, nb = q % 64, n0 = 32 * nb;
            const int d0 = n0 < 1024 ? 256 * (n0 / 128) + (n0 % 128) : 256 * ((n0 - 1024) / 128) + 128 + ((n0 - 1024) % 128);
            tr_item(P.w_gu + (size_t)e * 1024 * 2048, 2048, WGU + (size_t)e * 2048 * 1024, 1024, 0, 64 * kb, n0, d0, scr, lane); continue; } r -= I_GU;
        { const int e = r / 512, q = r % 512;
            tr_item(P.w_d + (size_t)e * 1024 * 1024, 1024, WD + (size_t)e * 1024 * 1024, 1024, 0, 64 * (q / 32), 32 * (q % 32), 32 * (q % 32), scr, lane); }
    }
    for (int i = gw * 64 + lane; i < 224 * 1024 / 8; i += NGW * 64) ((GAS v4u*)(WIN + (size_t)7712 * 1024))[i] = (v4u){0u, 0u, 0u, 0u};
    bf16* XN = (bf16*)(P.ws + WS_XN);
    for (int m = gw; m < M; m += NGW) {
        const GAS f32x4* xr = (const GAS f32x4*)(P.x + (size_t)m * DM) + lane; const GAS f32x4* wr = (const GAS f32x4*)P.norm1_w + lane;
        f32x4 v[4]; float s = 0.f;
#pragma unroll
        for (int j = 0; j < 4; ++j) { v[j] = xr[64 * j]; s += (v[j].x * v[j].x + v[j].y * v[j].y) + (v[j].z * v[j].z + v[j].w * v[j].w); }
        const float rstd = rsqrtf(wave_sum(s) * (1.f / DM) + EPS);
        GAS unsigned long long* o8 = (GAS unsigned long long*)(XN + (size_t)m * DM) + lane;
#pragma unroll
        for (int j = 0; j < 4; ++j) { const f32x4 w = wr[64 * j]; o8[64 * j] = (unsigned long long)pk2(v[j].x * rstd * w.x, v[j].y * rstd * w.y) | ((unsigned long long)pk2(v[j].z * rstd * w.z, v[j].w * rstd * w.w) << 32); }
    }
}

__device__ __forceinline__ void build_etab(const unsigned* cnt, LAS int* etab, int tid) {
    if (tid < 32) etab[40 + tid] = (int)__hip_atomic_load(cnt + tid, __ATOMIC_RELAXED, __HIP_MEMORY_SCOPE_AGENT);
    LDS_WAIT(); __syncthreads();
    if (tid == 0) { int s = 0; for (int e = 0; e < 32; ++e) { etab[e] = s; s += (etab[40 + e] + 255) >> 8; } etab[32] = s; }
    LDS_WAIT(); __syncthreads();
}

template <int VAR> __device__ __forceinline__ void p7_router(const Ptrs& P, LAS unsigned char* lds, int G, int tid, int wave, int lane) {
    LAS float* rw = (LAS float*)(lds + RING_OFF);
    LAS int* hist = (LAS int*)(lds + ETAB_OFF);
    LAS int* asg = (LAS int*)(lds + GTAB_OFF);
    const float* X1 = P.out; bf16* H2 = (bf16*)(P.ws + (VAR ? WS_ACT : WS_XN));
    unsigned* CNT = (unsigned*)(P.ws + WS_CTL) + CW_CNT; int* LIST = (int*)(P.ws + WS_LIST); float* GATEL = (float*)(P.ws + WS_GATEL); int* ASG = (int*)(P.ws + WS_ASG);
    for (int i = tid; i < 1024 * 8; i += 512) { const int c = i >> 3, e4 = i & 7, rho = ((((c >> 8) << 2) + (c & 3)) << 6) + ((c >> 2) & 63);
        ((LAS f32x4*)rw)[rho * 8 + (e4 ^ ((rho >> 1) & 7))] = ((const GAS f32x4*)P.router_w)[i]; }
    for (int grp = blockIdx.x; grp < M / 64; grp += G) {
        const int r0 = grp * 64;
        if (tid < 64) hist[tid] = 0;
        LDS_WAIT(); __syncthreads();
#pragma unroll 1
        for (int i = 0; i < 8; i += 2) {
            const int lrow = wave * 8 + i, m = r0 + lrow;
            const GAS f32x4* wr = (const GAS f32x4*)P.norm2_w + lane;
            f32x4 va[4], vb[4]; float sa = 0.f, sb = 0.f;
            { const GAS f32x4* xa = (const GAS f32x4*)(X1 + (size_t)m * DM) + lane; const GAS f32x4* xb = (const GAS f32x4*)(X1 + (size_t)(m + 1) * DM) + lane;
#pragma unroll
              for (int j = 0; j < 4; ++j) { va[j] = xa[64 * j]; vb[j] = xb[64 * j]; }
#pragma unroll
              for (int j = 0; j < 4; ++j) { sa += (va[j].x * va[j].x + va[j].y * va[j].y) + (va[j].z * va[j].z + va[j].w * va[j].w); sb += (vb[j].x * vb[j].x + vb[j].y * vb[j].y) + (vb[j].z * vb[j].z + vb[j].w * vb[j].w); } }
            const float rsa = rsqrtf(wave_sum(sa) * (1.f / DM) + EPS), rsb = rsqrtf(wave_sum(sb) * (1.f / DM) + EPS);
            GAS unsigned long long* oa8 = (GAS unsigned long long*)(H2 + (size_t)m * DM) + lane; GAS unsigned long long* ob8 = (GAS unsigned long long*)(H2 + (size_t)(m + 1) * DM) + lane;
            float acca[32], accb[32];
#pragma unroll
            for (int e = 0; e < 32; ++e) { acca[e] = 0.f; accb[e] = 0.f; }
#pragma unroll
            for (int j = 0; j < 4; ++j) { const f32x4 w = wr[64 * j];
                va[j].x *= rsa * w.x; va[j].y *= rsa * w.y; va[j].z *= rsa * w.z; va[j].w *= rsa * w.w; vb[j].x *= rsb * w.x; vb[j].y *= rsb * w.y; vb[j].z *= rsb * w.z; vb[j].w *= rsb * w.w;
                oa8[64 * j] = (unsigned long long)pk2(va[j].x, va[j].y) | ((unsigned long long)pk2(va[j].z, va[j].w) << 32);
                ob8[64 * j] = (unsigned long long)pk2(vb[j].x, vb[j].y) | ((unsigned long long)pk2(vb[j].z, vb[j].w) << 32);
#pragma unroll
                for (int q = 0; q < 4; ++q) { const float ha = va[j][q], hb = vb[j][q]; const LAS f32x4* rp = (const LAS f32x4*)rw + ((4 * j + q) * 64 + lane) * 8; const int sw = (lane >> 1) & 7;
#pragma unroll
                    for (int e4 = 0; e4 < 8; ++e4) { const f32x4 r4 = rp[e4 ^ sw];
                        acca[4 * e4] += ha * r4.x; acca[4 * e4 + 1] += ha * r4.y; acca[4 * e4 + 2] += ha * r4.z; acca[4 * e4 + 3] += ha * r4.w;
                        accb[4 * e4] += hb * r4.x; accb[4 * e4 + 1] += hb * r4.y; accb[4 * e4 + 2] += hb * r4.z; accb[4 * e4 + 3] += hb * r4.w; } } }
            float r32[32], r16[16], r8[8], r4[4], r2[2], lg;
            { const bool hi = (lane >> 5) & 1;
#pragma unroll
              for (int q = 0; q < 32; ++q) { const float keep = hi ? accb[q] : acca[q], send = hi ? acca[q] : accb[q]; r32[q] = keep + __shfl_xor(send, 32); } }
            { const bool hi = (lane >> 4) & 1;
#pragma unroll
              for (int q = 0; q < 16; ++q) { const float keep = hi ? r32[16 + q] : r32[q], send = hi ? r32[q] : r32[16 + q]; r16[q] = keep + __shfl_xor(send, 16); } }
            { const bool hi = (lane >> 3) & 1;
#pragma unroll
              for (int q = 0; q < 8; ++q) { const float keep = hi ? r16[8 + q] : r16[q], send = hi ? r16[q] : r16[8 + q]; r8[q] = keep + __shfl_xor(send, 8); } }
            { const bool hi = (lane >> 2) & 1;
#pragma unroll
              for (int q = 0; q < 4; ++q) { const float keep = hi ? r8[4 + q] : r8[q], send = hi ? r8[q] : r8[4 + q]; r4[q] = keep + __shfl_xor(send, 4); } }
            { const bool hi = (lane >> 1) & 1;
#pragma unroll
              for (int q = 0; q < 2; ++q) { const float keep = hi ? r4[2 + q] : r4[q], send = hi ? r4[q] : r4[2 + q]; r2[q] = keep + __shfl_xor(send, 2); } }
            { const bool hi = lane & 1; const float keep = hi ? r2[1] : r2[0], send = hi ? r2[0] : r2[1]; lg = keep + __shfl_xor(send, 1); }
            const int e = lane & 31, half = lane >> 5; lg += P.router_b[e];
            float lv[4]; int li[4]; float cur = lg;
#pragma unroll
            for (int r = 0; r < 4; ++r) { float bv = cur; int bi = e;
#pragma unroll
                for (int o = 1; o < 32; o <<= 1) { const float ov = __shfl_xor(bv, o); const int oi = __shfl_xor(bi, o); if (ov > bv || (ov == bv && oi < bi)) { bv = ov; bi = oi; } }
                lv[r] = bv; li[r] = bi; if (e == bi) cur = -3.0e38f; }
            const float e1 = __expf(lv[1] - lv[0]), e2 = __expf(lv[2] - lv[0]), e3 = __expf(lv[3] - lv[0]);
            const float inv = 1.f / (1.f + e1 + e2 + e3);
            if (e < 4) {
                const float g = (e == 0 ? 1.f : e == 1 ? e1 : e == 2 ? e2 : e3) * inv;
                const int ee = e == 0 ? li[0] : e == 1 ? li[1] : e == 2 ? li[2] : li[3];
                const int rank = atomicAdd((int*)(hist + ee), 1);
                const int a = (lrow + half) * 4 + e;
                asg[a] = ee | (rank << 8); asg[256 + a] = __float_as_int(g); asg[512 + a] = (m + half) * 4 + e;
            }
        }
        LDS_WAIT(); __syncthreads();
        if (tid < 32) hist[32 + tid] = VAR ? 0 : (int)__hip_atomic_fetch_add(CNT + tid, (unsigned)hist[tid], __ATOMIC_RELAXED, __HIP_MEMORY_SCOPE_AGENT);
        LDS_WAIT(); __syncthreads();
        if (tid < 256 && !VAR) { const int w = asg[tid], ee = w & 255, pos = hist[32 + ee] + (w >> 8); const int tk = asg[512 + tid];
            LIST[(size_t)ee * M + pos] = tk >> 2; GATEL[(size_t)ee * M + pos] = __int_as_float(asg[256 + tid]); ASG[tk] = (ee << 16) | pos; }
        LDS_WAIT(); __syncthreads();
    }
}

template <int VAR> __device__ __forceinline__ void p10_final(const Ptrs& P, LAS unsigned char* lds, int G, int tid, int wave, int lane) {
    LAS int* etab = (LAS int*)(lds + ETAB_OFF);
    build_etab((const unsigned*)(P.ws + WS_CTL) + CW_CNT, etab, tid);
    const int* ASG = (const int*)(P.ws + WS_ASG); const bf16* YEXP = (const bf16*)(P.ws + WS_YEXP);
    const int gw = blockIdx.x * NWAVES + wave, NGW = G * NWAVES;
    typedef unsigned u32x2 __attribute__((ext_vector_type(2)));
    const GAS f32x4* wr = (const GAS f32x4*)P.normf_w + lane;
    for (int m0 = gw; m0 < M; m0 += 2 * NGW) {
        const int m1 = m0 + NGW < M ? m0 + NGW : m0;
        int slot[2][4];
#pragma unroll
        for (int q = 0; q < 2; ++q) { const int4 a4 = *(const int4*)(ASG + (size_t)(q ? m1 : m0) * 4);
            slot[q][0] = etab[a4.x >> 16] * 256 + (a4.x & 0xffff); slot[q][1] = etab[a4.y >> 16] * 256 + (a4.y & 0xffff); slot[q][2] = etab[a4.z >> 16] * 256 + (a4.z & 0xffff); slot[q][3] = etab[a4.w >> 16] * 256 + (a4.w & 0xffff); }
        f32x4 v[2][4]; u32x2 y[2][4][4];
#pragma unroll
        for (int q = 0; q < 2; ++q) { const GAS f32x4* xr = (const GAS f32x4*)(P.out + (size_t)(q ? m1 : m0) * DM) + lane;
#pragma unroll
            for (int j = 0; j < 4; ++j) v[q][j] = xr[64 * j];
#pragma unroll
            for (int k = 0; k < 4; ++k) { const GAS u32x2* yr = (const GAS u32x2*)(YEXP + (size_t)slot[q][k] * DM) + lane;
#pragma unroll
                for (int j = 0; j < 4; ++j) y[q][k][j] = yr[64 * j]; } }
#pragma unroll
        for (int q = 0; q < 2; ++q) {
            float s = 0.f;
#pragma unroll
            for (int j = 0; j < 4; ++j) {
#pragma unroll
                for (int k = 0; k < 4; ++k) { const u32x2 yy = y[q][k][j]; v[q][j].x += __uint_as_float(yy.x << 16); v[q][j].y += __uint_as_float(yy.x & 0xffff0000u); v[q][j].z += __uint_as_float(yy.y << 16); v[q][j].w += __uint_as_float(yy.y & 0xffff0000u); }
                s += (v[q][j].x * v[q][j].x + v[q][j].y * v[q][j].y) + (v[q][j].z * v[q][j].z + v[q][j].w * v[q][j].w); }
            const float rstd = rsqrtf(wave_sum(s) * (1.f / DM) + EPS);
            if (q == 0 || m1 != m0) { GAS f32x4* xo = (GAS f32x4*)((VAR ? (float*)(P.ws + WS_ACT) : P.out) + (size_t)(q ? m1 : m0) * DM) + lane;
#pragma unroll
                for (int j = 0; j < 4; ++j) { const f32x4 w = wr[64 * j]; xo[64 * j] = (f32x4){v[q][j].x * rstd * w.x, v[q][j].y * rstd * w.y, v[q][j].z * rstd * w.z, v[q][j].w * rstd * w.w}; } }
        }
    }
}

typedef float f32x16 __attribute__((ext_vector_type(16)));
typedef short v4i16_t __attribute__((ext_vector_type(4)));
typedef float f32x2_t __attribute__((ext_vector_type(2))); typedef __bf16 bf16x2_t __attribute__((ext_vector_type(2)));
__device__ __forceinline__ unsigned cvtpk(float lo, float hi) { f32x2_t v = {lo, hi}; bf16x2_t b = __builtin_convertvector(v, bf16x2_t); return __builtin_bit_cast(unsigned, b); }
constexpr int ATT_VPITCH = 144;
constexpr int ATT_WAVE_LDS = 32 * ATT_VPITCH;
__device__ __forceinline__ void attn_unit(const bf16* proj, bf16* OP, float* LSE, LAS unsigned char* vt, int unit, int lane) {
    const int q128 = unit & 127, p = (unit >> 7) % 3, bh = unit / 384, b = bh >> 3, h = bh & 7;
    const int r = p == 0 ? 1 : (p == 1 ? 4 : 16), gpc = 128 / r, c = q128 / gpc, g = q128 % gpc, L = SEQ / r, u0 = 32 * g;
    int lq = lane & 31, hi = lane >> 5;
    asm volatile("" : "+v"(lq), "+v"(hi));
    const bf16* base = proj + ((size_t)b * SEQ + c) * NINP + h * 64;
    const size_t ustride = (size_t)r * NINP;
    const int vrow = lane >> 3, vch = lane & 7;
    v4u qst[4], kst[5][4];
#pragma unroll
    for (int i = 0; i < 4; ++i) qst[i] = *(const v4u*)(base + (size_t)(u0 + vrow + 8 * i) * ustride + P_QA + 8 * vch);
#define ATT_KLOAD(t) do { _Pragma("unroll") for (int i = 0; i < 4; ++i) { int uk_ = u0 - 64 + 32 * (t) + vrow + 8 * i; uk_ = uk_ < 0 ? 0 : (uk_ > L - 1 ? L - 1 : uk_); kst[t][i] = *(const v4u*)(base + (size_t)uk_ * ustride + P_KA + 8 * vch); } } while (0)
    ATT_KLOAD(0); ATT_KLOAD(1); ATT_KLOAD(2);
    bf16x8 qf[4];
#pragma unroll
    for (int i = 0; i < 4; ++i) *(LAS v4u*)(vt + (vrow + 8 * i) * ATT_VPITCH + vch * 16) = qst[i];
    asm volatile("" ::: "memory");
#pragma unroll
    for (int d0 = 0; d0 < 4; ++d0) qf[d0] = *(const LAS bf16x8*)(vt + lq * ATT_VPITCH + (16 * d0 + 8 * hi) * 2);
    asm volatile("" ::: "memory");
    f32x16 sc[5];
#pragma unroll
    for (int t = 0; t < 5; ++t) {
#pragma unroll
        for (int i = 0; i < 4; ++i) *(LAS v4u*)(vt + (vrow + 8 * i) * ATT_VPITCH + vch * 16) = kst[t][i];
        asm volatile("" ::: "memory");
        if (t == 0) ATT_KLOAD(3);
        if (t == 1) ATT_KLOAD(4);
        f32x16 a = {};
#pragma unroll
        for (int d0 = 0; d0 < 4; ++d0) a = __builtin_amdgcn_mfma_f32_32x32x16_bf16(*(const LAS bf16x8*)(vt + lq * ATT_VPITCH + (16 * d0 + 8 * hi) * 2), qf[d0], a, 0, 0, 0);
        sc[t] = a;
        asm volatile("" ::: "memory");
    }
#undef ATT_KLOAD
    v4u vst[5][4];
#define ATT_VLOAD(t) do { _Pragma("unroll") for (int i = 0; i < 4; ++i) { int uk_ = u0 - 64 + 32 * (t) + vrow + 8 * i; uk_ = uk_ < 0 ? 0 : (uk_ > L - 1 ? L - 1 : uk_); vst[t][i] = *(const v4u*)(base + (size_t)uk_ * ustride + P_VA + 8 * vch); } } while (0)
    ATT_VLOAD(0); ATT_VLOAD(1);
    const float slope2 = exp2f(-(float)(h + 1)) * (float)r * 1.4426950408889634f, qs = 0.125f * 1.4426950408889634f;
    const float Df = (float)(4 * hi - lq);
    float mx = -1e30f;
#pragma unroll
    for (int t = 0; t < 5; ++t)
#pragma unroll
        for (int i = 0; i < 16; ++i) {
            const float diff = (float)(32 * t + (i & 3) + 8 * (i >> 2) - 64) + Df;
            float v = fmaf(sc[t][i], qs, -slope2 * fabsf(diff));
            if (t == 0) v = diff >= -64.f ? v : -1e30f;
            if (t == 4) v = diff <= 64.f ? v : -1e30f;
            sc[t][i] = v;
        }
    if (u0 < 64 || u0 + 96 > L) {
#pragma unroll
        for (int t = 0; t < 5; ++t)
#pragma unroll
            for (int i = 0; i < 16; ++i) { const int uk = u0 - 64 + 32 * t + (i & 3) + 8 * (i >> 2) + 4 * hi; if (uk < 0 || uk >= L) sc[t][i] = -1e30f; }
    }
#pragma unroll
    for (int t = 0; t < 5; ++t)
#pragma unroll
        for (int i = 0; i < 16; ++i) mx = fmaxf(mx, sc[t][i]);
    mx = fmaxf(mx, __shfl_xor(mx, 32));
    float l = 0.f;
#pragma unroll
    for (int t = 0; t < 5; ++t)
#pragma unroll
        for (int i = 0; i < 16; ++i) { const float e = __builtin_amdgcn_exp2f(sc[t][i] - mx); sc[t][i] = e; l += e; }
    l += __shfl_xor(l, 32);
    const float il = __builtin_amdgcn_rcpf(l);
    unsigned pf[5][2][4];
#pragma unroll
    for (int t = 0; t < 5; ++t)
#pragma unroll
        for (int s = 0; s < 2; ++s)
#pragma unroll
            for (int w = 0; w < 4; ++w) pf[t][s][w] = cvtpk(sc[t][8 * s + 2 * w], sc[t][8 * s + 2 * w + 1]);
    f32x16 o0 = {}, o1 = {};
    const int i16 = lane & 15, g16 = (lane >> 4) & 1;
    const LAS unsigned char* trb = vt + (4 * hi + (i16 >> 2)) * ATT_VPITCH + (16 * g16 + 4 * (i16 & 3)) * 2;
#pragma unroll
    for (int t = 0; t < 5; ++t) {
#pragma unroll
        for (int i = 0; i < 4; ++i) *(LAS v4u*)(vt + (vrow + 8 * i) * ATT_VPITCH + vch * 16) = vst[t][i];
        asm volatile("" ::: "memory");
        if (t == 0) ATT_VLOAD(2);
        if (t == 1) ATT_VLOAD(3);
        if (t == 2) ATT_VLOAD(4);
#pragma unroll
        for (int s = 0; s < 2; ++s) {
#pragma unroll
            for (int dt = 0; dt < 2; ++dt) {
                const LAS unsigned char* pa = trb + (16 * s) * ATT_VPITCH + dt * 64;
                const v4i16_t lo = __builtin_amdgcn_ds_read_tr16_b64_v4i16((LAS v4i16_t*)pa);
                const v4i16_t hh = __builtin_amdgcn_ds_read_tr16_b64_v4i16((LAS v4i16_t*)(pa + 8 * ATT_VPITCH));
                const bf16x8 vf = (bf16x8){lo[0], lo[1], lo[2], lo[3], hh[0], hh[1], hh[2], hh[3]};
                const v4u pw = (v4u){pf[t][s][0], pf[t][s][1], pf[t][s][2], pf[t][s][3]};
                if (dt == 0) o0 = __builtin_amdgcn_mfma_f32_32x32x16_bf16(vf, __builtin_bit_cast(bf16x8, pw), o0, 0, 0, 0);
                else o1 = __builtin_amdgcn_mfma_f32_32x32x16_bf16(vf, __builtin_bit_cast(bf16x8, pw), o1, 0, 0, 0);
            }
        }
        asm volatile("" ::: "memory");
    }
#undef ATT_VLOAD
    const size_t tok = (size_t)b * SEQ + (size_t)(u0 + lq) * r + c;
    typedef unsigned u32x2 __attribute__((ext_vector_type(2)));
#pragma unroll
    for (int qd = 0; qd < 4; ++qd) {
        *(LAS u32x2*)(vt + lq * ATT_VPITCH + (4 * hi + 8 * qd) * 2) = (u32x2){cvtpk(o0[4 * qd] * il, o0[4 * qd + 1] * il), cvtpk(o0[4 * qd + 2] * il, o0[4 * qd + 3] * il)};
        *(LAS u32x2*)(vt + lq * ATT_VPITCH + (32 + 4 * hi + 8 * qd) * 2) = (u32x2){cvtpk(o1[4 * qd] * il, o1[4 * qd + 1] * il), cvtpk(o1[4 * qd + 2] * il, o1[4 * qd + 3] * il)};
    }
    asm volatile("" ::: "memory");
#pragma unroll
    for (int i = 0; i < 4; ++i) {
        const v4u ov = *(const LAS v4u*)(vt + (vrow + 8 * i) * ATT_VPITCH + vch * 16);
        *(v4u*)(OP + ((size_t)p * M + (size_t)b * SEQ + (size_t)(u0 + vrow + 8 * i) * r + c) * 512 + h * 64 + 8 * vch) = ov;
    }
    asm volatile("" ::: "memory");
    if (hi == 0) LSE[((size_t)p * M + tok) * 8 + h] = (mx + __builtin_amdgcn_logf(l)) * 0.6931471805599453f;
}
__device__ __forceinline__ void attn_phase(const Ptrs& P, LAS unsigned char* lds, int vcu, int G, int wave, int lane, int i0 = 0, int i1 = 1 << 30) {
    const bf16* proj = (const bf16*)(P.ws + WS_PROJ); bf16* OP = (bf16*)(P.ws + WS_OP); float* LSE = (float*)(P.ws + WS_LSE);
    LAS unsigned char* vt = lds + RING_OFF + wave * ATT_WAVE_LDS;
    for (int i = i0, unit = (vcu + i0 * G) * NWAVES + wave; i < i1 && unit < BATCH * 8 * 3 * 128; ++i, unit += G * NWAVES) attn_unit(proj, OP, LSE, vt, unit, lane);
}
__device__ __forceinline__ void merge_attn(const Ptrs& P, int G, int wave, int lane) {
    const bf16* OP = (const bf16*)(P.ws + WS_OP); const float* LSE = (const float*)(P.ws + WS_LSE); bf16* YAB = (bf16*)(P.ws + WS_YAB);
    for (int m = blockIdx.x * NWAVES + wave; m < M; m += G * NWAVES) {
        const int h = lane >> 3;
        const float l0 = LSE[(size_t)m * 8 + h], l1 = LSE[((size_t)M + m) * 8 + h], l2 = LSE[((size_t)2 * M + m) * 8 + h];
        const float mx = fmaxf(l0, fmaxf(l1, l2)), e0 = __expf(l0 - mx), e1 = __expf(l1 - mx), e2 = __expf(l2 - mx), inv = 1.f / (e0 + e1 + e2);
        const float w0 = e0 * inv, w1 = e1 * inv, w2 = e2 * inv;
        const v4u a = *(const v4u*)(OP + (size_t)m * 512 + lane * 8), bb = *(const v4u*)(OP + ((size_t)M + m) * 512 + lane * 8), cc = *(const v4u*)(OP + ((size_t)2 * M + m) * 512 + lane * 8);
        v4u o;
#define MG(x) pk2(w0 * __uint_as_float(a.x << 16) + w1 * __uint_as_float(bb.x << 16) + w2 * __uint_as_float(cc.x << 16), w0 * __uint_as_float(a.x & 0xffff0000u) + w1 * __uint_as_float(bb.x & 0xffff0000u) + w2 * __uint_as_float(cc.x & 0xffff0000u))
        o.x = MG(x); o.y = MG(y); o.z = MG(z); o.w = MG(w);
#undef MG
        *(v4u*)(YAB + (size_t)m * KAB + lane * 8) = o;
    }
}
constexpr int GL_QN = 0, GL_KN = 18432, GL_KT = 36864, GL_VT = 57472;
constexpr int GTS = 2576;
__device__ __forceinline__ constexpr int gl_mat(int d, int which) { return d == 0 ? 78080 + which * 10240 : (which < 2 ? 108800 + which * 10240 : 140800); }
static_assert(GL_VT + 8 * GTS == 78080 && gl_mat(1, 1) + 10240 <= RING_BYTES && GTAB_OFF + 7680 <= 140800 && 140800 + 10240 <= LDS_BYTES, "prep LDS map");
constexpr int GP128 = 288, GP64 = 160;
__device__ __forceinline__ bf16x8 ldfrag(const LAS unsigned char* base, int pitch, int r0, int k0, int lane) { return *(const LAS bf16x8*)(base + (r0 + (lane & 15)) * pitch + (k0 + 8 * (lane >> 4)) * 2); }
typedef unsigned u32x2 __attribute__((ext_vector_type(2)));
#define WG_BAR() do { asm volatile("s_waitcnt lgkmcnt(0)" ::: "memory"); __builtin_amdgcn_s_barrier(); asm volatile("" ::: "memory"); } while (0)
__device__ __forceinline__ float softplusf_(float x) { return x > 20.f ? x : log1pf(__expf(x)); }

struct CvIn { f32x4 v[8]; };
__device__ __forceinline__ void cv_decode(int p, const Ptrs& P, const float*& W, bf16*& WT, int& N, int& k0, int& n0, int& d0) {
    if (p < 32768) { const int e = p >> 10, r = p & 1023, kb = r >> 6, nb = r & 63; N = 2048; k0 = 64 * kb; n0 = 32 * nb;
        W = P.w_gu + (size_t)e * 1024 * 2048; WT = (bf16*)(P.ws + WS_WGU) + (size_t)e * 2048 * 1024;
        d0 = n0 < 1024 ? 256 * (n0 / 128) + (n0 % 128) : 256 * ((n0 - 1024) / 128) + 128 + ((n0 - 1024) % 128);
    } else { const int pp = p - 32768, e = pp >> 9, r = pp & 511, kb = r >> 5, nb = r & 31; N = 1024; k0 = 64 * kb; n0 = 32 * nb;
        W = P.w_d + (size_t)e * 1024 * 1024; WT = (bf16*)(P.ws + WS_WD) + (size_t)e * 1024 * 1024; d0 = n0; }
}
__device__ __forceinline__ void cv_load(CvIn& C, const Ptrs& P, int p, int lane) {
    const float* W; bf16* WT; int N, k0, n0, d0; cv_decode(p, P, W, WT, N, k0, n0, d0);
    const float* src = W + (size_t)(k0 + 4 * (lane >> 3)) * N + n0 + 4 * (lane & 7);
#pragma unroll
    for (int b = 0; b < 2; ++b)
#pragma unroll
        for (int j = 0; j < 4; ++j) C.v[b * 4 + j] = *(const f32x4*)(src + (size_t)(32 * b + j) * N);
}
__device__ __forceinline__ void cv_store(const CvIn& C, const Ptrs& P, int p, int lane, LAS unsigned char* buf) {
    const float* W; bf16* WT; int N, k0, n0, d0; cv_decode(p, P, W, WT, N, k0, n0, d0);
    const int r8 = lane >> 3, c4 = lane & 7;
#pragma unroll
    for (int b = 0; b < 2; ++b)
#pragma unroll
        for (int e = 0; e < 4; ++e)
            *(LAS u32x2*)(buf + (4 * c4 + e) * 128 + 16 * (((r8 >> 1) + 4 * b) ^ c4) + 8 * (r8 & 1)) = (u32x2){pk2(C.v[b * 4][e], C.v[b * 4 + 1][e]), pk2(C.v[b * 4 + 2][e], C.v[b * 4 + 3][e])};
    asm volatile("" ::: "memory");
#pragma unroll
    for (int t = 0; t < 4; ++t) { const int n = 8 * t + r8;
        const v4u d = *(const LAS v4u*)(buf + n * 128 + 16 * (c4 ^ ((n >> 2) & 7)));
        *(v4u*)(WT + (size_t)(d0 + n) * 1024 + k0 + 8 * c4) = d; }
    asm volatile("" ::: "memory");
}
constexpr int CV_PAIRS = 49152;
__device__ __forceinline__ void st_rowmajor(LAS unsigned char* mat, const f32x4& p, int rb, int c) {
#pragma unroll
    for (int rho = 0; rho < 4; ++rho) *(LAS bf16*)(mat + (rb + rho) * GP64 + c * 2) = (bf16)f2bf(p[rho]);
}
__device__ __forceinline__ void gdn_prep_item(const Ptrs& P, LAS unsigned char* lds, int bh, int n, int cvbase, bool has_next, unsigned (&TCH)[4], int tid, int wave, int lane, int pmode = 0) {
    const bool nost = pmode & 1, nold = pmode & 2, junk = pmode & 8;
#define JNK(T, p) (junk ? (T)(P.ws + ((size_t)504 << 20) + ((size_t)((unsigned char*)(p) - P.ws) & (((size_t)64 << 20) - 1))) : (p))
    asm volatile("" : "+v"(tid), "+v"(lane));
    const int b = bh >> 3, h = bh & 7, item = bh * 64 + n; const size_t m0 = (size_t)b * SEQ + n * 64;
    const bf16* proj = (const bf16*)(P.ws + WS_PROJ);
    LAS float* SM = (LAS float*)(lds + ETAB_OFF);
    const LAS float* CW = (const LAS float*)(lds + GTAB_OFF);
    float* EG = (float*)(P.ws + WS_GEG);
    const int rp = tid >> 4, part = tid & 15;
    v4u xn[6];
#pragma unroll
    for (int i = 0; i < 6; ++i) { const int t = n * 64 + 2 * rp + i - 2; xn[i] = (v4u){0u, 0u, 0u, 0u};
        if (t >= 0 && t < SEQ && !nold) xn[i] = *(const v4u*)(proj + ((size_t)b * SEQ + t) * NINP + P_QB + h * 128 + part * 8); }
    asm volatile("" ::: "memory");
    if (wave == 0 && !(pmode & 16)) {
        const bf16* pr = proj + (m0 + lane) * NINP;
        const float gf = -__expf(P.a_log_f[h]) * softplusf_(bf2f(pr[P_AF + h]) + P.dtb_f[h]);
        const float gb = -__expf(P.a_log_b[h]) * softplusf_(bf2f(pr[P_AB + h]) + P.dtb_b[h]);
        float cf = gf, cb = gb;
#pragma unroll
        for (int o = 1; o < 64; o <<= 1) { const float t1 = __shfl_up(cf, o), t2 = __shfl_down(cb, o); if (lane >= o) cf += t1; if (lane + o < 64) cb += t2; }
        SM[lane] = cf; SM[64 + lane] = cb; SM[128 + lane] = 1.f / (1.f + __expf(-bf2f(pr[P_BF + h]))); SM[192 + lane] = 1.f / (1.f + __expf(-bf2f(pr[P_BB + h])));
        const float cfl = __shfl(cf, 63), cb0 = __shfl(cb, 0);
        if (!nost && !junk) { EG[(size_t)item * 64 + lane] = __expf(cf); EG[(size_t)(2048 + item) * 64 + lane] = __expf(cb);
        EG[(size_t)(4096 + item) * 64 + lane] = __expf(cfl - cf); EG[(size_t)(6144 + item) * 64 + lane] = __expf(cb0 - cb); }
    }
    {
        bf16* Qg = (bf16*)(P.ws + WS_GQ);
#pragma unroll
        for (int which = 0; which < 3; ++which) {
            v4u x[6];
#pragma unroll
            for (int i = 0; i < 6; ++i) x[i] = xn[i];
            asm volatile("" ::: "memory");
            if (which < 2) {
#pragma unroll
                for (int i = 0; i < 6; ++i) { const int t = n * 64 + 2 * rp + i - 2; xn[i] = (v4u){0u, 0u, 0u, 0u};
                    if (t >= 0 && t < SEQ && !nold) xn[i] = *(const v4u*)(proj + ((size_t)b * SEQ + t) * NINP + P_QB + (which + 1) * 1024 + h * 128 + part * 8); }
            }
            asm volatile("" ::: "memory");
            float a[2][8];
#pragma unroll
            for (int o = 0; o < 2; ++o)
#pragma unroll
                for (int c = 0; c < 8; ++c) a[o][c] = 0.f;
#pragma unroll
            for (int j = 0; j < 5; ++j) {
                const LAS f32x4* wp = (const LAS f32x4*)(CW + (j * 3 + which) * 128 + part * 8);
                const f32x4 w0 = wp[0], w1 = wp[1];
#pragma unroll
                for (int o = 0; o < 2; ++o) { const v4u xv = x[o + j];
                    a[o][0] += __uint_as_float(xv.x << 16) * w0.x; a[o][1] += __uint_as_float(xv.x & 0xffff0000u) * w0.y; a[o][2] += __uint_as_float(xv.y << 16) * w0.z; a[o][3] += __uint_as_float(xv.y & 0xffff0000u) * w0.w;
                    a[o][4] += __uint_as_float(xv.z << 16) * w1.x; a[o][5] += __uint_as_float(xv.z & 0xffff0000u) * w1.y; a[o][6] += __uint_as_float(xv.w << 16) * w1.z; a[o][7] += __uint_as_float(xv.w & 0xffff0000u) * w1.w; }
            }
#pragma unroll
            for (int o = 0; o < 2; ++o) {
                float ss = 0.f;
#pragma unroll
                for (int c = 0; c < 8; ++c) { a[o][c] = a[o][c] * __builtin_amdgcn_rcpf(1.f + __expf(-a[o][c])); ss += a[o][c] * a[o][c]; }
                if (which < 2) {
                    ss += __shfl_xor(ss, 1); ss += __shfl_xor(ss, 2); ss += __shfl_xor(ss, 4); ss += __shfl_xor(ss, 8);
                    const float rn = rsqrtf(ss + EPS) * (which == 0 ? 0.08838834764831845f : 1.f);
#pragma unroll
                    for (int c = 0; c < 8; ++c) a[o][c] *= rn;
                    v4u ov; ov.x = pk2(a[o][0], a[o][1]); ov.y = pk2(a[o][2], a[o][3]); ov.z = pk2(a[o][4], a[o][5]); ov.w = pk2(a[o][6], a[o][7]);
                    *(LAS v4u*)(lds + (which == 0 ? GL_QN : GL_KN) + (2 * rp + o) * GP128 + part * 16) = ov;
                    if (which == 0 && !nost) *JNK(v4u*, (v4u*)(Qg + (m0 + 2 * rp + o) * 1024 + h * 128 + part * 8)) = ov;
                }
            }
            if (which >= 1) {
                LAS unsigned char* tp = lds + (which == 1 ? GL_KT : GL_VT) + (part >> 1) * GTS + ((part & 1) * 8) * GP64 + (2 * rp) * 2;
#pragma unroll
                for (int c = 0; c < 8; ++c) *(LAS unsigned*)(tp + c * GP64) = pk2(a[0][c], a[1][c]);
            }
        }
    }
    WG_BAR();
    if (has_next && !(pmode & 4)) {
        const bf16* tp_;
        if (tid < 408) { const int row = tid / 6, seg = tid % 6; int t = (n + 1) * 64 + row - 2; t = t < 0 ? 0 : (t > SEQ - 1 ? SEQ - 1 : t);
            tp_ = proj + ((size_t)b * SEQ + t) * NINP + P_QB + (seg >> 1) * 1024 + h * 128 + (seg & 1) * 64; }
        else { const int row = tid < 472 ? tid - 408 : 0; tp_ = proj + ((size_t)b * SEQ + (n + 1) * 64 + row) * NINP + P_AF; }
        asm volatile("global_load_dword %0, %1, off" : "+v"(TCH[0]) : "v"(tp_) : "memory");
    }
    { const int dk = tid >> 2, seg = tid & 3; bf16* KTg = (bf16*)(P.ws + WS_GKT) + (size_t)item * 8192 + dk * 64 + seg * 16;
      const LAS v4u* sp = (const LAS v4u*)(lds + GL_KT + (dk >> 4) * GTS + (dk & 15) * GP64 + seg * 32); if (!nost) { *JNK(v4u*, (v4u*)KTg) = sp[0]; *JNK(v4u*, (v4u*)(KTg + 8)) = sp[1]; } }
    const int q4 = lane >> 4, l16 = lane & 15;
    f32x4 accR[2][2];
#pragma unroll 1
    for (int rep2_ = 0; rep2_ < ((PREP_PROBE & 6) ? 2 : 1); ++rep2_) {
    if (rep2_ == 1) WG_BAR();
#pragma unroll
    for (int x = 0; x < 2; ++x) {
        const int tl = 2 * wave + x, mi = tl >> 2, nj = tl & 3, c = nj * 16 + l16, rb = mi * 16 + 4 * q4;
        f32x4 g = {0.f, 0.f, 0.f, 0.f}, qk = {0.f, 0.f, 0.f, 0.f};
#pragma unroll
        for (int kk = 0; kk < 4; ++kk) {
            const bf16x8 am = ldfrag(lds + GL_KN, GP128, mi * 16, kk * 32, lane), bn = ldfrag(lds + GL_KN, GP128, nj * 16, kk * 32, lane), qn = ldfrag(lds + GL_QN, GP128, nj * 16, kk * 32, lane);
            g = __builtin_amdgcn_mfma_f32_16x16x32_bf16(am, bn, g, 0, 0, 0);
            qk = __builtin_amdgcn_mfma_f32_16x16x32_bf16(am, qn, qk, 0, 0, 0);
        }
#pragma unroll
        for (int d = 0; d < 2; ++d) {
            const float gcc = SM[64 * d + c], bc = SM[128 + 64 * d + c];
            const f32x4 gcr = *(const LAS f32x4*)(SM + 64 * d + rb), br = *(const LAS f32x4*)(SM + 128 + 64 * d + rb);
            float at[4], am2[4], qv[4];
#pragma unroll
            for (int rho = 0; rho < 4; ++rho) {
                const int rr = rb + rho;
                const bool low = d == 0 ? (rr > c) : (rr < c);
                const bool upp = d == 0 ? (c > rr) : (c < rr);
                const float e1 = __expf(fminf(gcr[rho] - gcc, 0.f)), e2 = __expf(fminf(gcc - gcr[rho], 0.f));
                at[rho] = low ? br[rho] * e1 * g[rho] : 0.f;
                am2[rho] = upp ? bc * e2 * g[rho] : 0.f;
                const bool qm = d == 0 ? (rr <= c) : (rr >= c);
                qv[rho] = qm ? e2 * qk[rho] : 0.f;
                accR[d][x][rho] = (rr == c ? 1.f : 0.f) - at[rho];
            }
            *(LAS u32x2*)(lds + gl_mat(d, 1) + c * GP64 + rb * 2) = (u32x2){pk2(at[0], at[1]), pk2(at[2], at[3])};
            *(LAS u32x2*)(lds + gl_mat(d, 0) + c * GP64 + rb * 2) = (u32x2){pk2(am2[0], am2[1]), pk2(am2[2], am2[3])};
            *(LAS u32x2*)(lds + gl_mat(d, 2) + c * GP64 + rb * 2) = (u32x2){pk2((rb == c ? 1.f : 0.f) - am2[0], (rb + 1 == c ? 1.f : 0.f) - am2[1]), pk2((rb + 2 == c ? 1.f : 0.f) - am2[2], (rb + 3 == c ? 1.f : 0.f) - am2[3])};
            bf16* qg = (bf16*)(P.ws + WS_GQK) + ((size_t)(d * 2048 + item) * 64 + c) * 64 + rb;
            if (!nost) *JNK(u32x2*, (u32x2*)qg) = (u32x2){pk2(qv[0], qv[1]), pk2(qv[2], qv[3])};
        }
    }
    WG_BAR();
    if ((PREP_PROBE & 2) && rep2_ == 0) continue;
    const int cvb = (rep2_ == ((PREP_PROBE & 6) ? 1 : 0)) ? cvbase : -1;
    CvIn CV;
#pragma unroll
    for (int j = 0; j < 8; ++j) CV.v[j] = (f32x4){0.f, 0.f, 0.f, 0.f};
    auto stage = [&](const int s) __attribute__((always_inline)) {
        f32x4 accP[2][2];
#pragma unroll
        for (int d = 0; d < 2; ++d) {
#pragma unroll
            for (int x = 0; x < 2; ++x) {
                const int tl = 2 * wave + x, mi = tl >> 2, nj = tl & 3;
                f32x4 p = {0.f, 0.f, 0.f, 0.f}; f32x4 rr = accR[d][x];
                if (d == 0 ? (mi >= nj) : (mi <= nj))
#pragma unroll
                for (int kk = 0; kk < 2; ++kk) {
                    const bf16x8 pm = ldfrag(lds + gl_mat(d, 0), GP64, mi * 16, kk * 32, lane), pt = ldfrag(lds + gl_mat(d, 1), GP64, nj * 16, kk * 32, lane), rm = ldfrag(lds + gl_mat(d, 2), GP64, mi * 16, kk * 32, lane);
                    p = __builtin_amdgcn_mfma_f32_16x16x32_bf16(pm, pt, p, 0, 0, 0);
                    rr = __builtin_amdgcn_mfma_f32_16x16x32_bf16(rm, pt, rr, 0, 0, 0);
                }
                accP[d][x] = p; if (s >= 2) accR[d][x] = rr;
            }
        }
        WG_BAR();
#pragma unroll
        for (int d = 0; d < 2; ++d) {
#pragma unroll
            for (int x = 0; x < 2; ++x) {
                const int tl = 2 * wave + x, mi = tl >> 2, nj = tl & 3, c = nj * 16 + l16, rb = mi * 16 + 4 * q4;
                if (!(d == 0 ? (mi >= nj) : (mi <= nj))) continue;
                if (s < 6) {
                    const f32x4 p = accP[d][x];
                    *(LAS u32x2*)(lds + gl_mat(d, 1) + c * GP64 + rb * 2) = (u32x2){pk2(p[0], p[1]), pk2(p[2], p[3])};
                    st_rowmajor(lds + gl_mat(d, 0), p, rb, c); st_rowmajor(lds + gl_mat(d, 2), accR[d][x], rb, c);
                } else {
                    const float bc = SM[128 + 64 * d + c], bg = bc * __expf(SM[64 * d + c]);
                    st_rowmajor(lds + gl_mat(d, 2), accR[d][x] * bc, rb, c); st_rowmajor(lds + gl_mat(d, 0), accR[d][x] * bg, rb, c);
                }
            }
        }
        WG_BAR();
    };
#pragma unroll 1
    for (int sp = 0; sp < 3; ++sp) {
        if (cvb >= 0) cv_load(CV, P, cvb + sp * 2048, lane);
        stage(2 * sp + 1); stage(2 * sp + 2);
        asm volatile("" :: "v"(CV.v[0]), "v"(CV.v[1]), "v"(CV.v[2]), "v"(CV.v[3]), "v"(CV.v[4]), "v"(CV.v[5]), "v"(CV.v[6]), "v"(CV.v[7]));
        if (cvb >= 0) cv_store(CV, P, cvb + sp * 2048, lane, lds + GL_QN + wave * 4096);
    }
    }
#pragma unroll 1
    for (int rep3_ = 0; rep3_ < ((PREP_PROBE & 8) ? 2 : 1); ++rep3_)
#pragma unroll
    for (int d = 0; d < 2; ++d) {
        bf16* UTg = (bf16*)(P.ws + WS_GUT) + (size_t)(d * 2048 + item) * 8192; bf16* Wg = (bf16*)(P.ws + WS_GW) + (size_t)(d * 2048 + item) * 8192;
#pragma unroll
        for (int xp = 0; xp < 2; ++xp) {
            unsigned ua[2][2], wa[2][2];
#pragma unroll
            for (int xx = 0; xx < 2; ++xx) {
                const int tl = wave + 8 * (2 * xp + xx);
                { const int mi = tl >> 3, nj = tl & 7;
                  f32x4 u = {0.f, 0.f, 0.f, 0.f};
#pragma unroll
                  for (int kk = 0; kk < 2; ++kk) u = __builtin_amdgcn_mfma_f32_16x16x32_bf16(ldfrag(lds + gl_mat(d, 2), GP64, mi * 16, kk * 32, lane), ldfrag(lds + GL_VT + nj * GTS, GP64, 0, kk * 32, lane), u, 0, 0, 0);
                  ua[xx][0] = pk2(u[0], u[1]); ua[xx][1] = pk2(u[2], u[3]); }
                { const int md = tl >> 2, ni = tl & 3;
                  f32x4 w = {0.f, 0.f, 0.f, 0.f};
#pragma unroll
                  for (int kk = 0; kk < 2; ++kk) w = __builtin_amdgcn_mfma_f32_16x16x32_bf16(ldfrag(lds + GL_KT + md * GTS, GP64, 0, kk * 32, lane), ldfrag(lds + gl_mat(d, 0), GP64, ni * 16, kk * 32, lane), w, 0, 0, 0);
                  wa[xx][0] = pk2(w[0], w[1]); wa[xx][1] = pk2(w[2], w[3]); }
            }
            const int odd = q4 & 1, p8 = q4 >> 1, tls = wave + 8 * (2 * xp + odd);
            { const auto r0 = __builtin_amdgcn_permlane16_swap(ua[0][0], ua[1][0], false, false), r1 = __builtin_amdgcn_permlane16_swap(ua[0][1], ua[1][1], false, false);
              const int mi = tls >> 3, nj = tls & 7;
              if (!nost) *JNK(v4u*, (v4u*)(UTg + (nj * 16 + l16) * 64 + mi * 16 + 8 * p8)) = (v4u){r0[0], r1[0], r0[1], r1[1]}; }
            { const auto r0 = __builtin_amdgcn_permlane16_swap(wa[0][0], wa[1][0], false, false), r1 = __builtin_amdgcn_permlane16_swap(wa[0][1], wa[1][1], false, false);
              const int md = tls >> 2, ni = tls & 3;
              if (!nost) *JNK(v4u*, (v4u*)(Wg + (ni * 16 + l16) * 128 + md * 16 + 8 * p8)) = (v4u){r0[0], r1[0], r0[1], r1[1]}; }
        }
    }
    WG_BAR();
}
__device__ __forceinline__ void gdn_prep_phase(const Ptrs& P, LAS unsigned char* lds, int vcu, int G, int tid, int wave, int lane, bool ride = true, int pmode = 0) {
    unsigned TCH[4] = {0u, 0u, 0u, 0u};
    for (int it = vcu * 8; it < 2048; it += G * 8) {
        const int bh = it >> 6;
        LAS float* CW = (LAS float*)(lds + GTAB_OFF); const int h = bh & 7;
        __syncthreads();
        for (int i = tid; i < 5 * 3 * 128; i += 512) { const int j = i / 384, rem = i % 384, which = rem >> 7, ch = rem & 127; CW[i] = P.conv_w[j * 3072 + which * 1024 + h * 128 + ch]; }
        WG_BAR();
        for (int k = 0; k < 8; ++k) gdn_prep_item(P, lds, bh, (it & 63) + k, (G == 256 && ride) ? k * 3 * 2048 + vcu * 8 + wave : -1, k < 7, TCH, tid, wave, lane, pmode);
    }
    asm volatile("s_waitcnt vmcnt(0)" : "+v"(TCH[0]), "+v"(TCH[1]), "+v"(TCH[2]), "+v"(TCH[3]) :: "memory");
}

template <int MODE>
__device__ __forceinline__ void store_probe(const Ptrs& P, int vcu, int wave, int lane) {
    unsigned char* junk = P.ws + ((size_t)504 << 20);
    const int q4 = lane >> 4, l16 = lane & 15;
    v4u val = {(unsigned)lane, 1u, 2u, 3u};
#pragma unroll 1
    for (int rep = 0; rep < 4; ++rep)
#pragma unroll 1
    for (int k = 0; k < 8; ++k) {
        const size_t ibase = (((size_t)((rep * 8 + k) * 256 + vcu)) * 65536) & (((size_t)64 << 20) - 1);
        asm volatile("" : "+v"(val));
        if (MODE == 1) {
#pragma unroll
            for (int j = 0; j < 8; ++j) { const int jj = (wave * 8 + j) >> 1; *(v4u*)(junk + ibase + (size_t)(jj * 16 + l16) * 128 + (j & 1) * 64 + q4 * 16) = val; }
        } else if (MODE == 2) {
#pragma unroll
            for (int j = 0; j < 8; ++j) *(v4u*)(junk + ibase + (size_t)((wave * 8 + j) * 8 + (lane >> 3)) * 128 + (lane & 7) * 16) = val;
        } else if (MODE == 3) {
#pragma unroll
            for (int j = 0; j < 16; ++j) { const int jj = (wave * 16 + j) >> 2; *(u32x2*)(junk + ibase + (size_t)(jj * 16 + l16) * 128 + (j & 3) * 32 + q4 * 8) = (u32x2){val.x, val.y}; }
        } else if (MODE == 4) {
#pragma unroll
            for (int j = 0; j < 8; ++j) { const int row = (wave * 4 + (j >> 1)) * 32 + (lane & 31); *(v4u*)(junk + ((ibase * 4) & (((size_t)64 << 20) - 1)) + (size_t)row * 2048 / 8 * 8 + (lane >> 5) * 32 + (j & 1) * 16) = val; }
        }
    }
}
constexpr int SC_SLOT = 62464, SC_W = 0, SC_Q = 16384, SC_KT = 32768, SC_QK = 49152, SC_UT = 57344, SC_EG = 61440;
constexpr int SL_ST = GTAB_OFF, SL_VN = SL_ST + 32 * GP128, SL_VS = SL_VN + 32 * GP64;
static_assert(2 * SC_SLOT <= RING_BYTES && SL_VS + 32 * GP64 <= LDS_BYTES, "scan LDS map");
#define SC_GLDS(src, dst) __builtin_amdgcn_global_load_lds((const unsigned*)(src), (LAS unsigned*)(dst), 16, 0, 0)
__device__ __forceinline__ void scan_issue(const Ptrs& P, LAS unsigned char* lds, int slot, int bh, int d, int sl, int n, int wave, int lane) {
    if (wave >= 7) return;
    const int item = bh * 64 + n, b = bh >> 3, h = bh & 7;
    const char* Wb = (const char*)(P.ws + WS_GW) + ((size_t)(d * 2048 + item) * 8192) * 2;
    const char* Qb = (const char*)(P.ws + WS_GQ) + (((size_t)b * SEQ + n * 64) * 1024 + h * 128) * 2;
    const char* KTb = (const char*)(P.ws + WS_GKT) + ((size_t)item * 8192) * 2;
    const char* QKb = (const char*)(P.ws + WS_GQK) + ((size_t)(d * 2048 + item) * 4096) * 2;
    const char* UTb = (const char*)(P.ws + WS_GUT) + ((size_t)(d * 2048 + item) * 8192 + (sl * 32) * 64) * 2;
    LAS unsigned char* sb = lds + slot * SC_SLOT;
    const int r4 = lane >> 4, s16 = lane & 15, r8 = lane >> 3, s8 = lane & 7;
#pragma unroll
    for (int i = 0; i < 9; ++i) {
        const int pc = wave + 7 * i;
        if (pc < 32) {
            const int pp = pc & 15, row = pp * 4 + r4, c = (s16 - row) & 15;
            if (pc < 16) SC_GLDS(Wb + row * 256 + c * 16, sb + SC_W + pp * 1024); else SC_GLDS(Qb + (size_t)row * 2048 + c * 16, sb + SC_Q + pp * 1024);
        } else if (pc < 60) {
            const int pp = pc < 48 ? pc - 32 : (pc < 56 ? pc - 48 : pc - 56), row = pp * 8 + r8, c = (s8 - (row >> 1)) & 7;
            const char* src = (pc < 48 ? KTb : (pc < 56 ? QKb : UTb)) + row * 128 + c * 16;
            SC_GLDS(src, sb + (pc < 48 ? SC_KT : (pc < 56 ? SC_QK : SC_UT)) + pp * 1024);
        } else if (pc == 60) { const char* EGb = (const char*)(P.ws + WS_GEG) + ((size_t)((lane & 16 ? 2 + d : d) * 2048 + item) * 64) * 4 + (lane & 15) * 16; SC_GLDS(EGb, sb + SC_EG); }
    }
}
__device__ __forceinline__ bf16x8 frag256(const LAS unsigned char* t, int row, int c) { return *(const LAS bf16x8*)(t + row * 256 + (((c + row) & 15) << 4)); }
__device__ __forceinline__ bf16x8 frag128(const LAS unsigned char* t, int row, int c) { return *(const LAS bf16x8*)(t + row * 128 + (((c + (row >> 1)) & 7) << 4)); }
template <int VAR> __device__ __forceinline__ void scan_step(f32x4 (&accS)[2], f32x4& opend, const Ptrs& P, LAS unsigned char* lds, int slot, int d, int wave, int lane) {
    const int mi = wave >> 1, nj = wave & 1, l16 = lane & 15, q4 = lane >> 4;
    const LAS unsigned char* sb = lds + slot * SC_SLOT;
    const f32x4 r_eg = *(const LAS f32x4*)(sb + SC_EG + (mi * 16 + 4 * q4) * 4), r_ek = *(const LAS f32x4*)(sb + SC_EG + 256 + (mi * 16 + 4 * q4) * 4); const float r_gl = *(const LAS float*)(sb + SC_EG + (d == 0 ? 63 : 0) * 4);
    f32x4 x = {0.f, 0.f, 0.f, 0.f}, oa = {0.f, 0.f, 0.f, 0.f};
#pragma unroll
    for (int kk = 0; kk < 4; ++kk) { const bf16x8 bs = ldfrag(lds + SL_ST, GP128, nj * 16, kk * 32, lane);
        x = __builtin_amdgcn_mfma_f32_16x16x32_bf16(frag256(sb + SC_W, mi * 16 + l16, kk * 4 + q4), bs, x, 0, 0, 0);
        oa = __builtin_amdgcn_mfma_f32_16x16x32_bf16(frag256(sb + SC_Q, mi * 16 + l16, kk * 4 + q4), bs, oa, 0, 0, 0); }
    const int ur = nj * 16 + l16;
    const u32x2 u = *(const LAS u32x2*)(sb + SC_UT + ur * 128 + (((mi * 2 + (q4 >> 1) + (ur >> 1)) & 7) << 4) + (q4 & 1) * 8);
    f32x4 vn; vn[0] = __uint_as_float(u.x << 16) - x[0]; vn[1] = __uint_as_float(u.x & 0xffff0000u) - x[1]; vn[2] = __uint_as_float(u.y << 16) - x[2]; vn[3] = __uint_as_float(u.y & 0xffff0000u) - x[3];
    const int vo = (nj * 16 + l16) * GP64 + (mi * 16 + 4 * q4) * 2;
    *(LAS u32x2*)(lds + SL_VN + vo) = (u32x2){pk2(vn[0], vn[1]), pk2(vn[2], vn[3])};
    *(LAS u32x2*)(lds + SL_VS + vo) = (u32x2){pk2(vn[0] * r_ek[0], vn[1] * r_ek[1]), pk2(vn[2] * r_ek[2], vn[3] * r_ek[3])};
    WG_BAR();
    f32x4 o = oa * r_eg;
#pragma unroll
    for (int kk = 0; kk < 2; ++kk) o = __builtin_amdgcn_mfma_f32_16x16x32_bf16(frag128(sb + SC_QK, mi * 16 + l16, kk * 4 + q4), ldfrag(lds + SL_VN, GP64, nj * 16, kk * 32, lane), o, 0, 0, 0);
    opend = o;
#pragma unroll
    for (int n2 = 0; n2 < 2; ++n2) {
        f32x4 s = accS[n2] * r_gl;
#pragma unroll
        for (int kk = 0; kk < 2; ++kk) s = __builtin_amdgcn_mfma_f32_16x16x32_bf16(frag128(sb + SC_KT, wave * 16 + l16, kk * 4 + q4), ldfrag(lds + SL_VS, GP64, n2 * 16, kk * 32, lane), s, 0, 0, 0);
        accS[n2] = s;
        *(LAS u32x2*)(lds + SL_ST + (n2 * 16 + l16) * GP128 + (wave * 16 + 4 * q4) * 2) = (u32x2){pk2(s[0], s[1]), pk2(s[2], s[3])};
    }
    if (wave < 7) asm volatile("s_waitcnt vmcnt(0)" ::: "memory");
    WG_BAR();
}
template <int VAR> __device__ __forceinline__ void scan_store(const f32x4& o, const Ptrs& P, int bh, int d, int sl, int n, int wave, int lane) {
    if constexpr (!(VAR & 2)) {
        const int b = bh >> 3, h = bh & 7, mi = wave >> 1, nj = wave & 1, l16 = lane & 15, q4 = lane >> 4;
        bf16* Og = (bf16*)(P.ws + ((VAR & 4) ? WS_MERGED : (d == 0 ? WS_OF : WS_OB))) + ((size_t)b * SEQ + n * 64 + mi * 16 + 4 * q4) * 1024 + h * 128 + sl * 32 + nj * 16 + l16;
#pragma unroll
        for (int rho = 0; rho < 4; ++rho) Og[rho * 1024] = (bf16)f2bf(o[rho]);
    }
}
__device__ __forceinline__ const char* scan_touch(const Ptrs& P, int bh, int d, int sl, int n, int j, int lane) {
    const int item = bh * 64 + n, b = bh >> 3, h = bh & 7;
    int id = j * 64 + lane; id = id < 144 ? id : 143;
    const char* p;
    if (id < 112) { const int L = 4 * id + sl;
        if (L < 128) p = (const char*)(P.ws + WS_GW) + ((size_t)(d * 2048 + item) * 8192) * 2 + L * 128;
        else if (L < 256) p = (const char*)(P.ws + WS_GKT) + ((size_t)item * 8192) * 2 + (L - 128) * 128;
        else if (L < 320) p = (const char*)(P.ws + WS_GQK) + ((size_t)(d * 2048 + item) * 4096) * 2 + (L - 256) * 128;
        else { const int idx = L - 320; p = (const char*)(P.ws + WS_GQ) + (((size_t)b * SEQ + n * 64 + (idx >> 1)) * 1024 + h * 128) * 2 + (idx & 1) * 128; }
    } else p = (const char*)(P.ws + WS_GUT) + ((size_t)(d * 2048 + item) * 8192 + (sl * 32) * 64) * 2 + (id - 112) * 128;
    return p;
}
template <int VAR> __device__ __forceinline__ void gdn_scan_phase(const Ptrs& P, LAS unsigned char* lds, int vcu, int G, int tid, int wave, int lane) {
    for (int wk = vcu; wk < 256; wk += G) {
        const int sl = wk & 3, d = (wk >> 2) & 1, bh = wk >> 3;
        __syncthreads();
        for (int i = tid; i < 32 * GP128 / 4; i += 512) ((LAS unsigned*)(lds + SL_ST))[i] = 0u;
        f32x4 accS[2] = {{0.f, 0.f, 0.f, 0.f}, {0.f, 0.f, 0.f, 0.f}};
        f32x4 opend = {0.f, 0.f, 0.f, 0.f};
#define SCN(s) (d == 0 ? (s) : 63 - (s))
#define SCT(s) ((s) + 4 < 64 ? (s) + 4 : 63)
#define TOUCH_LD(T, n_) do { if (wave == 7) { _Pragma("unroll") for (int j_ = 0; j_ < 3; ++j_) { const char* tp_ = scan_touch(P, bh, d, sl, (n_), j_, lane); asm volatile("global_load_dword %0, %1, off" : "+v"(T[j_]) : "v"(tp_) : "memory"); } } } while (0)
        unsigned T0[3] = {0u, 0u, 0u}, T1[3] = {0u, 0u, 0u}, T2[3] = {0u, 0u, 0u}, T3[3] = {0u, 0u, 0u};
        TOUCH_LD(T0, SCN(1)); TOUCH_LD(T1, SCN(2)); TOUCH_LD(T2, SCN(3));
        scan_issue(P, lds, 0, bh, d, sl, SCN(0), wave, lane);
        asm volatile("s_waitcnt vmcnt(0)" ::: "memory"); WG_BAR();
#define SC_STEP(s, T) do { if ((s) > 0) scan_store<VAR>(opend, P, bh, d, sl, SCN((s) - 1), wave, lane); \
            if (!(VAR & 1)) scan_issue(P, lds, ((s) + 1) & 1, bh, d, sl, SCN((s) + 1 < 64 ? (s) + 1 : 63), wave, lane); \
            asm volatile("" ::: "memory"); TOUCH_LD(T, SCN(SCT(s))); \
            scan_step<VAR>(accS, opend, P, lds, (s) & 1, d, wave, lane); } while (0)
#pragma unroll 1
        for (int st = 0; st < 64; st += 4) { SC_STEP(st, T3); SC_STEP(st + 1, T0); SC_STEP(st + 2, T1); SC_STEP(st + 3, T2); }
        scan_store<VAR>(opend, P, bh, d, sl, SCN(63), wave, lane);
        asm volatile("s_waitcnt vmcnt(0)" : "+v"(T0[0]), "+v"(T0[1]), "+v"(T0[2]), "+v"(T1[0]), "+v"(T1[1]), "+v"(T1[2]), "+v"(T2[0]), "+v"(T2[1]), "+v"(T2[2]), "+v"(T3[0]), "+v"(T3[1]), "+v"(T3[2]) :: "memory"); asm volatile("" :: "v"(accS[0]), "v"(accS[1]));
#undef SC_STEP
#undef TOUCH_LD
#undef SCT
#undef SCN
    }
}
__device__ __forceinline__ void gdn_out_phase(const Ptrs& P, int G, int wave, int lane) {
    const bf16* OF = (const bf16*)(P.ws + WS_OF); const bf16* OB = (const bf16*)(P.ws + WS_OB); const bf16* proj = (const bf16*)(P.ws + WS_PROJ); bf16* YAB = (bf16*)(P.ws + WS_YAB);
    float nw[16];
#pragma unroll
    for (int c = 0; c < 16; ++c) nw[c] = P.gdn_nw[(lane & 7) * 16 + c];
    for (int m = blockIdx.x * NWAVES + wave; m < M; m += G * NWAVES) {
        const v4u a0 = *(const v4u*)(OF + (size_t)m * 1024 + lane * 16), a1 = *(const v4u*)(OF + (size_t)m * 1024 + lane * 16 + 8);
        const v4u b0 = *(const v4u*)(OB + (size_t)m * 1024 + lane * 16), b1 = *(const v4u*)(OB + (size_t)m * 1024 + lane * 16 + 8);
        const v4u z0 = *(const v4u*)(proj + (size_t)m * NINP + P_ZB + lane * 16), z1 = *(const v4u*)(proj + (size_t)m * NINP + P_ZB + lane * 16 + 8);
        float v[16], z[16];
#define UNP(dst, s0, s1, op, t0, t1) dst[0] op (__uint_as_float(s0.x << 16) + __uint_as_float(t0.x << 16)); dst[1] op (__uint_as_float(s0.x & 0xffff0000u) + __uint_as_float(t0.x & 0xffff0000u)); \
        dst[2] op (__uint_as_float(s0.y << 16) + __uint_as_float(t0.y << 16)); dst[3] op (__uint_as_float(s0.y & 0xffff0000u) + __uint_as_float(t0.y & 0xffff0000u)); \
        dst[4] op (__uint_as_float(s0.z << 16) + __uint_as_float(t0.z << 16)); dst[5] op (__uint_as_float(s0.z & 0xffff0000u) + __uint_as_float(t0.z & 0xffff0000u)); \
        dst[6] op (__uint_as_float(s0.w << 16) + __uint_as_float(t0.w << 16)); dst[7] op (__uint_as_float(s0.w & 0xffff0000u) + __uint_as_float(t0.w & 0xffff0000u)); \
        dst[8] op (__uint_as_float(s1.x << 16) + __uint_as_float(t1.x << 16)); dst[9] op (__uint_as_float(s1.x & 0xffff0000u) + __uint_as_float(t1.x & 0xffff0000u)); \
        dst[10] op (__uint_as_float(s1.y << 16) + __uint_as_float(t1.y << 16)); dst[11] op (__uint_as_float(s1.y & 0xffff0000u) + __uint_as_float(t1.y & 0xffff0000u)); \
        dst[12] op (__uint_as_float(s1.z << 16) + __uint_as_float(t1.z << 16)); dst[13] op (__uint_as_float(s1.z & 0xffff0000u) + __uint_as_float(t1.z & 0xffff0000u)); \
        dst[14] op (__uint_as_float(s1.w << 16) + __uint_as_float(t1.w << 16)); dst[15] op (__uint_as_float(s1.w & 0xffff0000u) + __uint_as_float(t1.w & 0xffff0000u));
        const v4u zz = {0u, 0u, 0u, 0u};
        UNP(v, a0, a1, =, b0, b1)
        UNP(z, z0, z1, =, zz, zz)
#undef UNP
        float ss = 0.f;
#pragma unroll
        for (int c = 0; c < 16; ++c) ss += v[c] * v[c];
        ss += __shfl_xor(ss, 1); ss += __shfl_xor(ss, 2); ss += __shfl_xor(ss, 4);
        const float r = rsqrtf(ss * (1.f / 128.f) + EPS);
        float o[16];
#pragma unroll
        for (int c = 0; c < 16; ++c) o[c] = v[c] * r * nw[c] * z[c] * __builtin_amdgcn_rcpf(1.f + __expf(-z[c]));
        v4u o0, o1;
        o0.x = pk2(o[0], o[1]); o0.y = pk2(o[2], o[3]); o0.z = pk2(o[4], o[5]); o0.w = pk2(o[6], o[7]); o1.x = pk2(o[8], o[9]); o1.y = pk2(o[10], o[11]); o1.z = pk2(o[12], o[13]); o1.w = pk2(o[14], o[15]);
        *(v4u*)(YAB + (size_t)m * KAB + 512 + lane * 16) = o0; *(v4u*)(YAB + (size_t)m * KAB + 512 + lane * 16 + 8) = o1;
    }
}
__global__ void __launch_bounds__(NWAVES * 64, 2) mega_fwd(Args args) {
    extern __shared__ __attribute__((aligned(16))) unsigned char lds_raw[];
    LAS unsigned char* lds = (LAS unsigned char*)lds_raw;
    const Ptrs& P = args.p;
    const int tid = threadIdx.x, lane = tid & 63, wave = __builtin_amdgcn_readfirstlane(tid >> 6);
    const int G = gridDim.x; const int bx = blockIdx.x; const int vcu = (G % 8 == 0) ? (bx % 8) * (G / 8) + bx / 8 : bx;
    gu32* ctl = (gu32*)(P.ws + WS_CTL);
    for (int u = tid; u < (GTAB_OFF - LDSCTL_OFF) / 4; u += NWAVES * 64) ((LAS unsigned*)(lds + LDSCTL_OFF))[u] = 0u;
    __syncthreads();
    XcdBarrier bar = xcd_barrier_post((unsigned*)(ctl + CW_BAR) + args.li * XCD_BAR_WORDS, (volatile LAS unsigned*)(lds + MISC_OFF) + 8);
    const int lo = args.ph_lo, hi = args.ph_hi;
#ifndef PH_MASK
#define PH_MASK 0xffff
#endif
#define IN(k) (((PH_MASK >> (k)) & 1) && lo <= (k) && (k) < hi)
#define BOTH(k) (IN(k) && IN((k) + 1))
#ifndef PH_TWICE
#define PH_TWICE 0
#endif
#define REP(k) for (int rep_ = 0; rep_ < (((PH_TWICE >> (k)) & 1) ? 2 : 1); ++rep_)
#ifndef PH_AGAIN
#define PH_AGAIN 0
#endif
#define AGAIN(k) if ((PH_AGAIN >> (k)) & 1)
    LAS unsigned* gtab = (LAS unsigned*)(lds + GTAB_OFF);
    LAS int* etab = (LAS int*)(lds + ETAB_OFF);

    if (IN(0)) { REP(0) p0_prologue(P, lds, vcu, G, wave, lane); if (BOTH(0)) xcd_barrier(bar); }

    if (IN(1)) {
        pg8::DenseOrder S; S.so.init(M, NINP, G, bx); S.A = (const char*)(P.ws + WS_XN); S.Bt = (const char*)(P.ws + WS_WIN); S.tstep = (size_t)256 * 1024 * 2;
        pg8::EpiBf16<0> E{(pg8::bf16_t*)(P.ws + WS_PROJ), NINP, nullptr, 0, 0, 1.f};
        pg8::gemm_phase<pg8::EpiBf16<0>, pg8::DenseOrder, true, true>(lds + RING_OFF, 1024, S, E, gtab);
        AGAIN(1) pg8::gemm_phase<pg8::EpiBf16<0>, pg8::DenseOrder, true, true>(lds + RING_OFF, 1024, S, E, gtab);
        if (BOTH(1)) xcd_barrier(bar);
    }
    if (IN(2)) {
        const int pre_ = (vcu & 1) ? STAG_PRE : 1 << 30;
#pragma unroll 1
        for (int part_ = 0; part_ < 2; ++part_) {
            attn_phase(P, lds, vcu, G, wave, lane, part_ == 0 ? 0 : pre_, part_ == 0 ? pre_ : 1 << 30);
            if (part_ == 0) gdn_prep_phase(P, lds, vcu, G, tid, wave, lane, !RIDE_OFF);
        }
#if STORE_PROBE
        store_probe<STORE_PROBE>(P, vcu, wave, lane);
#endif
        AGAIN(12) gdn_prep_phase(P, lds, vcu, G, tid, wave, lane, !((PH_AGAIN >> 13) & 1), PMODE); if (BOTH(2)) xcd_barrier(bar); }
    #ifndef SCAN_PROBE
#define SCAN_PROBE 0
#endif
    if (IN(3)) { gdn_scan_phase<0>(P, lds, vcu, G, tid, wave, lane); AGAIN(3) gdn_scan_phase<0>(P, lds, vcu, G, tid, wave, lane); if (SCAN_PROBE) gdn_scan_phase<SCAN_PROBE>(P, lds, vcu, G, tid, wave, lane); if (BOTH(3)) xcd_barrier(bar); }
    if (IN(4)) { REP(4) { merge_attn(P, G, wave, lane); gdn_out_phase(P, G, wave, lane); } if (BOTH(4)) xcd_barrier(bar); }

    if (IN(5)) {
        pg8::DenseOrder S; S.so.init(M, 1024, G, bx); S.A = (const char*)(P.ws + WS_YAB); S.Bt = (const char*)(P.ws + WS_WAB); S.tstep = (size_t)256 * KAB * 2;
        pg8::EpiMerged E{(const pg8::bf16_t*)(P.ws + WS_PROJ), (pg8::bf16_t*)(P.ws + WS_MERGED), NINP, P_GA, P_GB};
        pg8::gemm_phase<pg8::EpiMerged, pg8::DenseOrder, true, true>(lds + RING_OFF, KAB, S, E, gtab);
        AGAIN(5) pg8::gemm_phase<pg8::EpiMerged, pg8::DenseOrder, true, true>(lds + RING_OFF, KAB, S, E, gtab);
        if (BOTH(5)) xcd_barrier(bar);
    }
    if (IN(6)) {
        pg8::DenseOrder S; S.so.init(M, 1024, G, bx); S.A = (const char*)(P.ws + WS_MERGED); S.Bt = (const char*)(P.ws + WS_WOUT); S.tstep = (size_t)256 * 1024 * 2;
        pg8::EpiResid E{P.x, P.out};
        pg8::gemm_phase<pg8::EpiResid, pg8::DenseOrder, true, true>(lds + RING_OFF, 1024, S, E, gtab);
        AGAIN(6) pg8::gemm_phase<pg8::EpiResid, pg8::DenseOrder, true, true>(lds + RING_OFF, 1024, S, E, gtab);
        if (BOTH(6)) xcd_barrier(bar);
    }
    if (IN(7)) { p7_router<0>(P, lds, G, tid, wave, lane); AGAIN(7) { __syncthreads(); p7_router<1>(P, lds, G, tid, wave, lane); } if (BOTH(7)) xcd_barrier(bar); }
    if (IN(8)) {
        build_etab((const unsigned*)(ctl + CW_CNT), etab, tid);
        pg8::MoeOrder<8, true> S; S.etab = etab; S.G = G; S.c = bx; S.K = 1024; S.A = (const char*)(P.ws + WS_XN); S.W = (const char*)(P.ws + WS_WGU); S.wstride = (size_t)2048 * 1024 * 2; S.list = (const int*)(P.ws + WS_LIST);
        pg8::EpiSwiglu E{(pg8::bf16_t*)(P.ws + WS_ACT), P.b_gu};
        REP(8) pg8::gemm_phase<pg8::EpiSwiglu, pg8::MoeOrder<8, true>, true, true>(lds + RING_OFF, 1024, S, E, gtab);
        if (BOTH(8)) xcd_barrier(bar);
    }
    if (IN(9)) {
        build_etab((const unsigned*)(ctl + CW_CNT), etab, tid);
        pg8::MoeOrder<4, false> S; S.etab = etab; S.G = G; S.c = bx; S.K = 1024; S.A = (const char*)(P.ws + WS_ACT); S.W = (const char*)(P.ws + WS_WD); S.wstride = (size_t)1024 * 1024 * 2; S.list = (const int*)(P.ws + WS_LIST);
        pg8::EpiDown E{(pg8::bf16_t*)(P.ws + WS_YEXP), P.b_d, (const float*)(P.ws + WS_GATEL)};
        REP(9) pg8::gemm_phase<pg8::EpiDown, pg8::MoeOrder<4, false>, true, true>(lds + RING_OFF, 1024, S, E, gtab);
        if (BOTH(9)) xcd_barrier(bar);
    }
    if (IN(10)) { p10_final<0>(P, lds, G, tid, wave, lane); AGAIN(10) { __syncthreads(); p10_final<1>(P, lds, G, tid, wave, lane); } }
#undef IN
#undef BOTH
}

extern "C" void kernel_launch(void* const* d_in, const int* in_sizes, int n_in, void* d_out, int out_size, void* d_ws, size_t ws_size, hipStream_t stream) {
    static int grid = 0;
    if (grid == 0) {
        if (n_in != 20 || out_size != M * DM || ws_size < WS_END) { fprintf(stderr, "kernel_launch: unexpected shapes (n_in %d out %d ws %zu)\n", n_in, out_size, ws_size); grid = -1; return; }
        int dev = 0, cus = 0;
        if (hipGetDevice(&dev) != hipSuccess || hipDeviceGetAttribute(&cus, hipDeviceAttributeMultiprocessorCount, dev) != hipSuccess) { grid = -1; return; }
        if (hipFuncSetAttribute((const void*)mega_fwd, hipFuncAttributeMaxDynamicSharedMemorySize, LDS_BYTES) != hipSuccess) { fprintf(stderr, "kernel_launch: hipFuncSetAttribute failed\n"); grid = -1; return; }
        (void)hipGetLastError();
        grid = cus;
    }
    if (grid < 0) return;
    (void)hipMemsetAsync((char*)d_ws + WS_CTL, 0, CTL_ZERO_BYTES, stream);
    Args a{};
    const float** pp = (const float**)&a.p;
    for (int i = 0; i < 20; ++i) pp[i] = (const float*)d_in[i];
    a.p.out = (float*)d_out; a.p.ws = (unsigned char*)d_ws;
    a.ph_lo = 0; a.ph_hi = 11; a.li = 0;
    hipLaunchKernelGGL(mega_fwd, dim3(grid), dim3(NWAVES * 64), LDS_BYTES, stream, a);
}
```

```cpp
#include <hip/hip_runtime.h>
#include <cstdint>
#include <cstdio>

constexpr int BATCH = 4, SEQ = 4096, DM = 1024, M = BATCH * SEQ;
constexpr int NIN = 7712;
constexpr int NINP = 7936;
constexpr int P_QA = 0, P_KA = 512, P_VA = 1024, P_QB = 1536, P_ZB = 4608, P_GA = 5632, P_GB = 6656, P_AF = 7680, P_AB = 7688, P_BF = 7696, P_BB = 7704;
constexpr int NE = 32, DFF = 1024;
constexpr float EPS = 1e-6f;
constexpr int KAB = 1536;
constexpr int MAXBLK = 288;


#define PREP_PROBE 0
#define RIDE_OFF 0
#define PMODE 0
#define STAG_PRE 3
#define STORE_PROBE 0
namespace pg8 {
#define PG8_LAS __attribute__((address_space(3)))
typedef unsigned short bf16_t;
typedef short bf16x8 __attribute__((ext_vector_type(8)));
typedef float f32x4 __attribute__((ext_vector_type(4)));
typedef unsigned u32x4 __attribute__((ext_vector_type(4)));
constexpr int BM = 256, BK = 64, HALF = 128, HTB = HALF * BK * 2  , STAGE_BYTES = 8 * HTB, NXCD = 8, WGM = 8;

__host__ __device__ __forceinline__ int lds_byte(int r, int c) { const int st = (r >> 4) * 2 + (c >> 5), rr = r & 15, cc = c & 31, ob = rr * 64 + cc * 2; return st * 1024 + (ob ^ (((ob >> 9) & 1) << 5)); }
__host__ __device__ __forceinline__ void stage_rc(int b, int& R, int& C) { const int st = b / 1024, sb = b % 1024, swz = sb ^ (((sb >> 9) & 1) << 5); R = (st >> 1) * 16 + swz / 64; C = (st & 1) * 32 + (swz % 64) / 2; }
__host__ __device__ __forceinline__ int perm32(int rho) { const int n = rho >> 4, i = rho & 15; return 8 * (i >> 2) + 4 * n + (i & 3); }

struct Unit { int pm, pn; };
struct Gemm { const bf16_t* A; const bf16_t* Bt; int M, N, K; };

struct StaticOrder {
    int nM, nN, nwg, G, c;
    __host__ __device__ void init(int M, int N, int G_, int c_) { nM = M / BM; nN = N / BM; nwg = nM * nN; G = G_; c = c_; }
    __host__ __device__ bool next(int i, Unit& u) const {
        const long L = (long)i * G + c; if (L >= nwg) return false;
        int wgid = (int)L; { const int q = nwg / NXCD, r = nwg % NXCD, xcd = wgid % NXCD, off = wgid / NXCD; wgid = (xcd < r ? xcd * (q + 1) : r * (q + 1) + (xcd - r) * q) + off; }
        const int nig = WGM * nN, gid = wgid / nig, fm = gid * WGM, gsz = (nM - fm) < WGM ? (nM - fm) : WGM;
        u.pm = fm + ((wgid % nig) % gsz); u.pn = (wgid % nig) / gsz; return true;
    }
    __device__ __forceinline__ void a_ready(const Unit&) const {}
    __device__ __forceinline__ void done(const Unit&) const {}
};

__device__ __forceinline__ unsigned cvt_pk_bf16(float lo, float hi) { unsigned r; asm volatile("v_cvt_pk_bf16_f32 %0, %1, %2" : "=v"(r) : "v"(lo), "v"(hi)); return r; }
typedef float f32x2 __attribute__((ext_vector_type(2)));
__device__ __forceinline__ f32x2 gelu_pk(f32x2 v) {
    const f32x2 av = __builtin_elementwise_abs(v), d = av * 0.2316418882f + 1.0f;
    f32x2 t; t.x = __builtin_amdgcn_rcpf(d.x); t.y = __builtin_amdgcn_rcpf(d.y);
    f32x2 q = t * 0.5307027145f + (-0.7265760135f); q = q * t + 0.7107068705f; q = q * t + (-0.142248368f); q = q * t + 0.127414796f; q = q * t;
    const f32x2 s = (v * v) * (-0.72134752044f);
    f32x2 e; e.x = __builtin_amdgcn_exp2f(s.x); e.y = __builtin_amdgcn_exp2f(s.y);
    const f32x2 m = v * (q * e), r = v - m;
    f32x2 o; o.x = v.x < 0.f ? m.x : r.x; o.y = v.y < 0.f ? m.y : r.y; return o;
}

template <int ACT  > struct EpiBf16 {
    static constexpr bool PERM = true, AFTER_DRAIN = false, HAS_MID = false; static_assert(ACT == 0 || ACT == 1, "EpiBf16: ACT is 0 (none) or 1 (gelu_pk)");
    bf16_t* O; int ldc; const float* bias; int split_cols; size_t split_stride; float scale0;
    __device__ __forceinline__ void operator()(const f32x4 (&acc)[2][2][4][2], const Unit& u, int wr, int wc, int fr, int fq) const {
        const int row0 = u.pm * BM + wr * 64 + fr; int colt = u.pn * BM; bf16_t* base = O;
        float sc = 1.f; if (split_cols) { const int t = colt / split_cols; base += (size_t)t * split_stride; colt -= t * split_cols; if (t == 0) sc = scale0; }
        const int col0 = colt + wc * 32 + 8 * fq, bcol0 = u.pn * BM + wc * 32 + 8 * fq;
        f32x4 bv[2][2];
#pragma unroll
        for (int bj = 0; bj < 2; ++bj)
#pragma unroll
            for (int n = 0; n < 2; ++n) bv[bj][n] = bias ? *(const f32x4*)(bias + bcol0 + bj * HALF + 4 * n) : (f32x4){0.f, 0.f, 0.f, 0.f};
#pragma unroll
        for (int ai = 0; ai < 2; ++ai)
#pragma unroll
            for (int m = 0; m < 4; ++m) { bf16_t* rowp = base + (size_t)(row0 + ai * HALF + m * 16) * ldc + col0;
#pragma unroll
                for (int bj = 0; bj < 2; ++bj) { f32x4 v0 = acc[ai][bj][m][0] + bv[bj][0], v1 = acc[ai][bj][m][1] + bv[bj][1];
                    if (ACT == 1) { f32x2 a = gelu_pk((f32x2){v0[0], v0[1]}), b = gelu_pk((f32x2){v0[2], v0[3]}), c = gelu_pk((f32x2){v1[0], v1[1]}), d = gelu_pk((f32x2){v1[2], v1[3]});
                        v0 = (f32x4){a.x, a.y, b.x, b.y}; v1 = (f32x4){c.x, c.y, d.x, d.y}; }
                    v0 = v0 * sc; v1 = v1 * sc; u32x4 w; w.x = cvt_pk_bf16(v0[0], v0[1]); w.y = cvt_pk_bf16(v0[2], v0[3]); w.z = cvt_pk_bf16(v1[0], v1[1]); w.w = cvt_pk_bf16(v1[2], v1[3]);
                    *(u32x4*)(rowp + bj * HALF) = w; } }
    }
};
__device__ __forceinline__ float bflo(unsigned w) { return __uint_as_float(w << 16); }
__device__ __forceinline__ float bfhi(unsigned w) { return __uint_as_float(w & 0xffff0000u); }
__device__ __forceinline__ float sigm(float x) { return __builtin_amdgcn_rcpf(1.0f + __expf(-fmaxf(x, -30.0f))); }

struct DenseOrder {
    typedef Unit UnitT; static constexpr bool GATHER = false;
    StaticOrder so; const char* A; const char* Bt; size_t tstep;
    __device__ __forceinline__ bool next(int i, Unit& u) const { return so.next(i, u); }
    __device__ __forceinline__ const char* ptrA(const Unit& u) const { return A + (size_t)u.pm * tstep; }
    __device__ __forceinline__ const char* ptrB(const Unit& u) const { return Bt + (size_t)u.pn * tstep; }
    __device__ __forceinline__ unsigned rowoff(const Unit&, int) const { return 0u; }
    __device__ __forceinline__ void a_ready(const Unit&) const {}
    __device__ __forceinline__ void done(const Unit&) const {}
};
struct MUnit { int pm, pn, e, j, rows, slot0; };
template <int NT, bool GATHER_> struct MoeOrder {
    typedef MUnit UnitT; static constexpr bool GATHER = GATHER_;
    const PG8_LAS int* etab; int G, c, K; const char* A; const char* W; size_t wstride; const int* list;
    __device__ __forceinline__ bool next(int i, MUnit& u) const {
        const int L = i * G + c; if (L >= etab[32] * NT) return false;
        const int blk = L / NT; int e = 0;
#pragma unroll
        for (int q = 1; q < 32; ++q) e += (etab[q] <= blk) ? 1 : 0;
        u.e = e; u.j = blk - etab[e]; u.pm = blk; u.pn = L % NT; const int left = etab[40 + e] - 256 * u.j; u.rows = left < 256 ? left : 256; u.slot0 = blk * 256; return true;
    }
    __device__ __forceinline__ const char* ptrA(const MUnit& u) const { return GATHER_ ? A : A + (size_t)u.slot0 * K * 2; }
    __device__ __forceinline__ const char* ptrB(const MUnit& u) const { return W + (size_t)u.e * wstride + (size_t)u.pn * 256 * K * 2; }
    __device__ __forceinline__ unsigned rowoff(const MUnit& u, int r) const { const int pos = u.j * 256 + r; const int tok = list[(size_t)u.e * 16384 + (pos < etab[40 + u.e] ? pos : 0)]; return (unsigned)tok * (unsigned)K * 2u; }
    __device__ __forceinline__ void a_ready(const MUnit&) const {}
    __device__ __forceinline__ void done(const MUnit&) const {}
};

struct EpiMerged {
    static constexpr bool PERM = true, AFTER_DRAIN = false, HAS_MID = true; static constexpr int TMID = 8;
    const bf16_t* proj; bf16_t* out; int ld, ga_off, gb_off;
    __device__ __forceinline__ void mid(f32x4 (&acc)[2][2][4][2], const Unit& u, int wr, int wc, int fr, int fq) const {
        int row0 = u.pm * BM + wr * 64 + fr, c0 = u.pn * BM + wc * 32 + 8 * fq;
        asm volatile("" : "+v"(row0), "+v"(c0));
#pragma unroll
        for (int ai = 0; ai < 2; ++ai)
#pragma unroll
            for (int mp = 0; mp < 2; ++mp) {
                u32x4 gav[2][2], gbv[2][2];
#pragma unroll
                for (int mm = 0; mm < 2; ++mm) { const bf16_t* rp = proj + (size_t)(row0 + ai * HALF + (2 * mp + mm) * 16) * ld + c0;
#pragma unroll
                    for (int bj = 0; bj < 2; ++bj) { gav[mm][bj] = *(const u32x4*)(rp + ga_off + bj * HALF); gbv[mm][bj] = *(const u32x4*)(rp + gb_off + bj * HALF); } }
#pragma unroll
                for (int mm = 0; mm < 2; ++mm) { const int m = 2 * mp + mm;
#pragma unroll
                    for (int bj = 0; bj < 2; ++bj) { const u32x4 ga = gav[mm][bj], gb = gbv[mm][bj];
#define EM_R(a, b) ((1.0f + __expf(-fmaxf((b), -30.0f))) * __builtin_amdgcn_rcpf(1.0f + __expf(-fmaxf((a), -30.0f))))
                        acc[ai][bj][m][0][0] *= EM_R(bflo(ga.x), bflo(gb.x)); acc[ai][bj][m][0][1] *= EM_R(bfhi(ga.x), bfhi(gb.x));
                        acc[ai][bj][m][0][2] *= EM_R(bflo(ga.y), bflo(gb.y)); acc[ai][bj][m][0][3] *= EM_R(bfhi(ga.y), bfhi(gb.y));
                        acc[ai][bj][m][1][0] *= EM_R(bflo(ga.z), bflo(gb.z)); acc[ai][bj][m][1][1] *= EM_R(bfhi(ga.z), bfhi(gb.z));
                        acc[ai][bj][m][1][2] *= EM_R(bflo(ga.w), bflo(gb.w)); acc[ai][bj][m][1][3] *= EM_R(bfhi(ga.w), bfhi(gb.w));
#undef EM_R
                    }
                    asm volatile("" : "+v"(acc[ai][0][m][0]), "+v"(acc[ai][0][m][1]), "+v"(acc[ai][1][m][0]), "+v"(acc[ai][1][m][1])); }
                asm volatile("" ::: "memory"); }
    }
    __device__ __forceinline__ void operator()(const f32x4 (&acc)[2][2][4][2], const Unit& u, int wr, int wc, int fr, int fq) const {
        const int row0 = u.pm * BM + wr * 64 + fr, c0 = u.pn * BM + wc * 32 + 8 * fq;
#pragma unroll
        for (int ai = 0; ai < 2; ++ai) {
            u32x4 gbv[4][2];
#pragma unroll
            for (int m = 0; m < 4; ++m)
#pragma unroll
                for (int bj = 0; bj < 2; ++bj) gbv[m][bj] = *(const u32x4*)(proj + (size_t)(row0 + ai * HALF + m * 16) * ld + gb_off + c0 + bj * HALF);
#pragma unroll
            for (int m = 0; m < 4; ++m) { const size_t row = (size_t)(row0 + ai * HALF + m * 16);
#pragma unroll
                for (int bj = 0; bj < 2; ++bj) { const u32x4 gb = gbv[m][bj];
                    const f32x4 v0 = acc[ai][bj][m][0], v1 = acc[ai][bj][m][1]; u32x4 w;
                    w.x = cvt_pk_bf16(v0[0] * sigm(bflo(gb.x)), v0[1] * sigm(bfhi(gb.x))); w.y = cvt_pk_bf16(v0[2] * sigm(bflo(gb.y)), v0[3] * sigm(bfhi(gb.y)));
                    w.z = cvt_pk_bf16(v1[0] * sigm(bflo(gb.z)), v1[1] * sigm(bfhi(gb.z))); w.w = cvt_pk_bf16(v1[2] * sigm(bflo(gb.w)), v1[3] * sigm(bfhi(gb.w)));
                    *(u32x4*)(out + row * 1024 + c0 + bj * HALF) = w; } }
            asm volatile("" ::: "memory"); }
    }
};
struct EpiResid {
    static constexpr bool PERM = false, AFTER_DRAIN = false, HAS_MID = false;
    const float* base; float* out;
    __device__ __forceinline__ void operator()(const f32x4 (&acc)[2][2][4][2], const Unit& u, int wr, int wc, int fr, int fq) const {
        const int row0 = u.pm * BM + wr * 64 + fr, col0 = u.pn * BM + wc * 32 + 4 * fq;
#pragma unroll
        for (int ai = 0; ai < 2; ++ai)
#pragma unroll
            for (int m = 0; m < 4; ++m) { const size_t off = (size_t)(row0 + ai * HALF + m * 16) * 1024 + col0;
#pragma unroll
                for (int bj = 0; bj < 2; ++bj)
#pragma unroll
                    for (int n = 0; n < 2; ++n) { const size_t o = off + bj * HALF + n * 16; *(f32x4*)(out + o) = *(const f32x4*)(base + o) + acc[ai][bj][m][n]; } }
    }
};
struct EpiSwiglu {
    static constexpr bool PERM = true, AFTER_DRAIN = false, HAS_MID = false;
    bf16_t* act; const float* bgu;
    __device__ __forceinline__ void operator()(const f32x4 (&acc)[2][2][4][2], const MUnit& u, int wr, int wc, int fr, int fq) const {
        const int r0 = wr * 64 + fr, j0 = u.pn * HALF + wc * 32 + 8 * fq;
        const float* bp = bgu + (size_t)u.e * 2048 + j0;
        const f32x4 bg0 = *(const f32x4*)(bp), bg1 = *(const f32x4*)(bp + 4), bl0 = *(const f32x4*)(bp + 1024), bl1 = *(const f32x4*)(bp + 1028);
#pragma unroll
        for (int ai = 0; ai < 2; ++ai)
#pragma unroll
            for (int m = 0; m < 4; ++m) { const int r = r0 + ai * HALF + m * 16;
                if (r < u.rows) {
                    const f32x4 g0 = acc[ai][0][m][0] + bg0, g1 = acc[ai][0][m][1] + bg1, l0 = acc[ai][1][m][0] + bl0, l1 = acc[ai][1][m][1] + bl1;
                    float o[8];
#pragma unroll
                    for (int i = 0; i < 4; ++i) { const float g = fminf(g0[i], 7.0f), l = fminf(fmaxf(l0[i], -7.0f), 7.0f); o[i] = g * sigm(1.702f * g) * (l + 1.0f); }
#pragma unroll
                    for (int i = 0; i < 4; ++i) { const float g = fminf(g1[i], 7.0f), l = fminf(fmaxf(l1[i], -7.0f), 7.0f); o[4 + i] = g * sigm(1.702f * g) * (l + 1.0f); }
                    u32x4 w; w.x = cvt_pk_bf16(o[0], o[1]); w.y = cvt_pk_bf16(o[2], o[3]); w.z = cvt_pk_bf16(o[4], o[5]); w.w = cvt_pk_bf16(o[6], o[7]);
                    *(u32x4*)(act + (size_t)(u.slot0 + r) * 1024 + j0) = w; } }
    }
};
struct EpiDown {
    static constexpr bool PERM = true, AFTER_DRAIN = false, HAS_MID = false;
    bf16_t* yexp; const float* bd; const float* gatel;
    __device__ __forceinline__ void operator()(const f32x4 (&acc)[2][2][4][2], const MUnit& u, int wr, int wc, int fr, int fq) const {
        const int r0 = wr * 64 + fr, c0 = u.pn * BM + wc * 32 + 8 * fq;
        f32x4 bv[2][2];
#pragma unroll
        for (int bj = 0; bj < 2; ++bj)
#pragma unroll
            for (int n = 0; n < 2; ++n) bv[bj][n] = *(const f32x4*)(bd + (size_t)u.e * 1024 + c0 + bj * HALF + 4 * n);
        float gv[2][4];
#pragma unroll
        for (int ai = 0; ai < 2; ++ai)
#pragma unroll
            for (int m = 0; m < 4; ++m) gv[ai][m] = gatel[(size_t)u.e * 16384 + u.j * 256 + r0 + ai * HALF + m * 16];
#pragma unroll
        for (int ai = 0; ai < 2; ++ai)
#pragma unroll
            for (int m = 0; m < 4; ++m) { const int r = r0 + ai * HALF + m * 16;
                if (r < u.rows) { const float g = gv[ai][m];
#pragma unroll
                    for (int bj = 0; bj < 2; ++bj) { const f32x4 v0 = (acc[ai][bj][m][0] + bv[bj][0]) * g, v1 = (acc[ai][bj][m][1] + bv[bj][1]) * g;
                        u32x4 w; w.x = cvt_pk_bf16(v0[0], v0[1]); w.y = cvt_pk_bf16(v0[2], v0[3]); w.z = cvt_pk_bf16(v1[0], v1[1]); w.w = cvt_pk_bf16(v1[2], v1[3]);
                        *(u32x4*)(yexp + (size_t)(u.slot0 + r) * 1024 + c0 + bj * HALF) = w; } } }
    }
};

template <class Epi, class Sched, bool ALIGN_EPI = false, bool SP2 = false>
__device__ __forceinline__ void gemm_phase(PG8_LAS unsigned char* lds, const int K, const Sched& S, const Epi& E, PG8_LAS unsigned* gtab) {
    const int tid = threadIdx.x, wid = __builtin_amdgcn_readfirstlane(tid >> 6), lane = tid & 63, wr = wid >> 2, wc = wid & 3, fr = lane & 15, fq = lane >> 4;
    const int nt = K / BK;
    unsigned voffA[2], voffB[2]; unsigned voffG[2][2] = {{0u, 0u}, {0u, 0u}}; int gR[2]; unsigned gC2[2];
#pragma unroll
    for (int i = 0; i < 2; ++i) { int R, C; stage_rc(tid * 16 + i * 8192, R, C); const int Rb = Epi::PERM ? ((R & ~31) + perm32(R & 31)) : R;
        gR[i] = R; gC2[i] = (unsigned)C * 2u; voffA[i] = (unsigned)(R * K + C) * 2u; voffB[i] = (unsigned)(Rb * K + C) * 2u; }
    const size_t kstep = (size_t)(BK * 2);
    const size_t hstep = (size_t)HALF * K * 2;
    const size_t tstep = 2 * hstep;
    const unsigned ldsw = (unsigned)wid * 1024u;
    const int aoff = lds_byte(wr * 64 + fr, fq * 8), boff = lds_byte(wc * 32 + fr, fq * 8);
#define PG8_SA(b, h) (((b) * 2 + (h)) * HTB)
#define PG8_SB(b, h) ((4 + (b) * 2 + (h)) * HTB)
#define PG8_STAGE(bufoff, gbase, voff) do { _Pragma("unroll") for (int _i = 0; _i < 2; ++_i) \
        __builtin_amdgcn_global_load_lds((const unsigned*)((const char*)(gbase) + (voff)[_i]), (PG8_LAS unsigned*)(lds + (bufoff) + ldsw + _i * 8192), 16, 0, 0); } while (0)
#define PG8_STAGE_A(bufoff, gbase, h) do { _Pragma("unroll") for (int _i = 0; _i < 2; ++_i) { const char* _src; \
        if constexpr (Sched::GATHER) _src = (const char*)(gbase) + voffG[h][_i]; else _src = (const char*)(gbase) + (size_t)(h) * hstep + voffA[_i]; \
        __builtin_amdgcn_global_load_lds((const unsigned*)_src, (PG8_LAS unsigned*)(lds + (bufoff) + ldsw + _i * 8192), 16, 0, 0); } } while (0)
#define PG8_LOADG(uidx) do { _Pragma("unroll") for (int _h = 0; _h < 2; ++_h) _Pragma("unroll") for (int _i = 0; _i < 2; ++_i) voffG[_h][_i] = gtab[(uidx) * 256 + _h * 128 + gR[_i]] + gC2[_i]; } while (0)
#define PG8_GSWITCH do { if constexpr (Sched::GATHER) { if (last && has_next) PG8_LOADG(ui + 1); } } while (0)
#define PG8_LDA(dst, b, h) do { _Pragma("unroll") for (int m = 0; m < 4; ++m) _Pragma("unroll") for (int k = 0; k < 2; ++k) dst[m][k] = *(const PG8_LAS bf16x8*)(lds + PG8_SA(b, h) + aoff + m * 2048 + k * 1024); } while (0)
#define PG8_LDB(dst, b, h) do { _Pragma("unroll") for (int n = 0; n < 2; ++n) _Pragma("unroll") for (int k = 0; k < 2; ++k) dst[n][k] = *(const PG8_LAS bf16x8*)(lds + PG8_SB(b, h) + boff + n * 2048 + k * 1024); } while (0)
#define PG8_MMA(ai, bj, At, Bt) do { __builtin_amdgcn_s_setprio(1); _Pragma("unroll") for (int m = 0; m < 4; ++m) _Pragma("unroll") for (int n = 0; n < 2; ++n) _Pragma("unroll") for (int k = 0; k < 2; ++k) \
        acc[ai][bj][m][n] = __builtin_amdgcn_mfma_f32_16x16x32_bf16(Bt[n][k], At[m][k], acc[ai][bj][m][n], 0, 0, 0); __builtin_amdgcn_s_setprio(0); } while (0)
#define PG8_WAIT_V(n) asm volatile("s_waitcnt vmcnt(" #n ")" ::: "memory")
#define PG8_WAIT_L(n) asm volatile("s_waitcnt lgkmcnt(" #n ")" ::: "memory")
#define PG8_BAR __builtin_amdgcn_s_barrier()
#define PG8_SCHED __builtin_amdgcn_sched_barrier(0)
    typename Sched::UnitT cur, nxt; int ui = 0;
    if (!S.next(0, cur)) return;
    f32x4 acc[2][2][4][2];
#pragma unroll
    for (int a = 0; a < 2; ++a)
#pragma unroll
        for (int b = 0; b < 2; ++b)
#pragma unroll
            for (int m = 0; m < 4; ++m)
#pragma unroll
                for (int n = 0; n < 2; ++n) acc[a][b][m][n] = (f32x4){0.f, 0.f, 0.f, 0.f};
    bf16x8 At[4][2], B0[2][2], B1[2][2];
    const char* cA = S.ptrA(cur); const char* cB = S.ptrB(cur);
    if constexpr (Sched::GATHER) {
        for (int i0 = 0; ; i0 += 4) {
            typename Sched::UnitT gu[4]; bool ok[4]; unsigned rv[4];
#pragma unroll
            for (int q = 0; q < 4; ++q) ok[q] = S.next(i0 + q, gu[q]);
#pragma unroll
            for (int q = 0; q < 4; ++q) rv[q] = (ok[q] && tid < 256) ? S.rowoff(gu[q], tid) : 0u;
#pragma unroll
            for (int q = 0; q < 4; ++q) if (ok[q] && tid < 256) gtab[(i0 + q) * 256 + tid] = rv[q];
            if (!ok[3]) break;
        }
        asm volatile("s_waitcnt vmcnt(0) lgkmcnt(0)" ::: "memory"); __builtin_amdgcn_s_barrier(); asm volatile("" ::: "memory");
        PG8_LOADG(0);
    }
    S.a_ready(cur);
    if constexpr (SP2) {
        PG8_STAGE(PG8_SB(0, 0), cB, voffB); PG8_STAGE(PG8_SB(0, 1), cB + hstep, voffB); PG8_STAGE_A(PG8_SA(0, 0), cA, 0); PG8_STAGE_A(PG8_SA(0, 1), cA, 1);
        if (wr == 1) PG8_BAR;
        PG8_WAIT_V(2); PG8_BAR;
        PG8_STAGE(PG8_SB(1, 0), cB + kstep, voffB); PG8_STAGE_A(PG8_SA(1, 0), cA + kstep, 0); PG8_STAGE(PG8_SB(1, 1), cB + hstep + kstep, voffB);
        PG8_WAIT_V(6); PG8_BAR;
    } else {
        PG8_STAGE(PG8_SB(0, 0), cB, voffB); PG8_STAGE_A(PG8_SA(0, 0), cA, 0); PG8_STAGE(PG8_SB(0, 1), cB + hstep, voffB); PG8_STAGE_A(PG8_SA(0, 1), cA, 1);
        if (wr == 1) PG8_BAR;
        PG8_WAIT_V(4); PG8_BAR;
        PG8_STAGE(PG8_SB(1, 0), cB + kstep, voffB); PG8_STAGE_A(PG8_SA(1, 0), cA + kstep, 0); PG8_STAGE(PG8_SB(1, 1), cB + hstep + kstep, voffB);
        PG8_WAIT_V(6); PG8_BAR;
    }
    for (;;) {
        const bool has_next = S.next(ui + 1, nxt);
        const char* nA = has_next ? S.ptrA(nxt) : cA; const char* nB = has_next ? S.ptrB(nxt) : cB;
        for (int t = 0; t < nt; t += 2) {
            if constexpr (Epi::HAS_MID) { if (t == Epi::TMID) E.mid(acc, cur, wr, wc, fr, fq); }
            const bool last = (t == nt - 2);
            const char* a1 = cA + (size_t)(t + 1) * kstep;
            const char* a2 = last ? nA : cA + (size_t)(t + 2) * kstep; const char* b2 = last ? nB : cB + (size_t)(t + 2) * kstep;
            const char* a3 = a2 + kstep; const char* b3 = b2 + kstep;
            if (last && has_next) S.a_ready(nxt);
            if constexpr (SP2) {
            PG8_LDB(B0, 0, 0); PG8_LDB(B1, 0, 1); PG8_SCHED; PG8_LDA(At, 0, 0); PG8_STAGE_A(PG8_SA(1, 1), a1, 1); PG8_GSWITCH;
            PG8_WAIT_V(8); PG8_WAIT_L(0); PG8_BAR; PG8_MMA(0, 0, At, B0); PG8_MMA(0, 1, At, B1); PG8_BAR; PG8_SCHED;
            PG8_LDA(At, 0, 1); PG8_STAGE(PG8_SB(0, 0), b2, voffB); PG8_STAGE(PG8_SB(0, 1), b2 + hstep, voffB); PG8_STAGE_A(PG8_SA(0, 0), a2, 0);
            PG8_WAIT_V(8); PG8_WAIT_L(0); PG8_BAR; PG8_MMA(1, 0, At, B0); PG8_MMA(1, 1, At, B1); PG8_BAR; PG8_SCHED;
            PG8_LDB(B0, 1, 0); PG8_LDB(B1, 1, 1); PG8_SCHED; PG8_LDA(At, 1, 0); PG8_STAGE_A(PG8_SA(0, 1), a2, 1);
            PG8_WAIT_V(8); PG8_WAIT_L(0); PG8_BAR; PG8_MMA(0, 0, At, B0); PG8_MMA(0, 1, At, B1); PG8_BAR; PG8_SCHED;
            PG8_LDA(At, 1, 1); PG8_STAGE(PG8_SB(1, 0), b3, voffB); PG8_STAGE(PG8_SB(1, 1), b3 + hstep, voffB); PG8_STAGE_A(PG8_SA(1, 0), a3, 0);
            PG8_WAIT_V(8); PG8_WAIT_L(0); PG8_BAR; PG8_MMA(1, 0, At, B0); PG8_MMA(1, 1, At, B1); PG8_BAR; PG8_SCHED;
            } else {
            PG8_LDB(B0, 0, 0); PG8_SCHED; PG8_LDA(At, 0, 0); PG8_STAGE_A(PG8_SA(1, 1), a1, 1); PG8_GSWITCH;
            PG8_WAIT_L(8); PG8_BAR; PG8_WAIT_L(0); PG8_MMA(0, 0, At, B0); PG8_BAR; PG8_SCHED;
            PG8_LDB(B1, 0, 1); PG8_STAGE(PG8_SB(0, 0), b2, voffB);
            PG8_BAR; PG8_WAIT_L(0); PG8_MMA(0, 1, At, B1); PG8_BAR;
            PG8_LDA(At, 0, 1); PG8_STAGE_A(PG8_SA(0, 0), a2, 0);
            PG8_BAR; PG8_WAIT_L(0); PG8_MMA(1, 0, At, B0); PG8_BAR; PG8_SCHED;
            PG8_STAGE(PG8_SB(0, 1), b2 + hstep, voffB);
            PG8_WAIT_V(6); PG8_BAR; PG8_MMA(1, 1, At, B1); PG8_BAR;
            PG8_LDB(B0, 1, 0); PG8_SCHED; PG8_LDA(At, 1, 0); PG8_STAGE_A(PG8_SA(0, 1), a2, 1);
            PG8_WAIT_L(8); PG8_BAR; PG8_WAIT_L(0); PG8_MMA(0, 0, At, B0); PG8_BAR; PG8_SCHED;
            PG8_LDB(B1, 1, 1); PG8_STAGE(PG8_SB(1, 0), b3, voffB);
            PG8_BAR; PG8_WAIT_L(0); PG8_MMA(0, 1, At, B1); PG8_BAR;
            PG8_LDA(At, 1, 1); PG8_STAGE_A(PG8_SA(1, 0), a3, 0);
            PG8_BAR; PG8_WAIT_L(0); PG8_MMA(1, 0, At, B0); PG8_BAR; PG8_SCHED;
            PG8_STAGE(PG8_SB(1, 1), b3 + hstep, voffB);
            PG8_WAIT_V(6); PG8_BAR; PG8_MMA(1, 1, At, B1); PG8_BAR;
            }
        }
        if constexpr (ALIGN_EPI) { if (wr == 0) PG8_BAR; }
        if constexpr (!Epi::AFTER_DRAIN) { E(acc, cur, wr, wc, fr, fq); S.done(cur); }
        if (!has_next) break;
#pragma unroll
        for (int a = 0; a < 2; ++a)
#pragma unroll
            for (int b = 0; b < 2; ++b)
#pragma unroll
                for (int m = 0; m < 4; ++m)
#pragma unroll
                    for (int n = 0; n < 2; ++n) acc[a][b][m][n] = (f32x4){0.f, 0.f, 0.f, 0.f};
        cur = nxt; cA = nA; cB = nB; ++ui;
        if constexpr (ALIGN_EPI) { if (wr == 1) PG8_BAR; }
    }
    PG8_WAIT_V(0);
    if constexpr (!ALIGN_EPI) { if (wr == 0) PG8_BAR; }
    PG8_BAR;
    if constexpr (Epi::AFTER_DRAIN) { E.fused(acc, cur, wr, wc, fr, fq, lds, wid, lane); S.done(cur); }
#undef PG8_SA
#undef PG8_SB
#undef PG8_STAGE
#undef PG8_STAGE_A
#undef PG8_LOADG
#undef PG8_GSWITCH
#undef PG8_LDA
#undef PG8_LDB
#undef PG8_MMA
#undef PG8_WAIT_V
#undef PG8_WAIT_L
#undef PG8_BAR
#undef PG8_SCHED
}
}
constexpr size_t MiB = 1u << 20;
constexpr size_t WS_CTL = 0, CTL_ZERO_BYTES = 128 * 1024;
constexpr size_t WS_WIN = 2 * MiB;
constexpr size_t WS_WAB = 18 * MiB;
constexpr size_t WS_WOUT = 21 * MiB;
constexpr size_t WS_GATEL = 23 * MiB;
constexpr size_t WS_LIST = 25 * MiB;
constexpr size_t WS_ASG = 27 * MiB;
constexpr size_t WS_WGU = 32 * MiB;
constexpr size_t WS_WD = 160 * MiB;
constexpr size_t WS_XN = 224 * MiB;
constexpr size_t WS_PROJ = 256 * MiB;
constexpr size_t WS_YAB = 504 * MiB;
constexpr size_t WS_MERGED = 552 * MiB;
constexpr size_t WS_ACT = 256 * MiB;
constexpr size_t WS_GQ = 584 * MiB;
constexpr size_t WS_GKT = 616 * MiB;
constexpr size_t WS_GUT = 648 * MiB;
constexpr size_t WS_GW = 712 * MiB;
constexpr size_t WS_GQK = 776 * MiB;
constexpr size_t WS_GEG = 808 * MiB;
constexpr size_t WS_OF = 890 * MiB;
constexpr size_t WS_OB = 922 * MiB;
constexpr size_t WS_YEXP = 840 * MiB;
constexpr size_t WS_OP = 840 * MiB;
constexpr size_t WS_LSE = 888 * MiB;
constexpr size_t WS_END = 984 * MiB;
constexpr int CW_TMO = 0, CW_CODE = 1, CW_BAR = 4096, CW_CNT = 16384;
constexpr int N_BAR_REGIONS = 3;
static_assert((CW_CNT + 64) * 4 <= (int)CTL_ZERO_BYTES && (CW_BAR + 3 * 3456) * 4 <= CW_CNT * 4, "control words inside the per-call memset");

constexpr int RING_OFF = 0, RING_BYTES = 131072;
constexpr int LDSCTL_OFF = RING_BYTES, MISC_OFF = LDSCTL_OFF + 320;
constexpr int ETAB_OFF = LDSCTL_OFF + 1024;
constexpr int GTAB_OFF = LDSCTL_OFF + 2048;
constexpr int LDS_BYTES = 163840;
static_assert(GTAB_OFF + 16 * 1024 <= LDS_BYTES, "LDS map");
constexpr int NWAVES = 8;

#define GAS __attribute__((address_space(1)))
#define LAS __attribute__((address_space(3)))
typedef unsigned short bf16;
typedef unsigned v4u __attribute__((ext_vector_type(4)));
typedef float f32x4 __attribute__((ext_vector_type(4)));
typedef short bf16x8 __attribute__((ext_vector_type(8)));
typedef GAS unsigned gu32;
typedef GAS unsigned long long gu64;
#define RLX_AGENT __ATOMIC_RELAXED, __HIP_MEMORY_SCOPE_AGENT
#define LDS_WAIT() asm volatile("s_waitcnt lgkmcnt(0)" ::: "memory")
#define VM_WAIT() asm volatile("s_waitcnt vmcnt(0)" ::: "memory")
__device__ __forceinline__ unsigned long long rt() { return __builtin_amdgcn_s_memrealtime(); }
typedef float pk_f32x2_t __attribute__((ext_vector_type(2))); typedef __bf16 pk_bf16x2_t __attribute__((ext_vector_type(2)));
__device__ __forceinline__ unsigned pk2(float lo, float hi) { pk_f32x2_t v = {lo, hi}; pk_bf16x2_t b = __builtin_convertvector(v, pk_bf16x2_t); return __builtin_bit_cast(unsigned, b); }
__device__ __forceinline__ unsigned f2bf(float f) { return pk2(f, 0.f) & 0xffffu; }

#define XB_TMO      128
#define XB_XCNT(j)  (256  + 64 * (j))
#define XB_XSUB(j)  (1280 + 64 * (j))
#define XB_XGEN(j)  (2304 + 64 * (j))
#define XB_TOP      3328
#define XB_TOPGEN   3392
#define XCD_BAR_WORDS 3456
#define XB_SPIN_CAP (1u << 18)

__device__ __forceinline__ unsigned xb_ld(unsigned* p)              { return __hip_atomic_load(p, __ATOMIC_RELAXED, __HIP_MEMORY_SCOPE_AGENT); }
__device__ __forceinline__ unsigned xb_add(unsigned* p, unsigned v) { return __hip_atomic_fetch_add(p, v, __ATOMIC_RELAXED, __HIP_MEMORY_SCOPE_AGENT); }
__device__ __forceinline__ unsigned xb_xcc_id() { return (unsigned)__builtin_amdgcn_s_getreg((3 << 11) | 20) & 0xFu; }
#define XB_SPIN(cond, bar) do { unsigned _sp = 0; while (cond) { __builtin_amdgcn_s_sleep(1); \
    if ((++_sp & 255u) == 0u) { if (xb_ld(&(bar)[XB_TMO])) break; if (_sp > XB_SPIN_CAP) { atomicAdd(&(bar)[XB_TMO], 1u); break; } } } } while (0)

struct XcdBarrier {
    unsigned* bar; unsigned x;
    volatile LAS unsigned* st;
};

__device__ __forceinline__ XcdBarrier xcd_barrier_post(unsigned* bar, volatile LAS unsigned* st) {
    XcdBarrier b; b.bar = bar; b.x = xb_xcc_id(); b.st = st;
    if (threadIdx.x == 0) (void)xb_add(&bar[XB_XCNT(b.x)], 1u);
    return b;
}
__device__ __forceinline__ void xcd_barrier_complete(unsigned* bar, unsigned x, unsigned& nloc, unsigned& nx) {
    const unsigned G = gridDim.x * gridDim.y * gridDim.z;
    unsigned sum, cnt, mine, sp = 0u;
    for (;;) {
        sum = 0u; cnt = 0u; mine = 0u;
#pragma unroll
        for (unsigned j = 0; j < 16; ++j) { const unsigned c = xb_ld(&bar[XB_XCNT(j)]); sum += c; cnt += (c > 0u) ? 1u : 0u; mine = (j == x) ? c : mine; }
        if (sum == G) break;
        __builtin_amdgcn_s_sleep(1);
        if ((++sp & 255u) == 0u) { if (xb_ld(&bar[XB_TMO])) break; if (sp > XB_SPIN_CAP) { atomicAdd(&bar[XB_TMO], 1u); break; } }
    }
    nloc = mine > 0u ? mine : 1u; nx = cnt > 0u ? cnt : 1u;
}

__device__ __forceinline__ void xcd_barrier(const XcdBarrier& b) {
    asm volatile("s_waitcnt vmcnt(0)" ::: "memory");
    __syncthreads();
    if (threadIdx.x == 0) {
        unsigned* bar = b.bar;
        __builtin_amdgcn_s_waitcnt(0);
        unsigned nloc = b.st[0], nx = b.st[1];
        if (nloc == 0u) { xcd_barrier_complete(bar, b.x, nloc, nx); b.st[0] = nloc; b.st[1] = nx; }
        const unsigned old = xb_add(&bar[XB_XSUB(b.x)], 1u);
        const unsigned gen = old / nloc;
        if (old + 1u == (gen + 1u) * nloc) {
            __builtin_amdgcn_fence(__ATOMIC_RELEASE, "agent");
            asm volatile("s_waitcnt vmcnt(0)" ::: "memory");
            const unsigned og = xb_add(&bar[XB_TOP], 1u);
            const unsigned tg = og / nx;
            if (og + 1u == (tg + 1u) * nx) xb_add(&bar[XB_TOPGEN], 1u);
            else XB_SPIN(xb_ld(&bar[XB_TOPGEN]) == tg, bar);
            __builtin_amdgcn_fence(__ATOMIC_ACQUIRE, "agent");
            xb_add(&bar[XB_XGEN(b.x)], 1u);
            asm volatile("s_waitcnt vmcnt(0)" ::: "memory");
        } else {
            XB_SPIN(xb_ld(&bar[XB_XGEN(b.x)]) == gen, bar);
            __builtin_amdgcn_fence(__ATOMIC_ACQUIRE, "agent");
            asm volatile("s_waitcnt vmcnt(0)" ::: "memory");
        }
    }
    __syncthreads();
}
__device__ __forceinline__ float wave_sum(float v) {
#pragma unroll
    for (int o = 1; o < 64; o <<= 1) v += __shfl_xor(v, o);
    return v;
}
__device__ __forceinline__ float bf2f(unsigned short b) { return __uint_as_float((unsigned)b << 16); }

__device__ __forceinline__ void tr_item(const float* W, int N, bf16* WT, int pitch, int kcol0, int k0, int n0, int drow0, LAS float* scr, int lane) {
#pragma unroll 8
    for (int i = 0; i < 32; ++i) { const int kk = 2 * i + (lane >> 5); scr[kk * 33 + (lane & 31)] = W[(size_t)(k0 + kk) * N + n0 + (lane & 31)]; }
    LDS_WAIT(); asm volatile("" ::: "memory");
    const int c = lane & 7;
#pragma unroll
    for (int j = 0; j < 4; ++j) { const int n = (lane >> 3) + 8 * j; const LAS float* s = scr + (8 * c) * 33 + n;
        v4u o; o.x = pk2(s[0 * 33], s[1 * 33]); o.y = pk2(s[2 * 33], s[3 * 33]); o.z = pk2(s[4 * 33], s[5 * 33]); o.w = pk2(s[6 * 33], s[7 * 33]);
        *(GAS v4u*)(WT + (size_t)(drow0 + n) * pitch + kcol0 + k0 + 8 * c) = o; }
    LDS_WAIT(); asm volatile("" ::: "memory");
}

struct Ptrs {
    const float *x, *norm1_w, *w_in, *conv_w, *a_log_f, *a_log_b, *dtb_f, *dtb_b, *gdn_nw, *w_ba, *w_bb, *w_out, *norm2_w, *router_w, *router_b, *w_gu, *b_gu, *w_d, *b_d, *normf_w;
    float* out; unsigned char* ws;
};
struct Args { Ptrs p; int ph_lo, ph_hi, li, pad; };

__device__ __forceinline__ void p0_prologue(const Ptrs& P, LAS unsigned char* lds, int vcu, int G, int wave, int lane) {
    LAS float* scr = (LAS float*)(lds + RING_OFF + wave * 16384);
    const int gw = vcu * NWAVES + wave, NGW = G * NWAVES;
    bf16* WIN = (bf16*)(P.ws + WS_WIN); bf16* WAB = (bf16*)(P.ws + WS_WAB); bf16* WOUT = (bf16*)(P.ws + WS_WOUT); bf16* WGU = (bf16*)(P.ws + WS_WGU); bf16* WD = (bf16*)(P.ws + WS_WD);
    constexpr int I_IN = 16 * 241, I_BA = 8 * 32, I_BB = 16 * 32, I_OUT = 16 * 32, I_GU = 32 * 16 * 64, I_D = 32 * 16 * 32;
    constexpr int NITEMS = I_IN + I_BA + I_BB + I_OUT + I_GU + I_D;
    const int nitems = (G == 256 && !RIDE_OFF) ? I_IN + I_BA + I_BB + I_OUT : NITEMS;
    for (int it = gw; it < nitems; it += NGW) {
        int r = it;
        if (r < I_IN) { const int kb = r / 241, nb = r % 241, n0 = 32 * nb;
            const int d0 = n0 < 5632 ? n0 : (n0 < 5664 ? P_AF + (n0 - 5632) : P_GA + (n0 - 5664));
            tr_item(P.w_in, NIN, WIN, 1024, 0, 64 * kb, n0, d0, scr, lane); continue; } r -= I_IN;
        if (r < I_BA) { tr_item(P.w_ba, 1024, WAB, KAB, 0, 64 * (r / 32), 32 * (r % 32), 32 * (r % 32), scr, lane); continue; } r -= I_BA;
        if (r < I_BB) { tr_item(P.w_bb, 1024, WAB, KAB, 512, 64 * (r / 32), 32 * (r % 32), 32 * (r % 32), scr, lane); continue; } r -= I_BB;
        if (r < I_OUT) { tr_item(P.w_out, 1024, WOUT, 1024, 0, 64 * (r / 32), 32 * (r % 32), 32 * (r % 32), scr, lane); continue; } r -= I_OUT;
        if (r < I_GU) { const int e = r / 1024, q = r % 1024, kb = q / 64, nb = q % 64, n0 = 32 * nb;
            const int d0 = n0 < 1024 ? 256 * (n0 / 128) + (n0 % 128) : 256 * ((n0 - 1024) / 128) + 128 + ((n0 - 1024) % 128);
            tr_item(P.w_gu + (size_t)e * 1024 * 2048, 2048, WGU + (size_t)e * 2048 * 1024, 1024, 0, 64 * kb, n0, d0, scr, lane); continue; } r -= I_GU;
        { const int e = r / 512, q = r % 512;
            tr_item(P.w_d + (size_t)e * 1024 * 1024, 1024, WD + (size_t)e * 1024 * 1024, 1024, 0, 64 * (q / 32), 32 * (q % 32), 32 * (q % 32), scr, lane); }
    }
    for (int i = gw * 64 + lane; i < 224 * 1024 / 8; i += NGW * 64) ((GAS v4u*)(WIN + (size_t)7712 * 1024))[i] = (v4u){0u, 0u, 0u, 0u};
    bf16* XN = (bf16*)(P.ws + WS_XN);
    for (int m = gw; m < M; m += NGW) {
        const GAS f32x4* xr = (const GAS f32x4*)(P.x + (size_t)m * DM) + lane; const GAS f32x4* wr = (const GAS f32x4*)P.norm1_w + lane;
        f32x4 v[4]; float s = 0.f;
#pragma unroll
        for (int j = 0; j < 4; ++j) { v[j] = xr[64 * j]; s += (v[j].x * v[j].x + v[j].y * v[j].y) + (v[j].z * v[j].z + v[j].w * v[j].w); }
        const float rstd = rsqrtf(wave_sum(s) * (1.f / DM) + EPS);
        GAS unsigned long long* o8 = (GAS unsigned long long*)(XN + (size_t)m * DM) + lane;
#pragma unroll
        for (int j = 0; j < 4; ++j) { const f32x4 w = wr[64 * j]; o8[64 * j] = (unsigned long long)pk2(v[j].x * rstd * w.x, v[j].y * rstd * w.y) | ((unsigned long long)pk2(v[j].z * rstd * w.z, v[j].w * rstd * w.w) << 32); }
    }
}

__device__ __forceinline__ void build_etab(const unsigned* cnt, LAS int* etab, int tid) {
    if (tid < 32) etab[40 + tid] = (int)__hip_atomic_load(cnt + tid, __ATOMIC_RELAXED, __HIP_MEMORY_SCOPE_AGENT);
    LDS_WAIT(); __syncthreads();
    if (tid == 0) { int s = 0; for (int e = 0; e < 32; ++e) { etab[e] = s; s += (etab[40 + e] + 255) >> 8; } etab[32] = s; }
    LDS_WAIT(); __syncthreads();
}

template <int VAR> __device__ __forceinline__ void p7_router(const Ptrs& P, LAS unsigned char* lds, int G, int tid, int wave, int lane) {
    LAS float* rw = (LAS float*)(lds + RING_OFF);
    LAS int* hist = (LAS int*)(lds + ETAB_OFF);
    LAS int* asg = (LAS int*)(lds + GTAB_OFF);
    const float* X1 = P.out; bf16* H2 = (bf16*)(P.ws + (VAR ? WS_ACT : WS_XN));
    unsigned* CNT = (unsigned*)(P.ws + WS_CTL) + CW_CNT; int* LIST = (int*)(P.ws + WS_LIST); float* GATEL = (float*)(P.ws + WS_GATEL); int* ASG = (int*)(P.ws + WS_ASG);
    for (int i = tid; i < 1024 * 8; i += 512) { const int c = i >> 3, e4 = i & 7, rho = ((((c >> 8) << 2) + (c & 3)) << 6) + ((c >> 2) & 63);
        ((LAS f32x4*)rw)[rho * 8 + (e4 ^ ((rho >> 1) & 7))] = ((const GAS f32x4*)P.router_w)[i]; }
    for (int grp = blockIdx.x; grp < M / 64; grp += G) {
        const int r0 = grp * 64;
        if (tid < 64) hist[tid] = 0;
        LDS_WAIT(); __syncthreads();
#pragma unroll 1
        for (int i = 0; i < 8; i += 2) {
            const int lrow = wave * 8 + i, m = r0 + lrow;
            const GAS f32x4* wr = (const GAS f32x4*)P.norm2_w + lane;
            f32x4 va[4], vb[4]; float sa = 0.f, sb = 0.f;
            { const GAS f32x4* xa = (const GAS f32x4*)(X1 + (size_t)m * DM) + lane; const GAS f32x4* xb = (const GAS f32x4*)(X1 + (size_t)(m + 1) * DM) + lane;
#pragma unroll
              for (int j = 0; j < 4; ++j) { va[j] = xa[64 * j]; vb[j] = xb[64 * j]; }
#pragma unroll
              for (int j = 0; j < 4; ++j) { sa += (va[j].x * va[j].x + va[j].y * va[j].y) + (va[j].z * va[j].z + va[j].w * va[j].w); sb += (vb[j].x * vb[j].x + vb[j].y * vb[j].y) + (vb[j].z * vb[j].z + vb[j].w * vb[j].w); } }
            const float rsa = rsqrtf(wave_sum(sa) * (1.f / DM) + EPS), rsb = rsqrtf(wave_sum(sb) * (1.f / DM) + EPS);
            GAS unsigned long long* oa8 = (GAS unsigned long long*)(H2 + (size_t)m * DM) + lane; GAS unsigned long long* ob8 = (GAS unsigned long long*)(H2 + (size_t)(m + 1) * DM) + lane;
            float acca[32], accb[32];
#pragma unroll
            for (int e = 0; e < 32; ++e) { acca[e] = 0.f; accb[e] = 0.f; }
#pragma unroll
            for (int j = 0; j < 4; ++j) { const f32x4 w = wr[64 * j];
                va[j].x *= rsa * w.x; va[j].y *= rsa * w.y; va[j].z *= rsa * w.z; va[j].w *= rsa * w.w; vb[j].x *= rsb * w.x; vb[j].y *= rsb * w.y; vb[j].z *= rsb * w.z; vb[j].w *= rsb * w.w;
                oa8[64 * j] = (unsigned long long)pk2(va[j].x, va[j].y) | ((unsigned long long)pk2(va[j].z, va[j].w) << 32);
                ob8[64 * j] = (unsigned long long)pk2(vb[j].x, vb[j].y) | ((unsigned long long)pk2(vb[j].z, vb[j].w) << 32);
#pragma unroll
                for (int q = 0; q < 4; ++q) { const float ha = va[j][q], hb = vb[j][q]; const LAS f32x4* rp = (const LAS f32x4*)rw + ((4 * j + q) * 64 + lane) * 8; const int sw = (lane >> 1) & 7;
#pragma unroll
                    for (int e4 = 0; e4 < 8; ++e4) { const f32x4 r4 = rp[e4 ^ sw];
                        acca[4 * e4] += ha * r4.x; acca[4 * e4 + 1] += ha * r4.y; acca[4 * e4 + 2] += ha * r4.z; acca[4 * e4 + 3] += ha * r4.w;
                        accb[4 * e4] += hb * r4.x; accb[4 * e4 + 1] += hb * r4.y; accb[4 * e4 + 2] += hb * r4.z; accb[4 * e4 + 3] += hb * r4.w; } } }
            float r32[32], r16[16], r8[8], r4[4], r2[2], lg;
            { const bool hi = (lane >> 5) & 1;
#pragma unroll
              for (int q = 0; q < 32; ++q) { const float keep = hi ? accb[q] : acca[q], send = hi ? acca[q] : accb[q]; r32[q] = keep + __shfl_xor(send, 32); } }
            { const bool hi = (lane >> 4) & 1;
#pragma unroll
              for (int q = 0; q < 16; ++q) { const float keep = hi ? r32[16 + q] : r32[q], send = hi ? r32[q] : r32[16 + q]; r16[q] = keep + __shfl_xor(send, 16); } }
            { const bool hi = (lane >> 3) & 1;
#pragma unroll
              for (int q = 0; q < 8; ++q) { const float keep = hi ? r16[8 + q] : r16[q], send = hi ? r16[q] : r16[8 + q]; r8[q] = keep + __shfl_xor(send, 8); } }
            { const bool hi = (lane >> 2) & 1;
#pragma unroll
              for (int q = 0; q < 4; ++q) { const float keep = hi ? r8[4 + q] : r8[q], send = hi ? r8[q] : r8[4 + q]; r4[q] = keep + __shfl_xor(send, 4); } }
            { const bool hi = (lane >> 1) & 1;
#pragma unroll
              for (int q = 0; q < 2; ++q) { const float keep = hi ? r4[2 + q] : r4[q], send = hi ? r4[q] : r4[2 + q]; r2[q] = keep + __shfl_xor(send, 2); } }
            { const bool hi = lane & 1; const float keep = hi ? r2[1] : r2[0], send = hi ? r2[0] : r2[1]; lg = keep + __shfl_xor(send, 1); }
            const int e = lane & 31, half = lane >> 5; lg += P.router_b[e];
            float lv[4]; int li[4]; float cur = lg;
#pragma unroll
            for (int r = 0; r < 4; ++r) { float bv = cur; int bi = e;
#pragma unroll
                for (int o = 1; o < 32; o <<= 1) { const float ov = __shfl_xor(bv, o); const int oi = __shfl_xor(bi, o); if (ov > bv || (ov == bv && oi < bi)) { bv = ov; bi = oi; } }
                lv[r] = bv; li[r] = bi; if (e == bi) cur = -3.0e38f; }
            const float e1 = __expf(lv[1] - lv[0]), e2 = __expf(lv[2] - lv[0]), e3 = __expf(lv[3] - lv[0]);
            const float inv = 1.f / (1.f + e1 + e2 + e3);
            if (e < 4) {
                const float g = (e == 0 ? 1.f : e == 1 ? e1 : e == 2 ? e2 : e3) * inv;
                const int ee = e == 0 ? li[0] : e == 1 ? li[1] : e == 2 ? li[2] : li[3];
                const int rank = atomicAdd((int*)(hist + ee), 1);
                const int a = (lrow + half) * 4 + e;
                asg[a] = ee | (rank << 8); asg[256 + a] = __float_as_int(g); asg[512 + a] = (m + half) * 4 + e;
            }
        }
        LDS_WAIT(); __syncthreads();
        if (tid < 32) hist[32 + tid] = VAR ? 0 : (int)__hip_atomic_fetch_add(CNT + tid, (unsigned)hist[tid], __ATOMIC_RELAXED, __HIP_MEMORY_SCOPE_AGENT);
        LDS_WAIT(); __syncthreads();
        if (tid < 256 && !VAR) { const int w = asg[tid], ee = w & 255, pos = hist[32 + ee] + (w >> 8); const int tk = asg[512 + tid];
            LIST[(size_t)ee * M + pos] = tk >> 2; GATEL[(size_t)ee * M + pos] = __int_as_float(asg[256 + tid]); ASG[tk] = (ee << 16) | pos; }
        LDS_WAIT(); __syncthreads();
    }
}

template <int VAR> __device__ __forceinline__ void p10_final(const Ptrs& P, LAS unsigned char* lds, int G, int tid, int wave, int lane) {
    LAS int* etab = (LAS int*)(lds + ETAB_OFF);
    build_etab((const unsigned*)(P.ws + WS_CTL) + CW_CNT, etab, tid);
    const int* ASG = (const int*)(P.ws + WS_ASG); const bf16* YEXP = (const bf16*)(P.ws + WS_YEXP);
    const int gw = blockIdx.x * NWAVES + wave, NGW = G * NWAVES;
    typedef unsigned u32x2 __attribute__((ext_vector_type(2)));
    const GAS f32x4* wr = (const GAS f32x4*)P.normf_w + lane;
    for (int m0 = gw; m0 < M; m0 += 2 * NGW) {
        const int m1 = m0 + NGW < M ? m0 + NGW : m0;
        int slot[2][4];
#pragma unroll
        for (int q = 0; q < 2; ++q) { const int4 a4 = *(const int4*)(ASG + (size_t)(q ? m1 : m0) * 4);
            slot[q][0] = etab[a4.x >> 16] * 256 + (a4.x & 0xffff); slot[q][1] = etab[a4.y >> 16] * 256 + (a4.y & 0xffff); slot[q][2] = etab[a4.z >> 16] * 256 + (a4.z & 0xffff); slot[q][3] = etab[a4.w >> 16] * 256 + (a4.w & 0xffff); }
        f32x4 v[2][4]; u32x2 y[2][4][4];
#pragma unroll
        for (int q = 0; q < 2; ++q) { const GAS f32x4* xr = (const GAS f32x4*)(P.out + (size_t)(q ? m1 : m0) * DM) + lane;
#pragma unroll
            for (int j = 0; j < 4; ++j) v[q][j] = xr[64 * j];
#pragma unroll
            for (int k = 0; k < 4; ++k) { const GAS u32x2* yr = (const GAS u32x2*)(YEXP + (size_t)slot[q][k] * DM) + lane;
#pragma unroll
                for (int j = 0; j < 4; ++j) y[q][k][j] = yr[64 * j]; } }
#pragma unroll
        for (int q = 0; q < 2; ++q) {
            float s = 0.f;
#pragma unroll
            for (int j = 0; j < 4; ++j) {
#pragma unroll
                for (int k = 0; k < 4; ++k) { const u32x2 yy = y[q][k][j]; v[q][j].x += __uint_as_float(yy.x << 16); v[q][j].y += __uint_as_float(yy.x & 0xffff0000u); v[q][j].z += __uint_as_float(yy.y << 16); v[q][j].w += __uint_as_float(yy.y & 0xffff0000u); }
                s += (v[q][j].x * v[q][j].x + v[q][j].y * v[q][j].y) + (v[q][j].z * v[q][j].z + v[q][j].w * v[q][j].w); }
            const float rstd = rsqrtf(wave_sum(s) * (1.f / DM) + EPS);
            if (q == 0 || m1 != m0) { GAS f32x4* xo = (GAS f32x4*)((VAR ? (float*)(P.ws + WS_ACT) : P.out) + (size_t)(q ? m1 : m0) * DM) + lane;
#pragma unroll
                for (int j = 0; j < 4; ++j) { const f32x4 w = wr[64 * j]; xo[64 * j] = (f32x4){v[q][j].x * rstd * w.x, v[q][j].y * rstd * w.y, v[q][j].z * rstd * w.z, v[q][j].w * rstd * w.w}; } }
        }
    }
}

typedef float f32x16 __attribute__((ext_vector_type(16)));
typedef short v4i16_t __attribute__((ext_vector_type(4)));
typedef float f32x2_t __attribute__((ext_vector_type(2))); typedef __bf16 bf16x2_t __attribute__((ext_vector_type(2)));
__device__ __forceinline__ unsigned cvtpk(float lo, float hi) { f32x2_t v = {lo, hi}; bf16x2_t b = __builtin_convertvector(v, bf16x2_t); return __builtin_bit_cast(unsigned, b); }
constexpr int ATT_VPITCH = 144;
constexpr int ATT_WAVE_LDS = 32 * ATT_VPITCH;
__device__ __forceinline__ void attn_unit(const bf16* proj, bf16* OP, float* LSE, LAS unsigned char* vt, int unit, int lane) {
    const int q128 = unit & 127, p = (unit >> 7) % 3, bh = unit / 384, b = bh >> 3, h = bh & 7;
    const int r = p == 0 ? 1 : (p == 1 ? 4 : 16), gpc = 128 / r, c = q128 / gpc, g = q128 % gpc, L = SEQ / r, u0 = 32 * g;
    int lq = lane & 31, hi = lane >> 5;
    asm volatile("" : "+v"(lq), "+v"(hi));
    const bf16* base = proj + ((size_t)b * SEQ + c) * NINP + h * 64;
    const size_t ustride = (size_t)r * NINP;
    const int vrow = lane >> 3, vch = lane & 7;
    v4u qst[4], kst[5][4];
#pragma unroll
    for (int i = 0; i < 4; ++i) qst[i] = *(const v4u*)(base + (size_t)(u0 + vrow + 8 * i) * ustride + P_QA + 8 * vch);
#define ATT_KLOAD(t) do { _Pragma("unroll") for (int i = 0; i < 4; ++i) { int uk_ = u0 - 64 + 32 * (t) + vrow + 8 * i; uk_ = uk_ < 0 ? 0 : (uk_ > L - 1 ? L - 1 : uk_); kst[t][i] = *(const v4u*)(base + (size_t)uk_ * ustride + P_KA + 8 * vch); } } while (0)
    ATT_KLOAD(0); ATT_KLOAD(1); ATT_KLOAD(2);
    bf16x8 qf[4];
#pragma unroll
    for (int i = 0; i < 4; ++i) *(LAS v4u*)(vt + (vrow + 8 * i) * ATT_VPITCH + vch * 16) = qst[i];
    asm volatile("" ::: "memory");
#pragma unroll
    for (int d0 = 0; d0 < 4; ++d0) qf[d0] = *(const LAS bf16x8*)(vt + lq * ATT_VPITCH + (16 * d0 + 8 * hi) * 2);
    asm volatile("" ::: "memory");
    f32x16 sc[5];
#pragma unroll
    for (int t = 0; t < 5; ++t) {
#pragma unroll
        for (int i = 0; i < 4; ++i) *(LAS v4u*)(vt + (vrow + 8 * i) * ATT_VPITCH + vch * 16) = kst[t][i];
        asm volatile("" ::: "memory");
        if (t == 0) ATT_KLOAD(3);
        if (t == 1) ATT_KLOAD(4);
        f32x16 a = {};
#pragma unroll
        for (int d0 = 0; d0 < 4; ++d0) a = __builtin_amdgcn_mfma_f32_32x32x16_bf16(*(const LAS bf16x8*)(vt + lq * ATT_VPITCH + (16 * d0 + 8 * hi) * 2), qf[d0], a, 0, 0, 0);
        sc[t] = a;
        asm volatile("" ::: "memory");
    }
#undef ATT_KLOAD
    v4u vst[5][4];
#define ATT_VLOAD(t) do { _Pragma("unroll") for (int i = 0; i < 4; ++i) { int uk_ = u0 - 64 + 32 * (t) + vrow + 8 * i; uk_ = uk_ < 0 ? 0 : (uk_ > L - 1 ? L - 1 : uk_); vst[t][i] = *(const v4u*)(base + (size_t)uk_ * ustride + P_VA + 8 * vch); } } while (0)
    ATT_VLOAD(0); ATT_VLOAD(1);
    const float slope2 = exp2f(-(float)(h + 1)) * (float)r * 1.4426950408889634f, qs = 0.125f * 1.4426950408889634f;
    const float Df = (float)(4 * hi - lq);
    float mx = -1e30f;
#pragma unroll
    for (int t = 0; t < 5; ++t)
#pragma unroll
        for (int i = 0; i < 16; ++i) {
            const float diff = (float)(32 * t + (i & 3) + 8 * (i >> 2) - 64) + Df;
            float v = fmaf(sc[t][i], qs, -slope2 * fabsf(diff));
            if (t == 0) v = diff >= -64.f ? v : -1e30f;
            if (t == 4) v = diff <= 64.f ? v : -1e30f;
            sc[t][i] = v;
        }
    if (u0 < 64 || u0 + 96 > L) {
#pragma unroll
        for (int t = 0; t < 5; ++t)
#pragma unroll
            for (int i = 0; i < 16; ++i) { const int uk = u0 - 64 + 32 * t + (i & 3) + 8 * (i >> 2) + 4 * hi; if (uk < 0 || uk >= L) sc[t][i] = -1e30f; }
    }
#pragma unroll
    for (int t = 0; t < 5; ++t)
#pragma unroll
        for (int i = 0; i < 16; ++i) mx = fmaxf(mx, sc[t][i]);
    mx = fmaxf(mx, __shfl_xor(mx, 32));
    float l = 0.f;
#pragma unroll
    for (int t = 0; t < 5; ++t)
#pragma unroll
        for (int i = 0; i < 16; ++i) { const float e = __builtin_amdgcn_exp2f(sc[t][i] - mx); sc[t][i] = e; l += e; }
    l += __shfl_xor(l, 32);
    const float il = __builtin_amdgcn_rcpf(l);
    unsigned pf[5][2][4];
#pragma unroll
    for (int t = 0; t < 5; ++t)
#pragma unroll
        for (int s = 0; s < 2; ++s)
#pragma unroll
            for (int w = 0; w < 4; ++w) pf[t][s][w] = cvtpk(sc[t][8 * s + 2 * w], sc[t][8 * s + 2 * w + 1]);
    f32x16 o0 = {}, o1 = {};
    const int i16 = lane & 15, g16 = (lane >> 4) & 1;
    const LAS unsigned char* trb = vt + (4 * hi + (i16 >> 2)) * ATT_VPITCH + (16 * g16 + 4 * (i16 & 3)) * 2;
#pragma unroll
    for (int t = 0; t < 5; ++t) {
#pragma unroll
        for (int i = 0; i < 4; ++i) *(LAS v4u*)(vt + (vrow + 8 * i) * ATT_VPITCH + vch * 16) = vst[t][i];
        asm volatile("" ::: "memory");
        if (t == 0) ATT_VLOAD(2);
        if (t == 1) ATT_VLOAD(3);
        if (t == 2) ATT_VLOAD(4);
#pragma unroll
        for (int s = 0; s < 2; ++s) {
#pragma unroll
            for (int dt = 0; dt < 2; ++dt) {
                const LAS unsigned char* pa = trb + (16 * s) * ATT_VPITCH + dt * 64;
                const v4i16_t lo = __builtin_amdgcn_ds_read_tr16_b64_v4i16((LAS v4i16_t*)pa);
                const v4i16_t hh = __builtin_amdgcn_ds_read_tr16_b64_v4i16((LAS v4i16_t*)(pa + 8 * ATT_VPITCH));
                const bf16x8 vf = (bf16x8){lo[0], lo[1], lo[2], lo[3], hh[0], hh[1], hh[2], hh[3]};
                const v4u pw = (v4u){pf[t][s][0], pf[t][s][1], pf[t][s][2], pf[t][s][3]};
                if (dt == 0) o0 = __builtin_amdgcn_mfma_f32_32x32x16_bf16(vf, __builtin_bit_cast(bf16x8, pw), o0, 0, 0, 0);
                else o1 = __builtin_amdgcn_mfma_f32_32x32x16_bf16(vf, __builtin_bit_cast(bf16x8, pw), o1, 0, 0, 0);
            }
        }
        asm volatile("" ::: "memory");
    }
#undef ATT_VLOAD
    const size_t tok = (size_t)b * SEQ + (size_t)(u0 + lq) * r + c;
    typedef unsigned u32x2 __attribute__((ext_vector_type(2)));
#pragma unroll
    for (int qd = 0; qd < 4; ++qd) {
        *(LAS u32x2*)(vt + lq * ATT_VPITCH + (4 * hi + 8 * qd) * 2) = (u32x2){cvtpk(o0[4 * qd] * il, o0[4 * qd + 1] * il), cvtpk(o0[4 * qd + 2] * il, o0[4 * qd + 3] * il)};
        *(LAS u32x2*)(vt + lq * ATT_VPITCH + (32 + 4 * hi + 8 * qd) * 2) = (u32x2){cvtpk(o1[4 * qd] * il, o1[4 * qd + 1] * il), cvtpk(o1[4 * qd + 2] * il, o1[4 * qd + 3] * il)};
    }
    asm volatile("" ::: "memory");
#pragma unroll
    for (int i = 0; i < 4; ++i) {
        const v4u ov = *(const LAS v4u*)(vt + (vrow + 8 * i) * ATT_VPITCH + vch * 16);
        *(v4u*)(OP + ((size_t)p * M + (size_t)b * SEQ + (size_t)(u0 + vrow + 8 * i) * r + c) * 512 + h * 64 + 8 * vch) = ov;
    }
    asm volatile("" ::: "memory");
    if (hi == 0) LSE[((size_t)p * M + tok) * 8 + h] = (mx + __builtin_amdgcn_logf(l)) * 0.6931471805599453f;
}
__device__ __forceinline__ void attn_phase(const Ptrs& P, LAS unsigned char* lds, int vcu, int G, int wave, int lane, int i0 = 0, int i1 = 1 << 30) {
    const bf16* proj = (const bf16*)(P.ws + WS_PROJ); bf16* OP = (bf16*)(P.ws + WS_OP); float* LSE = (float*)(P.ws + WS_LSE);
    LAS unsigned char* vt = lds + RING_OFF + wave * ATT_WAVE_LDS;
    for (int i = i0, unit = (vcu + i0 * G) * NWAVES + wave; i < i1 && unit < BATCH * 8 * 3 * 128; ++i, unit += G * NWAVES) attn_unit(proj, OP, LSE, vt, unit, lane);
}
__device__ __forceinline__ void merge_attn(const Ptrs& P, int G, int wave, int lane) {
    const bf16* OP = (const bf16*)(P.ws + WS_OP); const float* LSE = (const float*)(P.ws + WS_LSE); bf16* YAB = (bf16*)(P.ws + WS_YAB);
    for (int m = blockIdx.x * NWAVES + wave; m < M; m += G * NWAVES) {
        const int h = lane >> 3;
        const float l0 = LSE[(size_t)m * 8 + h], l1 = LSE[((size_t)M + m) * 8 + h], l2 = LSE[((size_t)2 * M + m) * 8 + h];
        const float mx = fmaxf(l0, fmaxf(l1, l2)), e0 = __expf(l0 - mx), e1 = __expf(l1 - mx), e2 = __expf(l2 - mx), inv = 1.f / (e0 + e1 + e2);
        const float w0 = e0 * inv, w1 = e1 * inv, w2 = e2 * inv;
        const v4u a = *(const v4u*)(OP + (size_t)m * 512 + lane * 8), bb = *(const v4u*)(OP + ((size_t)M + m) * 512 + lane * 8), cc = *(const v4u*)(OP + ((size_t)2 * M + m) * 512 + lane * 8);
        v4u o;
#define MG(x) pk2(w0 * __uint_as_float(a.x << 16) + w1 * __uint_as_float(bb.x << 16) + w2 * __uint_as_float(cc.x << 16), w0 * __uint_as_float(a.x & 0xffff0000u) + w1 * __uint_as_float(bb.x & 0xffff0000u) + w2 * __uint_as_float(cc.x & 0xffff0000u))
        o.x = MG(x); o.y = MG(y); o.z = MG(z); o.w = MG(w);
#undef MG
        *(v4u*)(YAB + (size_t)m * KAB + lane * 8) = o;
    }
}
constexpr int GL_QN = 0, GL_KN = 18432, GL_KT = 36864, GL_VT = 57472;
constexpr int GTS = 2576;
__device__ __forceinline__ constexpr int gl_mat(int d, int which) { return d == 0 ? 78080 + which * 10240 : (which < 2 ? 108800 + which * 10240 : 140800); }
static_assert(GL_VT + 8 * GTS == 78080 && gl_mat(1, 1) + 10240 <= RING_BYTES && GTAB_OFF + 7680 <= 140800 && 140800 + 10240 <= LDS_BYTES, "prep LDS map");
constexpr int GP128 = 288, GP64 = 160;
__device__ __forceinline__ bf16x8 ldfrag(const LAS unsigned char* base, int pitch, int r0, int k0, int lane) { return *(const LAS bf16x8*)(base + (r0 + (lane & 15)) * pitch + (k0 + 8 * (lane >> 4)) * 2); }
typedef unsigned u32x2 __attribute__((ext_vector_type(2)));
#define WG_BAR() do { asm volatile("s_waitcnt lgkmcnt(0)" ::: "memory"); __builtin_amdgcn_s_barrier(); asm volatile("" ::: "memory"); } while (0)
__device__ __forceinline__ float softplusf_(float x) { return x > 20.f ? x : log1pf(__expf(x)); }

struct CvIn { f32x4 v[8]; };
__device__ __forceinline__ void cv_decode(int p, const Ptrs& P, const float*& W, bf16*& WT, int& N, int& k0, int& n0, int& d0) {
    if (p < 32768) { const int e = p >> 10, r = p & 1023, kb = r >> 6, nb = r & 63; N = 2048; k0 = 64 * kb; n0 = 32 * nb;
        W = P.w_gu + (size_t)e * 1024 * 2048; WT = (bf16*)(P.ws + WS_WGU) + (size_t)e * 2048 * 1024;
        d0 = n0 < 1024 ? 256 * (n0 / 128) + (n0 % 128) : 256 * ((n0 - 1024) / 128) + 128 + ((n0 - 1024) % 128);
    } else { const int pp = p - 32768, e = pp >> 9, r = pp & 511, kb = r >> 5, nb = r & 31; N = 1024; k0 = 64 * kb; n0 = 32 * nb;
        W = P.w_d + (size_t)e * 1024 * 1024; WT = (bf16*)(P.ws + WS_WD) + (size_t)e * 1024 * 1024; d0 = n0; }
}
__device__ __forceinline__ void cv_load(CvIn& C, const Ptrs& P, int p, int lane) {
    const float* W; bf16* WT; int N, k0, n0, d0; cv_decode(p, P, W, WT, N, k0, n0, d0);
    const float* src = W + (size_t)(k0 + 4 * (lane >> 3)) * N + n0 + 4 * (lane & 7);
#pragma unroll
    for (int b = 0; b < 2; ++b)
#pragma unroll
        for (int j = 0; j < 4; ++j) C.v[b * 4 + j] = *(const f32x4*)(src + (size_t)(32 * b + j) * N);
}
__device__ __forceinline__ void cv_store(const CvIn& C, const Ptrs& P, int p, int lane, LAS unsigned char* buf) {
    const float* W; bf16* WT; int N, k0, n0, d0; cv_decode(p, P, W, WT, N, k0, n0, d0);
    const int r8 = lane >> 3, c4 = lane & 7;
#pragma unroll
    for (int b = 0; b < 2; ++b)
#pragma unroll
        for (int e = 0; e < 4; ++e)
            *(LAS u32x2*)(buf + (4 * c4 + e) * 128 + 16 * (((r8 >> 1) + 4 * b) ^ c4) + 8 * (r8 & 1)) = (u32x2){pk2(C.v[b * 4][e], C.v[b * 4 + 1][e]), pk2(C.v[b * 4 + 2][e], C.v[b * 4 + 3][e])};
    asm volatile("" ::: "memory");
#pragma unroll
    for (int t = 0; t < 4; ++t) { const int n = 8 * t + r8;
        const v4u d = *(const LAS v4u*)(buf + n * 128 + 16 * (c4 ^ ((n >> 2) & 7)));
        *(v4u*)(WT + (size_t)(d0 + n) * 1024 + k0 + 8 * c4) = d; }
    asm volatile("" ::: "memory");
}
constexpr int CV_PAIRS = 49152;
__device__ __forceinline__ void st_rowmajor(LAS unsigned char* mat, const f32x4& p, int rb, int c) {
#pragma unroll
    for (int rho = 0; rho < 4; ++rho) *(LAS bf16*)(mat + (rb + rho) * GP64 + c * 2) = (bf16)f2bf(p[rho]);
}
__device__ __forceinline__ void gdn_prep_item(const Ptrs& P, LAS unsigned char* lds, int bh, int n, int cvbase, bool has_next, unsigned (&TCH)[4], int tid, int wave, int lane, int pmode = 0) {
    const bool nost = pmode & 1, nold = pmode & 2, junk = pmode & 8;
#define JNK(T, p) (junk ? (T)(P.ws + ((size_t)504 << 20) + ((size_t)((unsigned char*)(p) - P.ws) & (((size_t)64 << 20) - 1))) : (p))
    asm volatile("" : "+v"(tid), "+v"(lane));
    const int b = bh >> 3, h = bh & 7, item = bh * 64 + n; const size_t m0 = (size_t)b * SEQ + n * 64;
    const bf16* proj = (const bf16*)(P.ws + WS_PROJ);
    LAS float* SM = (LAS float*)(lds + ETAB_OFF);
    const LAS float* CW = (const LAS float*)(lds + GTAB_OFF);
    float* EG = (float*)(P.ws + WS_GEG);
    const int rp = tid >> 4, part = tid & 15;
    v4u xn[6];
#pragma unroll
    for (int i = 0; i < 6; ++i) { const int t = n * 64 + 2 * rp + i - 2; xn[i] = (v4u){0u, 0u, 0u, 0u};
        if (t >= 0 && t < SEQ && !nold) xn[i] = *(const v4u*)(proj + ((size_t)b * SEQ + t) * NINP + P_QB + h * 128 + part * 8); }
    asm volatile("" ::: "memory");
    if (wave == 0 && !(pmode & 16)) {
        const bf16* pr = proj + (m0 + lane) * NINP;
        const float gf = -__expf(P.a_log_f[h]) * softplusf_(bf2f(pr[P_AF + h]) + P.dtb_f[h]);
        const float gb = -__expf(P.a_log_b[h]) * softplusf_(bf2f(pr[P_AB + h]) + P.dtb_b[h]);
        float cf = gf, cb = gb;
#pragma unroll
        for (int o = 1; o < 64; o <<= 1) { const float t1 = __shfl_up(cf, o), t2 = __shfl_down(cb, o); if (lane >= o) cf += t1; if (lane + o < 64) cb += t2; }
        SM[lane] = cf; SM[64 + lane] = cb; SM[128 + lane] = 1.f / (1.f + __expf(-bf2f(pr[P_BF + h]))); SM[192 + lane] = 1.f / (1.f + __expf(-bf2f(pr[P_BB + h])));
        const float cfl = __shfl(cf, 63), cb0 = __shfl(cb, 0);
        if (!nost && !junk) { EG[(size_t)item * 64 + lane] = __expf(cf); EG[(size_t)(2048 + item) * 64 + lane] = __expf(cb);
        EG[(size_t)(4096 + item) * 64 + lane] = __expf(cfl - cf); EG[(size_t)(6144 + item) * 64 + lane] = __expf(cb0 - cb); }
    }
    {
        bf16* Qg = (bf16*)(P.ws + WS_GQ);
#pragma unroll
        for (int which = 0; which < 3; ++which) {
            v4u x[6];
#pragma unroll
            for (int i = 0; i < 6; ++i) x[i] = xn[i];
            asm volatile("" ::: "memory");
            if (which < 2) {
#pragma unroll
                for (int i = 0; i < 6; ++i) { const int t = n * 64 + 2 * rp + i - 2; xn[i] = (v4u){0u, 0u, 0u, 0u};
                    if (t >= 0 && t < SEQ && !nold) xn[i] = *(const v4u*)(proj + ((size_t)b * SEQ + t) * NINP + P_QB + (which + 1) * 1024 + h * 128 + part * 8); }
            }
            asm volatile("" ::: "memory");
            float a[2][8];
#pragma unroll
            for (int o = 0; o < 2; ++o)
#pragma unroll
                for (int c = 0; c < 8; ++c) a[o][c] = 0.f;
#pragma unroll
            for (int j = 0; j < 5; ++j) {
                const LAS f32x4* wp = (const LAS f32x4*)(CW + (j * 3 + which) * 128 + part * 8);
                const f32x4 w0 = wp[0], w1 = wp[1];
#pragma unroll
                for (int o = 0; o < 2; ++o) { const v4u xv = x[o + j];
                    a[o][0] += __uint_as_float(xv.x << 16) * w0.x; a[o][1] += __uint_as_float(xv.x & 0xffff0000u) * w0.y; a[o][2] += __uint_as_float(xv.y << 16) * w0.z; a[o][3] += __uint_as_float(xv.y & 0xffff0000u) * w0.w;
                    a[o][4] += __uint_as_float(xv.z << 16) * w1.x; a[o][5] += __uint_as_float(xv.z & 0xffff0000u) * w1.y; a[o][6] += __uint_as_float(xv.w << 16) * w1.z; a[o][7] += __uint_as_float(xv.w & 0xffff0000u) * w1.w; }
            }
#pragma unroll
            for (int o = 0; o < 2; ++o) {
                float ss = 0.f;
#pragma unroll
                for (int c = 0; c < 8; ++c) { a[o][c] = a[o][c] * __builtin_amdgcn_rcpf(1.f + __expf(-a[o][c])); ss += a[o][c] * a[o][c]; }
                if (which < 2) {
                    ss += __shfl_xor(ss, 1); ss += __shfl_xor(ss, 2); ss += __shfl_xor(ss, 4); ss += __shfl_xor(ss, 8);
                    const float rn = rsqrtf(ss + EPS) * (which == 0 ? 0.08838834764831845f : 1.f);
#pragma unroll
                    for (int c = 0; c < 8; ++c) a[o][c] *= rn;
                    v4u ov; ov.x = pk2(a[o][0], a[o][1]); ov.y = pk2(a[o][2], a[o][3]); ov.z = pk2(a[o][4], a[o][5]); ov.w = pk2(a[o][6], a[o][7]);
                    *(LAS v4u*)(lds + (which == 0 ? GL_QN : GL_KN) + (2 * rp + o) * GP128 + part * 16) = ov;
                    if (which == 0 && !nost) *JNK(v4u*, (v4u*)(Qg + (m0 + 2 * rp + o) * 1024 + h * 128 + part * 8)) = ov;
                }
            }
            if (which >= 1) {
                LAS unsigned char* tp = lds + (which == 1 ? GL_KT : GL_VT) + (part >> 1) * GTS + ((part & 1) * 8) * GP64 + (2 * rp) * 2;
#pragma unroll
                for (int c = 0; c < 8; ++c) *(LAS unsigned*)(tp + c * GP64) = pk2(a[0][c], a[1][c]);
            }
        }
    }
    WG_BAR();
    if (has_next && !(pmode & 4)) {
        const bf16* tp_;
        if (tid < 408) { const int row = tid / 6, seg = tid % 6; int t = (n + 1) * 64 + row - 2; t = t < 0 ? 0 : (t > SEQ - 1 ? SEQ - 1 : t);
            tp_ = proj + ((size_t)b * SEQ + t) * NINP + P_QB + (seg >> 1) * 1024 + h * 128 + (seg & 1) * 64; }
        else { const int row = tid < 472 ? tid - 408 : 0; tp_ = proj + ((size_t)b * SEQ + (n + 1) * 64 + row) * NINP + P_AF; }
        asm volatile("global_load_dword %0, %1, off" : "+v"(TCH[0]) : "v"(tp_) : "memory");
    }
    { const int dk = tid >> 2, seg = tid & 3; bf16* KTg = (bf16*)(P.ws + WS_GKT) + (size_t)item * 8192 + dk * 64 + seg * 16;
      const LAS v4u* sp = (const LAS v4u*)(lds + GL_KT + (dk >> 4) * GTS + (dk & 15) * GP64 + seg * 32); if (!nost) { *JNK(v4u*, (v4u*)KTg) = sp[0]; *JNK(v4u*, (v4u*)(KTg + 8)) = sp[1]; } }
    const int q4 = lane >> 4, l16 = lane & 15;
    f32x4 accR[2][2];
#pragma unroll 1
    for (int rep2_ = 0; rep2_ < ((PREP_PROBE & 6) ? 2 : 1); ++rep2_) {
    if (rep2_ == 1) WG_BAR();
#pragma unroll
    for (int x = 0; x < 2; ++x) {
        const int tl = 2 * wave + x, mi = tl >> 2, nj = tl & 3, c = nj * 16 + l16, rb = mi * 16 + 4 * q4;
        f32x4 g = {0.f, 0.f, 0.f, 0.f}, qk = {0.f, 0.f, 0.f, 0.f};
#pragma unroll
        for (int kk = 0; kk < 4; ++kk) {
            const bf16x8 am = ldfrag(lds + GL_KN, GP128, mi * 16, kk * 32, lane), bn = ldfrag(lds + GL_KN, GP128, nj * 16, kk * 32, lane), qn = ldfrag(lds + GL_QN, GP128, nj * 16, kk * 32, lane);
            g = __builtin_amdgcn_mfma_f32_16x16x32_bf16(am, bn, g, 0, 0, 0);
            qk = __builtin_amdgcn_mfma_f32_16x16x32_bf16(am, qn, qk, 0, 0, 0);
        }
#pragma unroll
        for (int d = 0; d < 2; ++d) {
            const float gcc = SM[64 * d + c], bc = SM[128 + 64 * d + c];
            const f32x4 gcr = *(const LAS f32x4*)(SM + 64 * d + rb), br = *(const LAS f32x4*)(SM + 128 + 64 * d + rb);
            float at[4], am2[4], qv[4];
#pragma unroll
            for (int rho = 0; rho < 4; ++rho) {
                const int rr = rb + rho;
                const bool low = d == 0 ? (rr > c) : (rr < c);
                const bool upp = d == 0 ? (c > rr) : (c < rr);
                const float e1 = __expf(fminf(gcr[rho] - gcc, 0.f)), e2 = __expf(fminf(gcc - gcr[rho], 0.f));
                at[rho] = low ? br[rho] * e1 * g[rho] : 0.f;
                am2[rho] = upp ? bc * e2 * g[rho] : 0.f;
                const bool qm = d == 0 ? (rr <= c) : (rr >= c);
                qv[rho] = qm ? e2 * qk[rho] : 0.f;
                accR[d][x][rho] = (rr == c ? 1.f : 0.f) - at[rho];
            }
            *(LAS u32x2*)(lds + gl_mat(d, 1) + c * GP64 + rb * 2) = (u32x2){pk2(at[0], at[1]), pk2(at[2], at[3])};
            *(LAS u32x2*)(lds + gl_mat(d, 0) + c * GP64 + rb * 2) = (u32x2){pk2(am2[0], am2[1]), pk2(am2[2], am2[3])};
            *(LAS u32x2*)(lds + gl_mat(d, 2) + c * GP64 + rb * 2) = (u32x2){pk2((rb == c ? 1.f : 0.f) - am2[0], (rb + 1 == c ? 1.f : 0.f) - am2[1]), pk2((rb + 2 == c ? 1.f : 0.f) - am2[2], (rb + 3 == c ? 1.f : 0.f) - am2[3])};
            bf16* qg = (bf16*)(P.ws + WS_GQK) + ((size_t)(d * 2048 + item) * 64 + c) * 64 + rb;
            if (!nost) *JNK(u32x2*, (u32x2*)qg) = (u32x2){pk2(qv[0], qv[1]), pk2(qv[2], qv[3])};
        }
    }
    WG_BAR();
    if ((PREP_PROBE & 2) && rep2_ == 0) continue;
    const int cvb = (rep2_ == ((PREP_PROBE & 6) ? 1 : 0)) ? cvbase : -1;
    CvIn CV;
#pragma unroll
    for (int j = 0; j < 8; ++j) CV.v[j] = (f32x4){0.f, 0.f, 0.f, 0.f};
    auto stage = [&](const int s) __attribute__((always_inline)) {
        f32x4 accP[2][2];
#pragma unroll
        for (int d = 0; d < 2; ++d) {
#pragma unroll
            for (int x = 0; x < 2; ++x) {
                const int tl = 2 * wave + x, mi = tl >> 2, nj = tl & 3;
                f32x4 p = {0.f, 0.f, 0.f, 0.f}; f32x4 rr = accR[d][x];
                if (d == 0 ? (mi >= nj) : (mi <= nj))
#pragma unroll
                for (int kk = 0; kk < 2; ++kk) {
                    const bf16x8 pm = ldfrag(lds + gl_mat(d, 0), GP64, mi * 16, kk * 32, lane), pt = ldfrag(lds + gl_mat(d, 1), GP64, nj * 16, kk * 32, lane), rm = ldfrag(lds + gl_mat(d, 2), GP64, mi * 16, kk * 32, lane);
                    p = __builtin_amdgcn_mfma_f32_16x16x32_bf16(pm, pt, p, 0, 0, 0);
                    rr = __builtin_amdgcn_mfma_f32_16x16x32_bf16(rm, pt, rr, 0, 0, 0);
                }
                accP[d][x] = p; if (s >= 2) accR[d][x] = rr;
            }
        }
        WG_BAR();
#pragma unroll
        for (int d = 0; d < 2; ++d) {
#pragma unroll
            for (int x = 0; x < 2; ++x) {
                const int tl = 2 * wave + x, mi = tl >> 2, nj = tl & 3, c = nj * 16 + l16, rb = mi * 16 + 4 * q4;
                if (!(d == 0 ? (mi >= nj) : (mi <= nj))) continue;
                if (s < 6) {
                    const f32x4 p = accP[d][x];
                    *(LAS u32x2*)(lds + gl_mat(d, 1) + c * GP64 + rb * 2) = (u32x2){pk2(p[0], p[1]), pk2(p[2], p[3])};
                    st_rowmajor(lds + gl_mat(d, 0), p, rb, c); st_rowmajor(lds + gl_mat(d, 2), accR[d][x], rb, c);
                } else {
                    const float bc = SM[128 + 64 * d + c], bg = bc * __expf(SM[64 * d + c]);
                    st_rowmajor(lds + gl_mat(d, 2), accR[d][x] * bc, rb, c); st_rowmajor(lds + gl_mat(d, 0), accR[d][x] * bg, rb, c);
                }
            }
        }
        WG_BAR();
    };
#pragma unroll 1
    for (int sp = 0; sp < 3; ++sp) {
        if (cvb >= 0) cv_load(CV, P, cvb + sp * 2048, lane);
        stage(2 * sp + 1); stage(2 * sp + 2);
        asm volatile("" :: "v"(CV.v[0]), "v"(CV.v[1]), "v"(CV.v[2]), "v"(CV.v[3]), "v"(CV.v[4]), "v"(CV.v[5]), "v"(CV.v[6]), "v"(CV.v[7]));
        if (cvb >= 0) cv_store(CV, P, cvb + sp * 2048, lane, lds + GL_QN + wave * 4096);
    }
    }
#pragma unroll 1
    for (int rep3_ = 0; rep3_ < ((PREP_PROBE & 8) ? 2 : 1); ++rep3_)
#pragma unroll
    for (int d = 0; d < 2; ++d) {
        bf16* UTg = (bf16*)(P.ws + WS_GUT) + (size_t)(d * 2048 + item) * 8192; bf16* Wg = (bf16*)(P.ws + WS_GW) + (size_t)(d * 2048 + item) * 8192;
#pragma unroll
        for (int xp = 0; xp < 2; ++xp) {
            unsigned ua[2][2], wa[2][2];
#pragma unroll
            for (int xx = 0; xx < 2; ++xx) {
                const int tl = wave + 8 * (2 * xp + xx);
                { const int mi = tl >> 3, nj = tl & 7;
                  f32x4 u = {0.f, 0.f, 0.f, 0.f};
#pragma unroll
                  for (int kk = 0; kk < 2; ++kk) u = __builtin_amdgcn_mfma_f32_16x16x32_bf16(ldfrag(lds + gl_mat(d, 2), GP64, mi * 16, kk * 32, lane), ldfrag(lds + GL_VT + nj * GTS, GP64, 0, kk * 32, lane), u, 0, 0, 0);
                  ua[xx][0] = pk2(u[0], u[1]); ua[xx][1] = pk2(u[2], u[3]); }
                { const int md = tl >> 2, ni = tl & 3;
                  f32x4 w = {0.f, 0.f, 0.f, 0.f};
#pragma unroll
                  for (int kk = 0; kk < 2; ++kk) w = __builtin_amdgcn_mfma_f32_16x16x32_bf16(ldfrag(lds + GL_KT + md * GTS, GP64, 0, kk * 32, lane), ldfrag(lds + gl_mat(d, 0), GP64, ni * 16, kk * 32, lane), w, 0, 0, 0);
                  wa[xx][0] = pk2(w[0], w[1]); wa[xx][1] = pk2(w[2], w[3]); }
            }
            const int odd = q4 & 1, p8 = q4 >> 1, tls = wave + 8 * (2 * xp + odd);
            { const auto r0 = __builtin_amdgcn_permlane16_swap(ua[0][0], ua[1][0], false, false), r1 = __builtin_amdgcn_permlane16_swap(ua[0][1], ua[1][1], false, false);
              const int mi = tls >> 3, nj = tls & 7;
              if (!nost) *JNK(v4u*, (v4u*)(UTg + (nj * 16 + l16) * 64 + mi * 16 + 8 * p8)) = (v4u){r0[0], r1[0], r0[1], r1[1]}; }
            { const auto r0 = __builtin_amdgcn_permlane16_swap(wa[0][0], wa[1][0], false, false), r1 = __builtin_amdgcn_permlane16_swap(wa[0][1], wa[1][1], false, false);
              const int md = tls >> 2, ni = tls & 3;
              if (!nost) *JNK(v4u*, (v4u*)(Wg + (ni * 16 + l16) * 128 + md * 16 + 8 * p8)) = (v4u){r0[0], r1[0], r0[1], r1[1]}; }
        }
    }
    WG_BAR();
}
__device__ __forceinline__ void gdn_prep_phase(const Ptrs& P, LAS unsigned char* lds, int vcu, int G, int tid, int wave, int lane, bool ride = true, int pmode = 0) {
    unsigned TCH[4] = {0u, 0u, 0u, 0u};
    for (int it = vcu * 8; it < 2048; it += G * 8) {
        const int bh = it >> 6;
        LAS float* CW = (LAS float*)(lds + GTAB_OFF); const int h = bh & 7;
        __syncthreads();
        for (int i = tid; i < 5 * 3 * 128; i += 512) { const int j = i / 384, rem = i % 384, which = rem >> 7, ch = rem & 127; CW[i] = P.conv_w[j * 3072 + which * 1024 + h * 128 + ch]; }
        WG_BAR();
        for (int k = 0; k < 8; ++k) gdn_prep_item(P, lds, bh, (it & 63) + k, (G == 256 && ride) ? k * 3 * 2048 + vcu * 8 + wave : -1, k < 7, TCH, tid, wave, lane, pmode);
    }
    asm volatile("s_waitcnt vmcnt(0)" : "+v"(TCH[0]), "+v"(TCH[1]), "+v"(TCH[2]), "+v"(TCH[3]) :: "memory");
}

template <int MODE>
__device__ __forceinline__ void store_probe(const Ptrs& P, int vcu, int wave, int lane) {
    unsigned char* junk = P.ws + ((size_t)504 << 20);
    const int q4 = lane >> 4, l16 = lane & 15;
    v4u val = {(unsigned)lane, 1u, 2u, 3u};
#pragma unroll 1
    for (int rep = 0; rep < 4; ++rep)
#pragma unroll 1
    for (int k = 0; k < 8; ++k) {
        const size_t ibase = (((size_t)((rep * 8 + k) * 256 + vcu)) * 65536) & (((size_t)64 << 20) - 1);
        asm volatile("" : "+v"(val));
        if (MODE == 1) {
#pragma unroll
            for (int j = 0; j < 8; ++j) { const int jj = (wave * 8 + j) >> 1; *(v4u*)(junk + ibase + (size_t)(jj * 16 + l16) * 128 + (j & 1) * 64 + q4 * 16) = val; }
        } else if (MODE == 2) {
#pragma unroll
            for (int j = 0; j < 8; ++j) *(v4u*)(junk + ibase + (size_t)((wave * 8 + j) * 8 + (lane >> 3)) * 128 + (lane & 7) * 16) = val;
        } else if (MODE == 3) {
#pragma unroll
            for (int j = 0; j < 16; ++j) { const int jj = (wave * 16 + j) >> 2; *(u32x2*)(junk + ibase + (size_t)(jj * 16 + l16) * 128 + (j & 3) * 32 + q4 * 8) = (u32x2){val.x, val.y}; }
        } else if (MODE == 5) {
#pragma unroll
            for (int j = 0; j < 8; ++j) { const int jj = (wave * 8 + j) >> 1; *(v4u*)(junk + ibase + (size_t)(jj * 16 + (lane >> 2)) * 128 + (j & 1) * 64 + (lane & 3) * 16) = val; }
        } else if (MODE == 6) {
#pragma unroll
            for (int j = 0; j < 8; ++j) *(v4u*)(junk + ((ibase * 64) & (((size_t)64 << 20) - 1)) + (size_t)l16 * 4096 + (size_t)(wave * 8 + j) * 64 + q4 * 16) = val;
        } else if (MODE == 7) {
#pragma unroll
            for (int j = 0; j < 8; ++j) *(v4u*)(junk + ((ibase * 64) & (((size_t)64 << 20) - 1)) + (size_t)(lane >> 2) * 4096 + (size_t)(wave * 8 + j) * 64 + (lane & 3) * 16) = val;
        } else if (MODE == 4) {
#pragma unroll
            for (int j = 0; j < 8; ++j) { const int row = (wave * 4 + (j >> 1)) * 32 + (lane & 31); *(v4u*)(junk + ((ibase * 4) & (((size_t)64 << 20) - 1)) + (size_t)row * 2048 / 8 * 8 + (lane >> 5) * 32 + (j & 1) * 16) = val; }
        }
    }
}
constexpr int SC_SLOT = 62464, SC_W = 0, SC_Q = 16384, SC_KT = 32768, SC_QK = 49152, SC_UT = 57344, SC_EG = 61440;
constexpr int SL_ST = GTAB_OFF, SL_VN = SL_ST + 32 * GP128, SL_VS = SL_VN + 32 * GP64;
constexpr int SL_OB = SL_VS + 32 * GP64;
static_assert(2 * SC_SLOT <= RING_BYTES && SL_OB + 4096 <= LDS_BYTES && SL_OB % 16 == 0, "scan LDS map");
#define SC_GLDS(src, dst) __builtin_amdgcn_global_load_lds((const unsigned*)(src), (LAS unsigned*)(dst), 16, 0, 0)
__device__ __forceinline__ void scan_issue(const Ptrs& P, LAS unsigned char* lds, int slot, int bh, int d, int sl, int n, int wave, int lane) {
    if (wave >= 7) return;
    const int item = bh * 64 + n, b = bh >> 3, h = bh & 7;
    const char* Wb = (const char*)(P.ws + WS_GW) + ((size_t)(d * 2048 + item) * 8192) * 2;
    const char* Qb = (const char*)(P.ws + WS_GQ) + (((size_t)b * SEQ + n * 64) * 1024 + h * 128) * 2;
    const char* KTb = (const char*)(P.ws + WS_GKT) + ((size_t)item * 8192) * 2;
    const char* QKb = (const char*)(P.ws + WS_GQK) + ((size_t)(d * 2048 + item) * 4096) * 2;
    const char* UTb = (const char*)(P.ws + WS_GUT) + ((size_t)(d * 2048 + item) * 8192 + (sl * 32) * 64) * 2;
    LAS unsigned char* sb = lds + slot * SC_SLOT;
    const int r4 = lane >> 4, s16 = lane & 15, r8 = lane >> 3, s8 = lane & 7;
#pragma unroll
    for (int i = 0; i < 9; ++i) {
        const int pc = wave + 7 * i;
        if (pc < 32) {
            const int pp = pc & 15, row = pp * 4 + r4, c = (s16 - row) & 15;
            if (pc < 16) SC_GLDS(Wb + row * 256 + c * 16, sb + SC_W + pp * 1024); else SC_GLDS(Qb + (size_t)row * 2048 + c * 16, sb + SC_Q + pp * 1024);
        } else if (pc < 60) {
            const int pp = pc < 48 ? pc - 32 : (pc < 56 ? pc - 48 : pc - 56), row = pp * 8 + r8, c = (s8 - (row >> 1)) & 7;
            const char* src = (pc < 48 ? KTb : (pc < 56 ? QKb : UTb)) + row * 128 + c * 16;
            SC_GLDS(src, sb + (pc < 48 ? SC_KT : (pc < 56 ? SC_QK : SC_UT)) + pp * 1024);
        } else if (pc == 60) { const char* EGb = (const char*)(P.ws + WS_GEG) + ((size_t)((lane & 16 ? 2 + d : d) * 2048 + item) * 64) * 4 + (lane & 15) * 16; SC_GLDS(EGb, sb + SC_EG); }
    }
}
__device__ __forceinline__ bf16x8 frag256(const LAS unsigned char* t, int row, int c) { return *(const LAS bf16x8*)(t + row * 256 + (((c + row) & 15) << 4)); }
__device__ __forceinline__ bf16x8 frag128(const LAS unsigned char* t, int row, int c) { return *(const LAS bf16x8*)(t + row * 128 + (((c + (row >> 1)) & 7) << 4)); }
template <int VAR> __device__ __forceinline__ void scan_step(f32x4 (&accS)[2], f32x4& opend, const Ptrs& P, LAS unsigned char* lds, int slot, int d, int wave, int lane) {
    const int mi = wave >> 1, nj = wave & 1, l16 = lane & 15, q4 = lane >> 4;
    const LAS unsigned char* sb = lds + slot * SC_SLOT;
    const f32x4 r_eg = *(const LAS f32x4*)(sb + SC_EG + (mi * 16 + 4 * q4) * 4), r_ek = *(const LAS f32x4*)(sb + SC_EG + 256 + (mi * 16 + 4 * q4) * 4); const float r_gl = *(const LAS float*)(sb + SC_EG + (d == 0 ? 63 : 0) * 4);
    f32x4 x = {0.f, 0.f, 0.f, 0.f}, oa = {0.f, 0.f, 0.f, 0.f};
#pragma unroll
    for (int kk = 0; kk < 4; ++kk) { const bf16x8 bs = ldfrag(lds + SL_ST, GP128, nj * 16, kk * 32, lane);
        x = __builtin_amdgcn_mfma_f32_16x16x32_bf16(frag256(sb + SC_W, mi * 16 + l16, kk * 4 + q4), bs, x, 0, 0, 0);
        oa = __builtin_amdgcn_mfma_f32_16x16x32_bf16(frag256(sb + SC_Q, mi * 16 + l16, kk * 4 + q4), bs, oa, 0, 0, 0); }
    const int ur = nj * 16 + l16;
    const u32x2 u = *(const LAS u32x2*)(sb + SC_UT + ur * 128 + (((mi * 2 + (q4 >> 1) + (ur >> 1)) & 7) << 4) + (q4 & 1) * 8);
    f32x4 vn; vn[0] = __uint_as_float(u.x << 16) - x[0]; vn[1] = __uint_as_float(u.x & 0xffff0000u) - x[1]; vn[2] = __uint_as_float(u.y << 16) - x[2]; vn[3] = __uint_as_float(u.y & 0xffff0000u) - x[3];
    const int vo = (nj * 16 + l16) * GP64 + (mi * 16 + 4 * q4) * 2;
    *(LAS u32x2*)(lds + SL_VN + vo) = (u32x2){pk2(vn[0], vn[1]), pk2(vn[2], vn[3])};
    *(LAS u32x2*)(lds + SL_VS + vo) = (u32x2){pk2(vn[0] * r_ek[0], vn[1] * r_ek[1]), pk2(vn[2] * r_ek[2], vn[3] * r_ek[3])};
    WG_BAR();
    f32x4 o = oa * r_eg;
#pragma unroll
    for (int kk = 0; kk < 2; ++kk) o = __builtin_amdgcn_mfma_f32_16x16x32_bf16(frag128(sb + SC_QK, mi * 16 + l16, kk * 4 + q4), ldfrag(lds + SL_VN, GP64, nj * 16, kk * 32, lane), o, 0, 0, 0);
#pragma unroll
    for (int rho = 0; rho < 4; ++rho) *(LAS bf16*)(lds + SL_OB + (mi * 16 + 4 * q4 + rho) * 64 + ((((nj * 16 + l16) >> 3) ^ q4) << 4) + (l16 & 7) * 2) = (bf16)f2bf(o[rho]);
    opend = o;
#pragma unroll
    for (int n2 = 0; n2 < 2; ++n2) {
        f32x4 s = accS[n2] * r_gl;
#pragma unroll
        for (int kk = 0; kk < 2; ++kk) s = __builtin_amdgcn_mfma_f32_16x16x32_bf16(frag128(sb + SC_KT, wave * 16 + l16, kk * 4 + q4), ldfrag(lds + SL_VS, GP64, n2 * 16, kk * 32, lane), s, 0, 0, 0);
        accS[n2] = s;
        *(LAS u32x2*)(lds + SL_ST + (n2 * 16 + l16) * GP128 + (wave * 16 + 4 * q4) * 2) = (u32x2){pk2(s[0], s[1]), pk2(s[2], s[3])};
    }
    if (wave < 7) asm volatile("s_waitcnt vmcnt(0)" ::: "memory");
    WG_BAR();
}
template <int VAR> __device__ __forceinline__ void scan_store(const f32x4& o, const Ptrs& P, LAS unsigned char* lds, int bh, int d, int sl, int n, int wave, int lane) {
    if constexpr (!(VAR & 2)) {
        if (wave == 7) {
            const int b = bh >> 3, h = bh & 7;
            bf16* Og = (bf16*)(P.ws + ((VAR & 4) ? WS_MERGED : (d == 0 ? WS_OF : WS_OB))) + ((size_t)b * SEQ + n * 64) * 1024 + h * 128 + sl * 32;
#pragma unroll
            for (int j = 0; j < 4; ++j) { const int row = 16 * j + (lane >> 2), c = lane & 3;
                const v4u dv = *(const LAS v4u*)(lds + SL_OB + row * 64 + ((c ^ ((row >> 2) & 3)) << 4));
                *(v4u*)(Og + (size_t)row * 1024 + c * 8) = dv; }
        }
    }
}
__device__ __forceinline__ const char* scan_touch(const Ptrs& P, int bh, int d, int sl, int n, int j, int lane) {
    const int item = bh * 64 + n, b = bh >> 3, h = bh & 7;
    int id = j * 64 + lane; id = id < 144 ? id : 143;
    const char* p;
    if (id < 112) { const int L = 4 * id + sl;
        if (L < 128) p = (const char*)(P.ws + WS_GW) + ((size_t)(d * 2048 + item) * 8192) * 2 + L * 128;
        else if (L < 256) p = (const char*)(P.ws + WS_GKT) + ((size_t)item * 8192) * 2 + (L - 128) * 128;
        else if (L < 320) p = (const char*)(P.ws + WS_GQK) + ((size_t)(d * 2048 + item) * 4096) * 2 + (L - 256) * 128;
        else { const int idx = L - 320; p = (const char*)(P.ws + WS_GQ) + (((size_t)b * SEQ + n * 64 + (idx >> 1)) * 1024 + h * 128) * 2 + (idx & 1) * 128; }
    } else p = (const char*)(P.ws + WS_GUT) + ((size_t)(d * 2048 + item) * 8192 + (sl * 32) * 64) * 2 + (id - 112) * 128;
    return p;
}
template <int VAR> __device__ __forceinline__ void gdn_scan_phase(const Ptrs& P, LAS unsigned char* lds, int vcu, int G, int tid, int wave, int lane) {
    for (int wk = vcu; wk < 256; wk += G) {
        const int sl = wk & 3, d = (wk >> 2) & 1, bh = wk >> 3;
        __syncthreads();
        for (int i = tid; i < 32 * GP128 / 4; i += 512) ((LAS unsigned*)(lds + SL_ST))[i] = 0u;
        f32x4 accS[2] = {{0.f, 0.f, 0.f, 0.f}, {0.f, 0.f, 0.f, 0.f}};
        f32x4 opend = {0.f, 0.f, 0.f, 0.f};
#define SCN(s) (d == 0 ? (s) : 63 - (s))
#define SCT(s) ((s) + 4 < 64 ? (s) + 4 : 63)
#define TOUCH_LD(T, n_) do { if (wave == 7) { _Pragma("unroll") for (int j_ = 0; j_ < 3; ++j_) { const char* tp_ = scan_touch(P, bh, d, sl, (n_), j_, lane); asm volatile("global_load_dword %0, %1, off" : "+v"(T[j_]) : "v"(tp_) : "memory"); } } } while (0)
        unsigned T0[3] = {0u, 0u, 0u}, T1[3] = {0u, 0u, 0u}, T2[3] = {0u, 0u, 0u}, T3[3] = {0u, 0u, 0u};
        TOUCH_LD(T0, SCN(1)); TOUCH_LD(T1, SCN(2)); TOUCH_LD(T2, SCN(3));
        scan_issue(P, lds, 0, bh, d, sl, SCN(0), wave, lane);
        asm volatile("s_waitcnt vmcnt(0)" ::: "memory"); WG_BAR();
#define SC_STEP(s, T) do { if ((s) > 0) scan_store<VAR>(opend, P, lds, bh, d, sl, SCN((s) - 1), wave, lane); \
            if (!(VAR & 1)) scan_issue(P, lds, ((s) + 1) & 1, bh, d, sl, SCN((s) + 1 < 64 ? (s) + 1 : 63), wave, lane); \
            asm volatile("" ::: "memory"); TOUCH_LD(T, SCN(SCT(s))); \
            scan_step<VAR>(accS, opend, P, lds, (s) & 1, d, wave, lane); } while (0)
#pragma unroll 1
        for (int st = 0; st < 64; st += 4) { SC_STEP(st, T3); SC_STEP(st + 1, T0); SC_STEP(st + 2, T1); SC_STEP(st + 3, T2); }
        scan_store<VAR>(opend, P, lds, bh, d, sl, SCN(63), wave, lane);
        asm volatile("s_waitcnt vmcnt(0)" : "+v"(T0[0]), "+v"(T0[1]), "+v"(T0[2]), "+v"(T1[0]), "+v"(T1[1]), "+v"(T1[2]), "+v"(T2[0]), "+v"(T2[1]), "+v"(T2[2]), "+v"(T3[0]), "+v"(T3[1]), "+v"(T3[2]) :: "memory"); asm volatile("" :: "v"(accS[0]), "v"(accS[1]));
#undef SC_STEP
#undef TOUCH_LD
#undef SCT
#undef SCN
    }
}
__device__ __forceinline__ void gdn_out_phase(const Ptrs& P, int G, int wave, int lane) {
    const bf16* OF = (const bf16*)(P.ws + WS_OF); const bf16* OB = (const bf16*)(P.ws + WS_OB); const bf16* proj = (const bf16*)(P.ws + WS_PROJ); bf16* YAB = (bf16*)(P.ws + WS_YAB);
    float nw[16];
#pragma unroll
    for (int c = 0; c < 16; ++c) nw[c] = P.gdn_nw[(lane & 7) * 16 + c];
    for (int m = blockIdx.x * NWAVES + wave; m < M; m += G * NWAVES) {
        const v4u a0 = *(const v4u*)(OF + (size_t)m * 1024 + lane * 16), a1 = *(const v4u*)(OF + (size_t)m * 1024 + lane * 16 + 8);
        const v4u b0 = *(const v4u*)(OB + (size_t)m * 1024 + lane * 16), b1 = *(const v4u*)(OB + (size_t)m * 1024 + lane * 16 + 8);
        const v4u z0 = *(const v4u*)(proj + (size_t)m * NINP + P_ZB + lane * 16), z1 = *(const v4u*)(proj + (size_t)m * NINP + P_ZB + lane * 16 + 8);
        float v[16], z[16];
#define UNP(dst, s0, s1, op, t0, t1) dst[0] op (__uint_as_float(s0.x << 16) + __uint_as_float(t0.x << 16)); dst[1] op (__uint_as_float(s0.x & 0xffff0000u) + __uint_as_float(t0.x & 0xffff0000u)); \
        dst[2] op (__uint_as_float(s0.y << 16) + __uint_as_float(t0.y << 16)); dst[3] op (__uint_as_float(s0.y & 0xffff0000u) + __uint_as_float(t0.y & 0xffff0000u)); \
        dst[4] op (__uint_as_float(s0.z << 16) + __uint_as_float(t0.z << 16)); dst[5] op (__uint_as_float(s0.z & 0xffff0000u) + __uint_as_float(t0.z & 0xffff0000u)); \
        dst[6] op (__uint_as_float(s0.w << 16) + __uint_as_float(t0.w << 16)); dst[7] op (__uint_as_float(s0.w & 0xffff0000u) + __uint_as_float(t0.w & 0xffff0000u)); \
        dst[8] op (__uint_as_float(s1.x << 16) + __uint_as_float(t1.x << 16)); dst[9] op (__uint_as_float(s1.x & 0xffff0000u) + __uint_as_float(t1.x & 0xffff0000u)); \
        dst[10] op (__uint_as_float(s1.y << 16) + __uint_as_float(t1.y << 16)); dst[11] op (__uint_as_float(s1.y & 0xffff0000u) + __uint_as_float(t1.y & 0xffff0000u)); \
        dst[12] op (__uint_as_float(s1.z << 16) + __uint_as_float(t1.z << 16)); dst[13] op (__uint_as_float(s1.z & 0xffff0000u) + __uint_as_float(t1.z & 0xffff0000u)); \
        dst[14] op (__uint_as_float(s1.w << 16) + __uint_as_float(t1.w << 16)); dst[15] op (__uint_as_float(s1.w & 0xffff0000u) + __uint_as_float(t1.w & 0xffff0000u));
        const v4u zz = {0u, 0u, 0u, 0u};
        UNP(v, a0, a1, =, b0, b1)
        UNP(z, z0, z1, =, zz, zz)
#undef UNP
        float ss = 0.f;
#pragma unroll
        for (int c = 0; c < 16; ++c) ss += v[c] * v[c];
        ss += __shfl_xor(ss, 1); ss += __shfl_xor(ss, 2); ss += __shfl_xor(ss, 4);
        const float r = rsqrtf(ss * (1.f / 128.f) + EPS);
        float o[16];
#pragma unroll
        for (int c = 0; c < 16; ++c) o[c] = v[c] * r * nw[c] * z[c] * __builtin_amdgcn_rcpf(1.f + __expf(-z[c]));
        v4u o0, o1;
        o0.x = pk2(o[0], o[1]); o0.y = pk2(o[2], o[3]); o0.z = pk2(o[4], o[5]); o0.w = pk2(o[6], o[7]); o1.x = pk2(o[8], o[9]); o1.y = pk2(o[10], o[11]); o1.z = pk2(o[12], o[13]); o1.w = pk2(o[14], o[15]);
        *(v4u*)(YAB + (size_t)m * KAB + 512 + lane * 16) = o0; *(v4u*)(YAB + (size_t)m * KAB + 512 + lane * 16 + 8) = o1;
    }
}
__global__ void __launch_bounds__(NWAVES * 64, 2) mega_fwd(Args args) {
    extern __shared__ __attribute__((aligned(16))) unsigned char lds_raw[];
    LAS unsigned char* lds = (LAS unsigned char*)lds_raw;
    const Ptrs& P = args.p;
    const int tid = threadIdx.x, lane = tid & 63, wave = __builtin_amdgcn_readfirstlane(tid >> 6);
    const int G = gridDim.x; const int bx = blockIdx.x; const int vcu = (G % 8 == 0) ? (bx % 8) * (G / 8) + bx / 8 : bx;
    gu32* ctl = (gu32*)(P.ws + WS_CTL);
    for (int u = tid; u < (GTAB_OFF - LDSCTL_OFF) / 4; u += NWAVES * 64) ((LAS unsigned*)(lds + LDSCTL_OFF))[u] = 0u;
    __syncthreads();
    XcdBarrier bar = xcd_barrier_post((unsigned*)(ctl + CW_BAR) + args.li * XCD_BAR_WORDS, (volatile LAS unsigned*)(lds + MISC_OFF) + 8);
    const int lo = args.ph_lo, hi = args.ph_hi;
#ifndef PH_MASK
#define PH_MASK 0xffff
#endif
#define IN(k) (((PH_MASK >> (k)) & 1) && lo <= (k) && (k) < hi)
#define BOTH(k) (IN(k) && IN((k) + 1))
#ifndef PH_TWICE
#define PH_TWICE 0
#endif
#define REP(k) for (int rep_ = 0; rep_ < (((PH_TWICE >> (k)) & 1) ? 2 : 1); ++rep_)
#ifndef PH_AGAIN
#define PH_AGAIN 0
#endif
#define AGAIN(k) if ((PH_AGAIN >> (k)) & 1)
    LAS unsigned* gtab = (LAS unsigned*)(lds + GTAB_OFF);
    LAS int* etab = (LAS int*)(lds + ETAB_OFF);

    if (IN(0)) { REP(0) p0_prologue(P, lds, vcu, G, wave, lane); if (BOTH(0)) xcd_barrier(bar); }

    if (IN(1)) {
        pg8::DenseOrder S; S.so.init(M, NINP, G, bx); S.A = (const char*)(P.ws + WS_XN); S.Bt = (const char*)(P.ws + WS_WIN); S.tstep = (size_t)256 * 1024 * 2;
        pg8::EpiBf16<0> E{(pg8::bf16_t*)(P.ws + WS_PROJ), NINP, nullptr, 0, 0, 1.f};
        pg8::gemm_phase<pg8::EpiBf16<0>, pg8::DenseOrder, true, true>(lds + RING_OFF, 1024, S, E, gtab);
        AGAIN(1) pg8::gemm_phase<pg8::EpiBf16<0>, pg8::DenseOrder, true, true>(lds + RING_OFF, 1024, S, E, gtab);
        if (BOTH(1)) xcd_barrier(bar);
    }
    if (IN(2)) {
        const int pre_ = (vcu & 1) ? STAG_PRE : 1 << 30;
#pragma unroll 1
        for (int part_ = 0; part_ < 2; ++part_) {
            attn_phase(P, lds, vcu, G, wave, lane, part_ == 0 ? 0 : pre_, part_ == 0 ? pre_ : 1 << 30);
            if (part_ == 0) gdn_prep_phase(P, lds, vcu, G, tid, wave, lane, !RIDE_OFF);
        }
#if STORE_PROBE
        store_probe<STORE_PROBE>(P, vcu, wave, lane);
#endif
        AGAIN(12) gdn_prep_phase(P, lds, vcu, G, tid, wave, lane, !((PH_AGAIN >> 13) & 1), PMODE); if (BOTH(2)) xcd_barrier(bar); }
    #ifndef SCAN_PROBE
#define SCAN_PROBE 0
#endif
    if (IN(3)) { gdn_scan_phase<0>(P, lds, vcu, G, tid, wave, lane); AGAIN(3) gdn_scan_phase<0>(P, lds, vcu, G, tid, wave, lane); if (SCAN_PROBE) gdn_scan_phase<SCAN_PROBE>(P, lds, vcu, G, tid, wave, lane); if (BOTH(3)) xcd_barrier(bar); }
    if (IN(4)) { REP(4) { merge_attn(P, G, wave, lane); gdn_out_phase(P, G, wave, lane); } if (BOTH(4)) xcd_barrier(bar); }

    if (IN(5)) {
        pg8::DenseOrder S; S.so.init(M, 1024, G, bx); S.A = (const char*)(P.ws + WS_YAB); S.Bt = (const char*)(P.ws + WS_WAB); S.tstep = (size_t)256 * KAB * 2;
        pg8::EpiMerged E{(const pg8::bf16_t*)(P.ws + WS_PROJ), (pg8::bf16_t*)(P.ws + WS_MERGED), NINP, P_GA, P_GB};
        pg8::gemm_phase<pg8::EpiMerged, pg8::DenseOrder, true, true>(lds + RING_OFF, KAB, S, E, gtab);
        AGAIN(5) pg8::gemm_phase<pg8::EpiMerged, pg8::DenseOrder, true, true>(lds + RING_OFF, KAB, S, E, gtab);
        if (BOTH(5)) xcd_barrier(bar);
    }
    if (IN(6)) {
        pg8::DenseOrder S; S.so.init(M, 1024, G, bx); S.A = (const char*)(P.ws + WS_MERGED); S.Bt = (const char*)(P.ws + WS_WOUT); S.tstep = (size_t)256 * 1024 * 2;
        pg8::EpiResid E{P.x, P.out};
        pg8::gemm_phase<pg8::EpiResid, pg8::DenseOrder, true, true>(lds + RING_OFF, 1024, S, E, gtab);
        AGAIN(6) pg8::gemm_phase<pg8::EpiResid, pg8::DenseOrder, true, true>(lds + RING_OFF, 1024, S, E, gtab);
        if (BOTH(6)) xcd_barrier(bar);
    }
    if (IN(7)) { p7_router<0>(P, lds, G, tid, wave, lane); AGAIN(7) { __syncthreads(); p7_router<1>(P, lds, G, tid, wave, lane); } if (BOTH(7)) xcd_barrier(bar); }
    if (IN(8)) {
        build_etab((const unsigned*)(ctl + CW_CNT), etab, tid);
        pg8::MoeOrder<8, true> S; S.etab = etab; S.G = G; S.c = bx; S.K = 1024; S.A = (const char*)(P.ws + WS_XN); S.W = (const char*)(P.ws + WS_WGU); S.wstride = (size_t)2048 * 1024 * 2; S.list = (const int*)(P.ws + WS_LIST);
        pg8::EpiSwiglu E{(pg8::bf16_t*)(P.ws + WS_ACT), P.b_gu};
        REP(8) pg8::gemm_phase<pg8::EpiSwiglu, pg8::MoeOrder<8, true>, true, true>(lds + RING_OFF, 1024, S, E, gtab);
        if (BOTH(8)) xcd_barrier(bar);
    }
    if (IN(9)) {
        build_etab((const unsigned*)(ctl + CW_CNT), etab, tid);
        pg8::MoeOrder<4, false> S; S.etab = etab; S.G = G; S.c = bx; S.K = 1024; S.A = (const char*)(P.ws + WS_ACT); S.W = (const char*)(P.ws + WS_WD); S.wstride = (size_t)1024 * 1024 * 2; S.list = (const int*)(P.ws + WS_LIST);
        pg8::EpiDown E{(pg8::bf16_t*)(P.ws + WS_YEXP), P.b_d, (const float*)(P.ws + WS_GATEL)};
        REP(9) pg8::gemm_phase<pg8::EpiDown, pg8::MoeOrder<4, false>, true, true>(lds + RING_OFF, 1024, S, E, gtab);
        if (BOTH(9)) xcd_barrier(bar);
    }
    if (IN(10)) { p10_final<0>(P, lds, G, tid, wave, lane); AGAIN(10) { __syncthreads(); p10_final<1>(P, lds, G, tid, wave, lane); } }
#undef IN
#undef BOTH
}

extern "C" void kernel_launch(void* const* d_in, const int* in_sizes, int n_in, void* d_out, int out_size, void* d_ws, size_t ws_size, hipStream_t stream) {
    static int grid = 0;
    if (grid == 0) {
        if (n_in != 20 || out_size != M * DM || ws_size < WS_END) { fprintf(stderr, "kernel_launch: unexpected shapes (n_in %d out %d ws %zu)\n", n_in, out_size, ws_size); grid = -1; return; }
        int dev = 0, cus = 0;
        if (hipGetDevice(&dev) != hipSuccess || hipDeviceGetAttribute(&cus, hipDeviceAttributeMultiprocessorCount, dev) != hipSuccess) { grid = -1; return; }
        if (hipFuncSetAttribute((const void*)mega_fwd, hipFuncAttributeMaxDynamicSharedMemorySize, LDS_BYTES) != hipSuccess) { fprintf(stderr, "kernel_launch: hipFuncSetAttribute failed\n"); grid = -1; return; }
        (void)hipGetLastError();
        grid = cus;
    }
    if (grid < 0) return;
    (void)hipMemsetAsync((char*)d_ws + WS_CTL, 0, CTL_ZERO_BYTES, stream);
    Args a{};
    const float** pp = (const float**)&a.p;
    for (int i = 0; i < 20; ++i) pp[i] = (const float*)d_in[i];
    a.p.out = (float*)d_out; a.p.ws = (unsigned char*)d_ws;
    a.ph_lo = 0; a.ph_hi = 11; a.li = 0;
    hipLaunchKernelGGL(mega_fwd, dim3(grid), dim3(NWAVES * 64), LDS_BYTES, stream, a);
}
```

```cpp
#include <hip/hip_runtime.h>
#include <cstdint>
#include <cstdio>

constexpr int BATCH = 4, SEQ = 4096, DM = 1024, M = BATCH * SEQ;
constexpr int NIN = 7712;
constexpr int NINP = 7936;
constexpr int P_QA = 0, P_KA = 512, P_VA = 1024, P_QB = 1536, P_ZB = 4608, P_GA = 5632, P_GB = 6656, P_AF = 7680, P_AB = 7688, P_BF = 7696, P_BB = 7704;
constexpr int NE = 32, DFF = 1024;
constexpr float EPS = 1e-6f;
constexpr int KAB = 1536;
constexpr int MAXBLK = 288;


#define PREP_PROBE 0
#define RIDE_OFF 0
#define PMODE 0
#define STAG_PRE 3
#define STORE_PROBE 0
namespace pg8 {
#define PG8_LAS __attribute__((address_space(3)))
typedef unsigned short bf16_t;
typedef short bf16x8 __attribute__((ext_vector_type(8)));
typedef float f32x4 __attribute__((ext_vector_type(4)));
typedef unsigned u32x4 __attribute__((ext_vector_type(4)));
constexpr int BM = 256, BK = 64, HALF = 128, HTB = HALF * BK * 2  , STAGE_BYTES = 8 * HTB, NXCD = 8, WGM = 8;

__host__ __device__ __forceinline__ int lds_byte(int r, int c) { const int st = (r >> 4) * 2 + (c >> 5), rr = r & 15, cc = c & 31, ob = rr * 64 + cc * 2; return st * 1024 + (ob ^ (((ob >> 9) & 1) << 5)); }
__host__ __device__ __forceinline__ void stage_rc(int b, int& R, int& C) { const int st = b / 1024, sb = b % 1024, swz = sb ^ (((sb >> 9) & 1) << 5); R = (st >> 1) * 16 + swz / 64; C = (st & 1) * 32 + (swz % 64) / 2; }
__host__ __device__ __forceinline__ int perm32(int rho) { const int n = rho >> 4, i = rho & 15; return 8 * (i >> 2) + 4 * n + (i & 3); }

struct Unit { int pm, pn; };
struct Gemm { const bf16_t* A; const bf16_t* Bt; int M, N, K; };

struct StaticOrder {
    int nM, nN, nwg, G, c;
    __host__ __device__ void init(int M, int N, int G_, int c_) { nM = M / BM; nN = N / BM; nwg = nM * nN; G = G_; c = c_; }
    __host__ __device__ bool next(int i, Unit& u) const {
        const long L = (long)i * G + c; if (L >= nwg) return false;
        int wgid = (int)L; { const int q = nwg / NXCD, r = nwg % NXCD, xcd = wgid % NXCD, off = wgid / NXCD; wgid = (xcd < r ? xcd * (q + 1) : r * (q + 1) + (xcd - r) * q) + off; }
        const int nig = WGM * nN, gid = wgid / nig, fm = gid * WGM, gsz = (nM - fm) < WGM ? (nM - fm) : WGM;
        u.pm = fm + ((wgid % nig) % gsz); u.pn = (wgid % nig) / gsz; return true;
    }
    __device__ __forceinline__ void a_ready(const Unit&) const {}
    __device__ __forceinline__ void done(const Unit&) const {}
};

__device__ __forceinline__ unsigned cvt_pk_bf16(float lo, float hi) { unsigned r; asm volatile("v_cvt_pk_bf16_f32 %0, %1, %2" : "=v"(r) : "v"(lo), "v"(hi)); return r; }
typedef float f32x2 __attribute__((ext_vector_type(2)));
__device__ __forceinline__ f32x2 gelu_pk(f32x2 v) {
    const f32x2 av = __builtin_elementwise_abs(v), d = av * 0.2316418882f + 1.0f;
    f32x2 t; t.x = __builtin_amdgcn_rcpf(d.x); t.y = __builtin_amdgcn_rcpf(d.y);
    f32x2 q = t * 0.5307027145f + (-0.7265760135f); q = q * t + 0.7107068705f; q = q * t + (-0.142248368f); q = q * t + 0.127414796f; q = q * t;
    const f32x2 s = (v * v) * (-0.72134752044f);
    f32x2 e; e.x = __builtin_amdgcn_exp2f(s.x); e.y = __builtin_amdgcn_exp2f(s.y);
    const f32x2 m = v * (q * e), r = v - m;
    f32x2 o; o.x = v.x < 0.f ? m.x : r.x; o.y = v.y < 0.f ? m.y : r.y; return o;
}

template <int ACT  > struct EpiBf16 {
    static constexpr bool PERM = true, AFTER_DRAIN = false, HAS_MID = false; static_assert(ACT == 0 || ACT == 1, "EpiBf16: ACT is 0 (none) or 1 (gelu_pk)");
    bf16_t* O; int ldc; const float* bias; int split_cols; size_t split_stride; float scale0; PG8_LAS unsigned char* scr;
    __device__ __forceinline__ void operator()(const f32x4 (&acc)[2][2][4][2], const Unit& u, int wr, int wc, int fr, int fq) const {
        const int row0 = u.pm * BM + wr * 64 + fr; int colt = u.pn * BM; bf16_t* base = O;
        float sc = 1.f; if (split_cols) { const int t = colt / split_cols; base += (size_t)t * split_stride; colt -= t * split_cols; if (t == 0) sc = scale0; }
        const int bcol0 = u.pn * BM + wc * 32 + 8 * fq;
        PG8_LAS unsigned char* sp = scr + (wr * 4 + wc) * 1280; const int ln = fq * 16 + fr, r2 = ln >> 2, c2 = ln & 3;
        PG8_LAS unsigned char* spw = sp + fr * 80 + fq * 16; const PG8_LAS unsigned char* spr = sp + r2 * 80 + c2 * 16;
        const int row0p = u.pm * BM + wr * 64 + r2, col0 = colt + wc * 32 + 8 * c2;
        f32x4 bv[2][2];
#pragma unroll
        for (int bj = 0; bj < 2; ++bj)
#pragma unroll
            for (int n = 0; n < 2; ++n) bv[bj][n] = bias ? *(const f32x4*)(bias + bcol0 + bj * HALF + 4 * n) : (f32x4){0.f, 0.f, 0.f, 0.f};
#pragma unroll
        for (int ai = 0; ai < 2; ++ai)
#pragma unroll
            for (int m = 0; m < 4; ++m) { bf16_t* rowp = base + (size_t)(row0p + ai * HALF + m * 16) * ldc + col0;
#pragma unroll
                for (int bj = 0; bj < 2; ++bj) { f32x4 v0 = acc[ai][bj][m][0] + bv[bj][0], v1 = acc[ai][bj][m][1] + bv[bj][1];
                    if (ACT == 1) { f32x2 a = gelu_pk((f32x2){v0[0], v0[1]}), b = gelu_pk((f32x2){v0[2], v0[3]}), c = gelu_pk((f32x2){v1[0], v1[1]}), d = gelu_pk((f32x2){v1[2], v1[3]});
                        v0 = (f32x4){a.x, a.y, b.x, b.y}; v1 = (f32x4){c.x, c.y, d.x, d.y}; }
                    v0 = v0 * sc; v1 = v1 * sc; u32x4 w; w.x = cvt_pk_bf16(v0[0], v0[1]); w.y = cvt_pk_bf16(v0[2], v0[3]); w.z = cvt_pk_bf16(v1[0], v1[1]); w.w = cvt_pk_bf16(v1[2], v1[3]);
                    *(PG8_LAS u32x4*)spw = w; asm volatile("" ::: "memory"); const u32x4 w2 = *(const PG8_LAS u32x4*)spr; asm volatile("" ::: "memory");
                    *(u32x4*)(rowp + bj * HALF) = w2; } }
    }
};
__device__ __forceinline__ float bflo(unsigned w) { return __uint_as_float(w << 16); }
__device__ __forceinline__ float bfhi(unsigned w) { return __uint_as_float(w & 0xffff0000u); }
__device__ __forceinline__ float sigm(float x) { return __builtin_amdgcn_rcpf(1.0f + __expf(-fmaxf(x, -30.0f))); }

struct DenseOrder {
    typedef Unit UnitT; static constexpr bool GATHER = false;
    StaticOrder so; const char* A; const char* Bt; size_t tstep;
    __device__ __forceinline__ bool next(int i, Unit& u) const { return so.next(i, u); }
    __device__ __forceinline__ const char* ptrA(const Unit& u) const { return A + (size_t)u.pm * tstep; }
    __device__ __forceinline__ const char* ptrB(const Unit& u) const { return Bt + (size_t)u.pn * tstep; }
    __device__ __forceinline__ unsigned rowoff(const Unit&, int) const { return 0u; }
    __device__ __forceinline__ void a_ready(const Unit&) const {}
    __device__ __forceinline__ void done(const Unit&) const {}
};
struct MUnit { int pm, pn, e, j, rows, slot0; };
template <int NT, bool GATHER_> struct MoeOrder {
    typedef MUnit UnitT; static constexpr bool GATHER = GATHER_;
    const PG8_LAS int* etab; int G, c, K; const char* A; const char* W; size_t wstride; const int* list;
    __device__ __forceinline__ bool next(int i, MUnit& u) const {
        const int L = i * G + c; if (L >= etab[32] * NT) return false;
        const int blk = L / NT; int e = 0;
#pragma unroll
        for (int q = 1; q < 32; ++q) e += (etab[q] <= blk) ? 1 : 0;
        u.e = e; u.j = blk - etab[e]; u.pm = blk; u.pn = L % NT; const int left = etab[40 + e] - 256 * u.j; u.rows = left < 256 ? left : 256; u.slot0 = blk * 256; return true;
    }
    __device__ __forceinline__ const char* ptrA(const MUnit& u) const { return GATHER_ ? A : A + (size_t)u.slot0 * K * 2; }
    __device__ __forceinline__ const char* ptrB(const MUnit& u) const { return W + (size_t)u.e * wstride + (size_t)u.pn * 256 * K * 2; }
    __device__ __forceinline__ unsigned rowoff(const MUnit& u, int r) const { const int pos = u.j * 256 + r; const int tok = list[(size_t)u.e * 16384 + (pos < etab[40 + u.e] ? pos : 0)]; return (unsigned)tok * (unsigned)K * 2u; }
    __device__ __forceinline__ void a_ready(const MUnit&) const {}
    __device__ __forceinline__ void done(const MUnit&) const {}
};

struct EpiMerged {
    static constexpr bool PERM = true, AFTER_DRAIN = false, HAS_MID = true; static constexpr int TMID = 8;
    const bf16_t* proj; bf16_t* out; int ld, ga_off, gb_off; PG8_LAS unsigned char* scr;
    __device__ __forceinline__ void mid(f32x4 (&acc)[2][2][4][2], const Unit& u, int wr, int wc, int fr, int fq) const {
        int row0 = u.pm * BM + wr * 64 + fr, c0 = u.pn * BM + wc * 32 + 8 * fq;
        asm volatile("" : "+v"(row0), "+v"(c0));
#pragma unroll
        for (int ai = 0; ai < 2; ++ai)
#pragma unroll
            for (int mp = 0; mp < 2; ++mp) {
                u32x4 gav[2][2], gbv[2][2];
#pragma unroll
                for (int mm = 0; mm < 2; ++mm) { const bf16_t* rp = proj + (size_t)(row0 + ai * HALF + (2 * mp + mm) * 16) * ld + c0;
#pragma unroll
                    for (int bj = 0; bj < 2; ++bj) { gav[mm][bj] = *(const u32x4*)(rp + ga_off + bj * HALF); gbv[mm][bj] = *(const u32x4*)(rp + gb_off + bj * HALF); } }
#pragma unroll
                for (int mm = 0; mm < 2; ++mm) { const int m = 2 * mp + mm;
#pragma unroll
                    for (int bj = 0; bj < 2; ++bj) { const u32x4 ga = gav[mm][bj], gb = gbv[mm][bj];
#define EM_R(a, b) ((1.0f + __expf(-fmaxf((b), -30.0f))) * __builtin_amdgcn_rcpf(1.0f + __expf(-fmaxf((a), -30.0f))))
                        acc[ai][bj][m][0][0] *= EM_R(bflo(ga.x), bflo(gb.x)); acc[ai][bj][m][0][1] *= EM_R(bfhi(ga.x), bfhi(gb.x));
                        acc[ai][bj][m][0][2] *= EM_R(bflo(ga.y), bflo(gb.y)); acc[ai][bj][m][0][3] *= EM_R(bfhi(ga.y), bfhi(gb.y));
                        acc[ai][bj][m][1][0] *= EM_R(bflo(ga.z), bflo(gb.z)); acc[ai][bj][m][1][1] *= EM_R(bfhi(ga.z), bfhi(gb.z));
                        acc[ai][bj][m][1][2] *= EM_R(bflo(ga.w), bflo(gb.w)); acc[ai][bj][m][1][3] *= EM_R(bfhi(ga.w), bfhi(gb.w));
#undef EM_R
                    }
                    asm volatile("" : "+v"(acc[ai][0][m][0]), "+v"(acc[ai][0][m][1]), "+v"(acc[ai][1][m][0]), "+v"(acc[ai][1][m][1])); }
                asm volatile("" ::: "memory"); }
    }
    __device__ __forceinline__ void operator()(const f32x4 (&acc)[2][2][4][2], const Unit& u, int wr, int wc, int fr, int fq) const {
        const int row0 = u.pm * BM + wr * 64 + fr, c0 = u.pn * BM + wc * 32 + 8 * fq;
        PG8_LAS unsigned char* sp = scr + (wr * 4 + wc) * 1280; const int ln = fq * 16 + fr, r2 = ln >> 2, c2 = ln & 3;
        PG8_LAS unsigned char* spw = sp + fr * 80 + fq * 16; const PG8_LAS unsigned char* spr = sp + r2 * 80 + c2 * 16;
        const int row0p = u.pm * BM + wr * 64 + r2, c0p = u.pn * BM + wc * 32 + 8 * c2;
#pragma unroll
        for (int ai = 0; ai < 2; ++ai) {
            u32x4 gbv[4][2];
#pragma unroll
            for (int m = 0; m < 4; ++m)
#pragma unroll
                for (int bj = 0; bj < 2; ++bj) gbv[m][bj] = *(const u32x4*)(proj + (size_t)(row0 + ai * HALF + m * 16) * ld + gb_off + c0 + bj * HALF);
#pragma unroll
            for (int m = 0; m < 4; ++m) { const size_t row = (size_t)(row0 + ai * HALF + m * 16);
#pragma unroll
                for (int bj = 0; bj < 2; ++bj) { const u32x4 gb = gbv[m][bj];
                    const f32x4 v0 = acc[ai][bj][m][0], v1 = acc[ai][bj][m][1]; u32x4 w;
                    w.x = cvt_pk_bf16(v0[0] * sigm(bflo(gb.x)), v0[1] * sigm(bfhi(gb.x))); w.y = cvt_pk_bf16(v0[2] * sigm(bflo(gb.y)), v0[3] * sigm(bfhi(gb.y)));
                    w.z = cvt_pk_bf16(v1[0] * sigm(bflo(gb.z)), v1[1] * sigm(bfhi(gb.z))); w.w = cvt_pk_bf16(v1[2] * sigm(bflo(gb.w)), v1[3] * sigm(bfhi(gb.w)));
                    *(PG8_LAS u32x4*)spw = w; asm volatile("" ::: "memory"); const u32x4 w2 = *(const PG8_LAS u32x4*)spr; asm volatile("" ::: "memory");
                    *(u32x4*)(out + (size_t)(row0p + ai * HALF + m * 16) * 1024 + c0p + bj * HALF) = w2; } }
            asm volatile("" ::: "memory"); }
    }
};
struct EpiResid {
    static constexpr bool PERM = false, AFTER_DRAIN = false, HAS_MID = false;
    const float* base; float* out;
    __device__ __forceinline__ void operator()(const f32x4 (&acc)[2][2][4][2], const Unit& u, int wr, int wc, int fr, int fq) const {
        const int row0 = u.pm * BM + wr * 64 + fr, col0 = u.pn * BM + wc * 32 + 4 * fq;
#pragma unroll
        for (int ai = 0; ai < 2; ++ai)
#pragma unroll
            for (int m = 0; m < 4; ++m) { const size_t off = (size_t)(row0 + ai * HALF + m * 16) * 1024 + col0;
#pragma unroll
                for (int bj = 0; bj < 2; ++bj)
#pragma unroll
                    for (int n = 0; n < 2; ++n) { const size_t o = off + bj * HALF + n * 16; *(f32x4*)(out + o) = *(const f32x4*)(base + o) + acc[ai][bj][m][n]; } }
    }
};
struct EpiSwiglu {
    static constexpr bool PERM = true, AFTER_DRAIN = false, HAS_MID = false;
    bf16_t* act; const float* bgu; PG8_LAS unsigned char* scr;
    __device__ __forceinline__ void operator()(const f32x4 (&acc)[2][2][4][2], const MUnit& u, int wr, int wc, int fr, int fq) const {
        const int r0 = wr * 64 + fr, j0 = u.pn * HALF + wc * 32 + 8 * fq;
        PG8_LAS unsigned char* sp = scr + (wr * 4 + wc) * 1280; const int ln = fq * 16 + fr, r2 = ln >> 2, c2 = ln & 3;
        PG8_LAS unsigned char* spw = sp + fr * 80 + fq * 16; const PG8_LAS unsigned char* spr = sp + r2 * 80 + c2 * 16;
        const int r0p = wr * 64 + r2, j0p = u.pn * HALF + wc * 32 + 8 * c2;
        const float* bp = bgu + (size_t)u.e * 2048 + j0;
        const f32x4 bg0 = *(const f32x4*)(bp), bg1 = *(const f32x4*)(bp + 4), bl0 = *(const f32x4*)(bp + 1024), bl1 = *(const f32x4*)(bp + 1028);
#pragma unroll
        for (int ai = 0; ai < 2; ++ai)
#pragma unroll
            for (int m = 0; m < 4; ++m) { const int r = r0p + ai * HALF + m * 16;
                if (ai * HALF + m * 16 + wr * 64 < u.rows) {
                    const f32x4 g0 = acc[ai][0][m][0] + bg0, g1 = acc[ai][0][m][1] + bg1, l0 = acc[ai][1][m][0] + bl0, l1 = acc[ai][1][m][1] + bl1;
                    float o[8];
#pragma unroll
                    for (int i = 0; i < 4; ++i) { const float g = fminf(g0[i], 7.0f), l = fminf(fmaxf(l0[i], -7.0f), 7.0f); o[i] = g * sigm(1.702f * g) * (l + 1.0f); }
#pragma unroll
                    for (int i = 0; i < 4; ++i) { const float g = fminf(g1[i], 7.0f), l = fminf(fmaxf(l1[i], -7.0f), 7.0f); o[4 + i] = g * sigm(1.702f * g) * (l + 1.0f); }
                    u32x4 w; w.x = cvt_pk_bf16(o[0], o[1]); w.y = cvt_pk_bf16(o[2], o[3]); w.z = cvt_pk_bf16(o[4], o[5]); w.w = cvt_pk_bf16(o[6], o[7]);
                    *(PG8_LAS u32x4*)spw = w; asm volatile("" ::: "memory"); const u32x4 w2 = *(const PG8_LAS u32x4*)spr; asm volatile("" ::: "memory");
                    if (r < u.rows) *(u32x4*)(act + (size_t)(u.slot0 + r) * 1024 + j0p) = w2; } }
    }
};
struct EpiDown {
    static constexpr bool PERM = true, AFTER_DRAIN = false, HAS_MID = false;
    bf16_t* yexp; const float* bd; const float* gatel; PG8_LAS unsigned char* scr;
    __device__ __forceinline__ void operator()(const f32x4 (&acc)[2][2][4][2], const MUnit& u, int wr, int wc, int fr, int fq) const {
        const int r0 = wr * 64 + fr, c0 = u.pn * BM + wc * 32 + 8 * fq;
        PG8_LAS unsigned char* sp = scr + (wr * 4 + wc) * 1280; const int ln = fq * 16 + fr, r2 = ln >> 2, c2 = ln & 3;
        PG8_LAS unsigned char* spw = sp + fr * 80 + fq * 16; const PG8_LAS unsigned char* spr = sp + r2 * 80 + c2 * 16;
        const int r0p = wr * 64 + r2, c0p = u.pn * BM + wc * 32 + 8 * c2;
        f32x4 bv[2][2];
#pragma unroll
        for (int bj = 0; bj < 2; ++bj)
#pragma unroll
            for (int n = 0; n < 2; ++n) bv[bj][n] = *(const f32x4*)(bd + (size_t)u.e * 1024 + c0 + bj * HALF + 4 * n);
        float gv[2][4];
#pragma unroll
        for (int ai = 0; ai < 2; ++ai)
#pragma unroll
            for (int m = 0; m < 4; ++m) gv[ai][m] = gatel[(size_t)u.e * 16384 + u.j * 256 + r0 + ai * HALF + m * 16];
#pragma unroll
        for (int ai = 0; ai < 2; ++ai)
#pragma unroll
            for (int m = 0; m < 4; ++m) { const int r = r0p + ai * HALF + m * 16;
                if (ai * HALF + m * 16 + wr * 64 < u.rows) { const float g = gv[ai][m];
#pragma unroll
                    for (int bj = 0; bj < 2; ++bj) { const f32x4 v0 = (acc[ai][bj][m][0] + bv[bj][0]) * g, v1 = (acc[ai][bj][m][1] + bv[bj][1]) * g;
                        u32x4 w; w.x = cvt_pk_bf16(v0[0], v0[1]); w.y = cvt_pk_bf16(v0[2], v0[3]); w.z = cvt_pk_bf16(v1[0], v1[1]); w.w = cvt_pk_bf16(v1[2], v1[3]);
                        *(PG8_LAS u32x4*)spw = w; asm volatile("" ::: "memory"); const u32x4 w2 = *(const PG8_LAS u32x4*)spr; asm volatile("" ::: "memory");
                        if (r < u.rows) *(u32x4*)(yexp + (size_t)(u.slot0 + r) * 1024 + c0p + bj * HALF) = w2; } } }
    }
};

template <class Epi, class Sched, bool ALIGN_EPI = false, bool SP2 = false>
__device__ __forceinline__ void gemm_phase(PG8_LAS unsigned char* lds, const int K, const Sched& S, const Epi& E, PG8_LAS unsigned* gtab) {
    const int tid = threadIdx.x, wid = __builtin_amdgcn_readfirstlane(tid >> 6), lane = tid & 63, wr = wid >> 2, wc = wid & 3, fr = lane & 15, fq = lane >> 4;
    const int nt = K / BK;
    unsigned voffA[2], voffB[2]; unsigned voffG[2][2] = {{0u, 0u}, {0u, 0u}}; int gR[2]; unsigned gC2[2];
#pragma unroll
    for (int i = 0; i < 2; ++i) { int R, C; stage_rc(tid * 16 + i * 8192, R, C); const int Rb = Epi::PERM ? ((R & ~31) + perm32(R & 31)) : R;
        gR[i] = R; gC2[i] = (unsigned)C * 2u; voffA[i] = (unsigned)(R * K + C) * 2u; voffB[i] = (unsigned)(Rb * K + C) * 2u; }
    const size_t kstep = (size_t)(BK * 2);
    const size_t hstep = (size_t)HALF * K * 2;
    const size_t tstep = 2 * hstep;
    const unsigned ldsw = (unsigned)wid * 1024u;
    const int aoff = lds_byte(wr * 64 + fr, fq * 8), boff = lds_byte(wc * 32 + fr, fq * 8);
#define PG8_SA(b, h) (((b) * 2 + (h)) * HTB)
#define PG8_SB(b, h) ((4 + (b) * 2 + (h)) * HTB)
#define PG8_STAGE(bufoff, gbase, voff) do { _Pragma("unroll") for (int _i = 0; _i < 2; ++_i) \
        __builtin_amdgcn_global_load_lds((const unsigned*)((const char*)(gbase) + (voff)[_i]), (PG8_LAS unsigned*)(lds + (bufoff) + ldsw + _i * 8192), 16, 0, 0); } while (0)
#define PG8_STAGE_A(bufoff, gbase, h) do { _Pragma("unroll") for (int _i = 0; _i < 2; ++_i) { const char* _src; \
        if constexpr (Sched::GATHER) _src = (const char*)(gbase) + voffG[h][_i]; else _src = (const char*)(gbase) + (size_t)(h) * hstep + voffA[_i]; \
        __builtin_amdgcn_global_load_lds((const unsigned*)_src, (PG8_LAS unsigned*)(lds + (bufoff) + ldsw + _i * 8192), 16, 0, 0); } } while (0)
#define PG8_LOADG(uidx) do { _Pragma("unroll") for (int _h = 0; _h < 2; ++_h) _Pragma("unroll") for (int _i = 0; _i < 2; ++_i) voffG[_h][_i] = gtab[(uidx) * 256 + _h * 128 + gR[_i]] + gC2[_i]; } while (0)
#define PG8_GSWITCH do { if constexpr (Sched::GATHER) { if (last && has_next) PG8_LOADG(ui + 1); } } while (0)
#define PG8_LDA(dst, b, h) do { _Pragma("unroll") for (int m = 0; m < 4; ++m) _Pragma("unroll") for (int k = 0; k < 2; ++k) dst[m][k] = *(const PG8_LAS bf16x8*)(lds + PG8_SA(b, h) + aoff + m * 2048 + k * 1024); } while (0)
#define PG8_LDB(dst, b, h) do { _Pragma("unroll") for (int n = 0; n < 2; ++n) _Pragma("unroll") for (int k = 0; k < 2; ++k) dst[n][k] = *(const PG8_LAS bf16x8*)(lds + PG8_SB(b, h) + boff + n * 2048 + k * 1024); } while (0)
#define PG8_MMA(ai, bj, At, Bt) do { __builtin_amdgcn_s_setprio(1); _Pragma("unroll") for (int m = 0; m < 4; ++m) _Pragma("unroll") for (int n = 0; n < 2; ++n) _Pragma("unroll") for (int k = 0; k < 2; ++k) \
        acc[ai][bj][m][n] = __builtin_amdgcn_mfma_f32_16x16x32_bf16(Bt[n][k], At[m][k], acc[ai][bj][m][n], 0, 0, 0); __builtin_amdgcn_s_setprio(0); } while (0)
#define PG8_WAIT_V(n) asm volatile("s_waitcnt vmcnt(" #n ")" ::: "memory")
#define PG8_WAIT_L(n) asm volatile("s_waitcnt lgkmcnt(" #n ")" ::: "memory")
#define PG8_BAR __builtin_amdgcn_s_barrier()
#define PG8_SCHED __builtin_amdgcn_sched_barrier(0)
    typename Sched::UnitT cur, nxt; int ui = 0;
    if (!S.next(0, cur)) return;
    f32x4 acc[2][2][4][2];
#pragma unroll
    for (int a = 0; a < 2; ++a)
#pragma unroll
        for (int b = 0; b < 2; ++b)
#pragma unroll
            for (int m = 0; m < 4; ++m)
#pragma unroll
                for (int n = 0; n < 2; ++n) acc[a][b][m][n] = (f32x4){0.f, 0.f, 0.f, 0.f};
    bf16x8 At[4][2], B0[2][2], B1[2][2];
    const char* cA = S.ptrA(cur); const char* cB = S.ptrB(cur);
    if constexpr (Sched::GATHER) {
        for (int i0 = 0; ; i0 += 4) {
            typename Sched::UnitT gu[4]; bool ok[4]; unsigned rv[4];
#pragma unroll
            for (int q = 0; q < 4; ++q) ok[q] = S.next(i0 + q, gu[q]);
#pragma unroll
            for (int q = 0; q < 4; ++q) rv[q] = (ok[q] && tid < 256) ? S.rowoff(gu[q], tid) : 0u;
#pragma unroll
            for (int q = 0; q < 4; ++q) if (ok[q] && tid < 256) gtab[(i0 + q) * 256 + tid] = rv[q];
            if (!ok[3]) break;
        }
        asm volatile("s_waitcnt vmcnt(0) lgkmcnt(0)" ::: "memory"); __builtin_amdgcn_s_barrier(); asm volatile("" ::: "memory");
        PG8_LOADG(0);
    }
    S.a_ready(cur);
    if constexpr (SP2) {
        PG8_STAGE(PG8_SB(0, 0), cB, voffB); PG8_STAGE(PG8_SB(0, 1), cB + hstep, voffB); PG8_STAGE_A(PG8_SA(0, 0), cA, 0); PG8_STAGE_A(PG8_SA(0, 1), cA, 1);
        if (wr == 1) PG8_BAR;
        PG8_WAIT_V(2); PG8_BAR;
        PG8_STAGE(PG8_SB(1, 0), cB + kstep, voffB); PG8_STAGE_A(PG8_SA(1, 0), cA + kstep, 0); PG8_STAGE(PG8_SB(1, 1), cB + hstep + kstep, voffB);
        PG8_WAIT_V(6); PG8_BAR;
    } else {
        PG8_STAGE(PG8_SB(0, 0), cB, voffB); PG8_STAGE_A(PG8_SA(0, 0), cA, 0); PG8_STAGE(PG8_SB(0, 1), cB + hstep, voffB); PG8_STAGE_A(PG8_SA(0, 1), cA, 1);
        if (wr == 1) PG8_BAR;
        PG8_WAIT_V(4); PG8_BAR;
        PG8_STAGE(PG8_SB(1, 0), cB + kstep, voffB); PG8_STAGE_A(PG8_SA(1, 0), cA + kstep, 0); PG8_STAGE(PG8_SB(1, 1), cB + hstep + kstep, voffB);
        PG8_WAIT_V(6); PG8_BAR;
    }
    for (;;) {
        const bool has_next = S.next(ui + 1, nxt);
        const char* nA = has_next ? S.ptrA(nxt) : cA; const char* nB = has_next ? S.ptrB(nxt) : cB;
        for (int t = 0; t < nt; t += 2) {
            if constexpr (Epi::HAS_MID) { if (t == Epi::TMID) E.mid(acc, cur, wr, wc, fr, fq); }
            const bool last = (t == nt - 2);
            const char* a1 = cA + (size_t)(t + 1) * kstep;
            const char* a2 = last ? nA : cA + (size_t)(t + 2) * kstep; const char* b2 = last ? nB : cB + (size_t)(t + 2) * kstep;
            const char* a3 = a2 + kstep; const char* b3 = b2 + kstep;
            if (last && has_next) S.a_ready(nxt);
            if constexpr (SP2) {
            PG8_LDB(B0, 0, 0); PG8_LDB(B1, 0, 1); PG8_SCHED; PG8_LDA(At, 0, 0); PG8_STAGE_A(PG8_SA(1, 1), a1, 1); PG8_GSWITCH;
            PG8_WAIT_V(8); PG8_WAIT_L(0); PG8_BAR; PG8_MMA(0, 0, At, B0); PG8_MMA(0, 1, At, B1); PG8_BAR; PG8_SCHED;
            PG8_LDA(At, 0, 1); PG8_STAGE(PG8_SB(0, 0), b2, voffB); PG8_STAGE(PG8_SB(0, 1), b2 + hstep, voffB); PG8_STAGE_A(PG8_SA(0, 0), a2, 0);
            PG8_WAIT_V(8); PG8_WAIT_L(0); PG8_BAR; PG8_MMA(1, 0, At, B0); PG8_MMA(1, 1, At, B1); PG8_BAR; PG8_SCHED;
            PG8_LDB(B0, 1, 0); PG8_LDB(B1, 1, 1); PG8_SCHED; PG8_LDA(At, 1, 0); PG8_STAGE_A(PG8_SA(0, 1), a2, 1);
            PG8_WAIT_V(8); PG8_WAIT_L(0); PG8_BAR; PG8_MMA(0, 0, At, B0); PG8_MMA(0, 1, At, B1); PG8_BAR; PG8_SCHED;
            PG8_LDA(At, 1, 1); PG8_STAGE(PG8_SB(1, 0), b3, voffB); PG8_STAGE(PG8_SB(1, 1), b3 + hstep, voffB); PG8_STAGE_A(PG8_SA(1, 0), a3, 0);
            PG8_WAIT_V(8); PG8_WAIT_L(0); PG8_BAR; PG8_MMA(1, 0, At, B0); PG8_MMA(1, 1, At, B1); PG8_BAR; PG8_SCHED;
            } else {
            PG8_LDB(B0, 0, 0); PG8_SCHED; PG8_LDA(At, 0, 0); PG8_STAGE_A(PG8_SA(1, 1), a1, 1); PG8_GSWITCH;
            PG8_WAIT_L(8); PG8_BAR; PG8_WAIT_L(0); PG8_MMA(0, 0, At, B0); PG8_BAR; PG8_SCHED;
            PG8_LDB(B1, 0, 1); PG8_STAGE(PG8_SB(0, 0), b2, voffB);
            PG8_BAR; PG8_WAIT_L(0); PG8_MMA(0, 1, At, B1); PG8_BAR;
            PG8_LDA(At, 0, 1); PG8_STAGE_A(PG8_SA(0, 0), a2, 0);
            PG8_BAR; PG8_WAIT_L(0); PG8_MMA(1, 0, At, B0); PG8_BAR; PG8_SCHED;
            PG8_STAGE(PG8_SB(0, 1), b2 + hstep, voffB);
            PG8_WAIT_V(6); PG8_BAR; PG8_MMA(1, 1, At, B1); PG8_BAR;
            PG8_LDB(B0, 1, 0); PG8_SCHED; PG8_LDA(At, 1, 0); PG8_STAGE_A(PG8_SA(0, 1), a2, 1);
            PG8_WAIT_L(8); PG8_BAR; PG8_WAIT_L(0); PG8_MMA(0, 0, At, B0); PG8_BAR; PG8_SCHED;
            PG8_LDB(B1, 1, 1); PG8_STAGE(PG8_SB(1, 0), b3, voffB);
            PG8_BAR; PG8_WAIT_L(0); PG8_MMA(0, 1, At, B1); PG8_BAR;
            PG8_LDA(At, 1, 1); PG8_STAGE_A(PG8_SA(1, 0), a3, 0);
            PG8_BAR; PG8_WAIT_L(0); PG8_MMA(1, 0, At, B0); PG8_BAR; PG8_SCHED;
            PG8_STAGE(PG8_SB(1, 1), b3 + hstep, voffB);
            PG8_WAIT_V(6); PG8_BAR; PG8_MMA(1, 1, At, B1); PG8_BAR;
            }
        }
        if constexpr (ALIGN_EPI) { if (wr == 0) PG8_BAR; }
        if constexpr (!Epi::AFTER_DRAIN) { E(acc, cur, wr, wc, fr, fq); S.done(cur); }
        if (!has_next) break;
#pragma unroll
        for (int a = 0; a < 2; ++a)
#pragma unroll
            for (int b = 0; b < 2; ++b)
#pragma unroll
                for (int m = 0; m < 4; ++m)
#pragma unroll
                    for (int n = 0; n < 2; ++n) acc[a][b][m][n] = (f32x4){0.f, 0.f, 0.f, 0.f};
        cur = nxt; cA = nA; cB = nB; ++ui;
        if constexpr (ALIGN_EPI) { if (wr == 1) PG8_BAR; }
    }
    PG8_WAIT_V(0);
    if constexpr (!ALIGN_EPI) { if (wr == 0) PG8_BAR; }
    PG8_BAR;
    if constexpr (Epi::AFTER_DRAIN) { E.fused(acc, cur, wr, wc, fr, fq, lds, wid, lane); S.done(cur); }
#undef PG8_SA
#undef PG8_SB
#undef PG8_STAGE
#undef PG8_STAGE_A
#undef PG8_LOADG
#undef PG8_GSWITCH
#undef PG8_LDA
#undef PG8_LDB
#undef PG8_MMA
#undef PG8_WAIT_V
#undef PG8_WAIT_L
#undef PG8_BAR
#undef PG8_SCHED
}
}
constexpr size_t MiB = 1u << 20;
constexpr size_t WS_CTL = 0, CTL_ZERO_BYTES = 128 * 1024;
constexpr size_t WS_WIN = 2 * MiB;
constexpr size_t WS_WAB = 18 * MiB;
constexpr size_t WS_WOUT = 21 * MiB;
constexpr size_t WS_GATEL = 23 * MiB;
constexpr size_t WS_LIST = 25 * MiB;
constexpr size_t WS_ASG = 27 * MiB;
constexpr size_t WS_WGU = 32 * MiB;
constexpr size_t WS_WD = 160 * MiB;
constexpr size_t WS_XN = 224 * MiB;
constexpr size_t WS_PROJ = 256 * MiB;
constexpr size_t WS_YAB = 504 * MiB;
constexpr size_t WS_MERGED = 552 * MiB;
constexpr size_t WS_ACT = 256 * MiB;
constexpr size_t WS_GQ = 584 * MiB;
constexpr size_t WS_GKT = 616 * MiB;
constexpr size_t WS_GUT = 648 * MiB;
constexpr size_t WS_GW = 712 * MiB;
constexpr size_t WS_GQK = 776 * MiB;
constexpr size_t WS_GEG = 808 * MiB;
constexpr size_t WS_OF = 890 * MiB;
constexpr size_t WS_OB = 922 * MiB;
constexpr size_t WS_YEXP = 840 * MiB;
constexpr size_t WS_OP = 840 * MiB;
constexpr size_t WS_LSE = 888 * MiB;
constexpr size_t WS_END = 984 * MiB;
constexpr int CW_TMO = 0, CW_CODE = 1, CW_BAR = 4096, CW_CNT = 16384;
constexpr int N_BAR_REGIONS = 3;
static_assert((CW_CNT + 64) * 4 <= (int)CTL_ZERO_BYTES && (CW_BAR + 3 * 3456) * 4 <= CW_CNT * 4, "control words inside the per-call memset");

constexpr int RING_OFF = 0, RING_BYTES = 131072;
constexpr int LDSCTL_OFF = RING_BYTES, MISC_OFF = LDSCTL_OFF + 320;
constexpr int ETAB_OFF = LDSCTL_OFF + 1024;
constexpr int GTAB_OFF = LDSCTL_OFF + 2048;
constexpr int LDS_BYTES = 163840;
constexpr int EPISCR_OFF = GTAB_OFF + 16 * 1024;
static_assert(EPISCR_OFF + 8 * 1280 <= LDS_BYTES, "LDS map");
constexpr int NWAVES = 8;

#define GAS __attribute__((address_space(1)))
#define LAS __attribute__((address_space(3)))
typedef unsigned short bf16;
typedef unsigned v4u __attribute__((ext_vector_type(4)));
typedef float f32x4 __attribute__((ext_vector_type(4)));
typedef short bf16x8 __attribute__((ext_vector_type(8)));
typedef GAS unsigned gu32;
typedef GAS unsigned long long gu64;
#define RLX_AGENT __ATOMIC_RELAXED, __HIP_MEMORY_SCOPE_AGENT
#define LDS_WAIT() asm volatile("s_waitcnt lgkmcnt(0)" ::: "memory")
#define VM_WAIT() asm volatile("s_waitcnt vmcnt(0)" ::: "memory")
__device__ __forceinline__ unsigned long long rt() { return __builtin_amdgcn_s_memrealtime(); }
typedef float pk_f32x2_t __attribute__((ext_vector_type(2))); typedef __bf16 pk_bf16x2_t __attribute__((ext_vector_type(2)));
__device__ __forceinline__ unsigned pk2(float lo, float hi) { pk_f32x2_t v = {lo, hi}; pk_bf16x2_t b = __builtin_convertvector(v, pk_bf16x2_t); return __builtin_bit_cast(unsigned, b); }
__device__ __forceinline__ unsigned f2bf(float f) { return pk2(f, 0.f) & 0xffffu; }

#define XB_TMO      128
#define XB_XCNT(j)  (256  + 64 * (j))
#define XB_XSUB(j)  (1280 + 64 * (j))
#define XB_XGEN(j)  (2304 + 64 * (j))
#define XB_TOP      3328
#define XB_TOPGEN   3392
#define XCD_BAR_WORDS 3456
#define XB_SPIN_CAP (1u << 18)

__device__ __forceinline__ unsigned xb_ld(unsigned* p)              { return __hip_atomic_load(p, __ATOMIC_RELAXED, __HIP_MEMORY_SCOPE_AGENT); }
__device__ __forceinline__ unsigned xb_add(unsigned* p, unsigned v) { return __hip_atomic_fetch_add(p, v, __ATOMIC_RELAXED, __HIP_MEMORY_SCOPE_AGENT); }
__device__ __forceinline__ unsigned xb_xcc_id() { return (unsigned)__builtin_amdgcn_s_getreg((3 << 11) | 20) & 0xFu; }
#define XB_SPIN(cond, bar) do { unsigned _sp = 0; while (cond) { __builtin_amdgcn_s_sleep(1); \
    if ((++_sp & 255u) == 0u) { if (xb_ld(&(bar)[XB_TMO])) break; if (_sp > XB_SPIN_CAP) { atomicAdd(&(bar)[XB_TMO], 1u); break; } } } } while (0)

struct XcdBarrier {
    unsigned* bar; unsigned x;
    volatile LAS unsigned* st;
};

__device__ __forceinline__ XcdBarrier xcd_barrier_post(unsigned* bar, volatile LAS unsigned* st) {
    XcdBarrier b; b.bar = bar; b.x = xb_xcc_id(); b.st = st;
    if (threadIdx.x == 0) (void)xb_add(&bar[XB_XCNT(b.x)], 1u);
    return b;
}
__device__ __forceinline__ void xcd_barrier_complete(unsigned* bar, unsigned x, unsigned& nloc, unsigned& nx) {
    const unsigned G = gridDim.x * gridDim.y * gridDim.z;
    unsigned sum, cnt, mine, sp = 0u;
    for (;;) {
        sum = 0u; cnt = 0u; mine = 0u;
#pragma unroll
        for (unsigned j = 0; j < 16; ++j) { const unsigned c = xb_ld(&bar[XB_XCNT(j)]); sum += c; cnt += (c > 0u) ? 1u : 0u; mine = (j == x) ? c : mine; }
        if (sum == G) break;
        __builtin_amdgcn_s_sleep(1);
        if ((++sp & 255u) == 0u) { if (xb_ld(&bar[XB_TMO])) break; if (sp > XB_SPIN_CAP) { atomicAdd(&bar[XB_TMO], 1u); break; } }
    }
    nloc = mine > 0u ? mine : 1u; nx = cnt > 0u ? cnt : 1u;
}

__device__ __forceinline__ void xcd_barrier(const XcdBarrier& b) {
    asm volatile("s_waitcnt vmcnt(0)" ::: "memory");
    __syncthreads();
    if (threadIdx.x == 0) {
        unsigned* bar = b.bar;
        __builtin_amdgcn_s_waitcnt(0);
        unsigned nloc = b.st[0], nx = b.st[1];
        if (nloc == 0u) { xcd_barrier_complete(bar, b.x, nloc, nx); b.st[0] = nloc; b.st[1] = nx; }
        const unsigned old = xb_add(&bar[XB_XSUB(b.x)], 1u);
        const unsigned gen = old / nloc;
        if (old + 1u == (gen + 1u) * nloc) {
            __builtin_amdgcn_fence(__ATOMIC_RELEASE, "agent");
            asm volatile("s_waitcnt vmcnt(0)" ::: "memory");
            const unsigned og = xb_add(&bar[XB_TOP], 1u);
            const unsigned tg = og / nx;
            if (og + 1u == (tg + 1u) * nx) xb_add(&bar[XB_TOPGEN], 1u);
            else XB_SPIN(xb_ld(&bar[XB_TOPGEN]) == tg, bar);
            __builtin_amdgcn_fence(__ATOMIC_ACQUIRE, "agent");
            xb_add(&bar[XB_XGEN(b.x)], 1u);
            asm volatile("s_waitcnt vmcnt(0)" ::: "memory");
        } else {
            XB_SPIN(xb_ld(&bar[XB_XGEN(b.x)]) == gen, bar);
            __builtin_amdgcn_fence(__ATOMIC_ACQUIRE, "agent");
            asm volatile("s_waitcnt vmcnt(0)" ::: "memory");
        }
    }
    __syncthreads();
}
__device__ __forceinline__ float wave_sum(float v) {
#pragma unroll
    for (int o = 1; o < 64; o <<= 1) v += __shfl_xor(v, o);
    return v;
}
__device__ __forceinline__ float bf2f(unsigned short b) { return __uint_as_float((unsigned)b << 16); }

__device__ __forceinline__ void tr_item(const float* W, int N, bf16* WT, int pitch, int kcol0, int k0, int n0, int drow0, LAS float* scr, int lane) {
#pragma unroll 8
    for (int i = 0; i < 32; ++i) { const int kk = 2 * i + (lane >> 5); scr[kk * 33 + (lane & 31)] = W[(size_t)(k0 + kk) * N + n0 + (lane & 31)]; }
    LDS_WAIT(); asm volatile("" ::: "memory");
    const int c = lane & 7;
#pragma unroll
    for (int j = 0; j < 4; ++j) { const int n = (lane >> 3) + 8 * j; const LAS float* s = scr + (8 * c) * 33 + n;
        v4u o; o.x = pk2(s[0 * 33], s[1 * 33]); o.y = pk2(s[2 * 33], s[3 * 33]); o.z = pk2(s[4 * 33], s[5 * 33]); o.w = pk2(s[6 * 33], s[7 * 33]);
        *(GAS v4u*)(WT + (size_t)(drow0 + n) * pitch + kcol0 + k0 + 8 * c) = o; }
    LDS_WAIT(); asm volatile("" ::: "memory");
}

struct Ptrs {
    const float *x, *norm1_w, *w_in, *conv_w, *a_log_f, *a_log_b, *dtb_f, *dtb_b, *gdn_nw, *w_ba, *w_bb, *w_out, *norm2_w, *router_w, *router_b, *w_gu, *b_gu, *w_d, *b_d, *normf_w;
    float* out; unsigned char* ws;
};
struct Args { Ptrs p; int ph_lo, ph_hi, li, pad; };

__device__ __forceinline__ void p0_prologue(const Ptrs& P, LAS unsigned char* lds, int vcu, int G, int wave, int lane) {
    LAS float* scr = (LAS float*)(lds + RING_OFF + wave * 16384);
    const int gw = vcu * NWAVES + wave, NGW = G * NWAVES;
    bf16* WIN = (bf16*)(P.ws + WS_WIN); bf16* WAB = (bf16*)(P.ws + WS_WAB); bf16* WOUT = (bf16*)(P.ws + WS_WOUT); bf16* WGU = (bf16*)(P.ws + WS_WGU); bf16* WD = (bf16*)(P.ws + WS_WD);
    constexpr int I_IN = 16 * 241, I_BA = 8 * 32, I_BB = 16 * 32, I_OUT = 16 * 32, I_GU = 32 * 16 * 64, I_D = 32 * 16 * 32;
    constexpr int NITEMS = I_IN + I_BA + I_BB + I_OUT + I_GU + I_D;
    const int nitems = (G == 256 && !RIDE_OFF) ? I_IN + I_BA + I_BB + I_OUT : NITEMS;
    for (int it = gw; it < nitems; it += NGW) {
        int r = it;
        if (r < I_IN) { const int kb = r / 241, nb = r % 241, n0 = 32 * nb;
            const int d0 = n0 < 5632 ? n0 : (n0 < 5664 ? P_AF + (n0 - 5632) : P_GA + (n0 - 5664));
            tr_item(P.w_in, NIN, WIN, 1024, 0, 64 * kb, n0, d0, scr, lane); continue; } r -= I_IN;
        if (r < I_BA) { tr_item(P.w_ba, 1024, WAB, KAB, 0, 64 * (r / 32), 32 * (r % 32), 32 * (r % 32), scr, lane); continue; } r -= I_BA;
        if (r < I_BB) { tr_item(P.w_bb, 1024, WAB, KAB, 512, 64 * (r / 32), 32 * (r % 32), 32 * (r % 32), scr, lane); continue; } r -= I_BB;
        if (r < I_OUT) { tr_item(P.w_out, 1024, WOUT, 1024, 0, 64 * (r / 32), 32 * (r % 32), 32 * (r % 32), scr, lane); continue; } r -= I_OUT;
        if (r < I_GU) { const int e = r / 1024, q = r % 1024, kb = q / 64, nb = q % 64, n0 = 32 * nb;
            const int d0 = n0 < 1024 ? 256 * (n0 / 128) + (n0 % 128) : 256 * ((n0 - 1024) / 128) + 128 + ((n0 - 1024) % 128);
            tr_item(P.w_gu + (size_t)e * 1024 * 2048, 2048, WGU + (size_t)e * 2048 * 1024, 1024, 0, 64 * kb, n0, d0, scr, lane); continue; } r -= I_GU;
        { const int e = r / 512, q = r % 512;
            tr_item(P.w_d + (size_t)e * 1024 * 1024, 1024, WD + (size_t)e * 1024 * 1024, 1024, 0, 64 * (q / 32), 32 * (q % 32), 32 * (q % 32), scr, lane); }
    }
    for (int i = gw * 64 + lane; i < 224 * 1024 / 8; i += NGW * 64) ((GAS v4u*)(WIN + (size_t)7712 * 1024))[i] = (v4u){0u, 0u, 0u, 0u};
    bf16* XN = (bf16*)(P.ws + WS_XN);
    for (int m = gw; m < M; m += NGW) {
        const GAS f32x4* xr = (const GAS f32x4*)(P.x + (size_t)m * DM) + lane; const GAS f32x4* wr = (const GAS f32x4*)P.norm1_w + lane;
        f32x4 v[4]; float s = 0.f;
#pragma unroll
        for (int j = 0; j < 4; ++j) { v[j] = xr[64 * j]; s += (v[j].x * v[j].x + v[j].y * v[j].y) + (v[j].z * v[j].z + v[j].w * v[j].w); }
        const float rstd = rsqrtf(wave_sum(s) * (1.f / DM) + EPS);
        GAS unsigned long long* o8 = (GAS unsigned long long*)(XN + (size_t)m * DM) + lane;
#pragma unroll
        for (int j = 0; j < 4; ++j) { const f32x4 w = wr[64 * j]; o8[64 * j] = (unsigned long long)pk2(v[j].x * rstd * w.x, v[j].y * rstd * w.y) | ((unsigned long long)pk2(v[j].z * rstd * w.z, v[j].w * rstd * w.w) << 32); }
    }
}

__device__ __forceinline__ void build_etab(const unsigned* cnt, LAS int* etab, int tid) {
    if (tid < 32) etab[40 + tid] = (int)__hip_atomic_load(cnt + tid, __ATOMIC_RELAXED, __HIP_MEMORY_SCOPE_AGENT);
    LDS_WAIT(); __syncthreads();
    if (tid == 0) { int s = 0; for (int e = 0; e < 32; ++e) { etab[e] = s; s += (etab[40 + e] + 255) >> 8; } etab[32] = s; }
    LDS_WAIT(); __syncthreads();
}

template <int VAR> __device__ __forceinline__ void p7_router(const Ptrs& P, LAS unsigned char* lds, int G, int tid, int wave, int lane) {
    LAS float* rw = (LAS float*)(lds + RING_OFF);
    LAS int* hist = (LAS int*)(lds + ETAB_OFF);
    LAS int* asg = (LAS int*)(lds + GTAB_OFF);
    const float* X1 = P.out; bf16* H2 = (bf16*)(P.ws + (VAR ? WS_ACT : WS_XN));
    unsigned* CNT = (unsigned*)(P.ws + WS_CTL) + CW_CNT; int* LIST = (int*)(P.ws + WS_LIST); float* GATEL = (float*)(P.ws + WS_GATEL); int* ASG = (int*)(P.ws + WS_ASG);
    for (int i = tid; i < 1024 * 8; i += 512) { const int c = i >> 3, e4 = i & 7, rho = ((((c >> 8) << 2) + (c & 3)) << 6) + ((c >> 2) & 63);
        ((LAS f32x4*)rw)[rho * 8 + (e4 ^ ((rho >> 1) & 7))] = ((const GAS f32x4*)P.router_w)[i]; }
    for (int grp = blockIdx.x; grp < M / 64; grp += G) {
        const int r0 = grp * 64;
        if (tid < 64) hist[tid] = 0;
        LDS_WAIT(); __syncthreads();
#pragma unroll 1
        for (int i = 0; i < 8; i += 2) {
            const int lrow = wave * 8 + i, m = r0 + lrow;
            const GAS f32x4* wr = (const GAS f32x4*)P.norm2_w + lane;
            f32x4 va[4], vb[4]; float sa = 0.f, sb = 0.f;
            { const GAS f32x4* xa = (const GAS f32x4*)(X1 + (size_t)m * DM) + lane; const GAS f32x4* xb = (const GAS f32x4*)(X1 + (size_t)(m + 1) * DM) + lane;
#pragma unroll
              for (int j = 0; j < 4; ++j) { va[j] = xa[64 * j]; vb[j] = xb[64 * j]; }
#pragma unroll
              for (int j = 0; j < 4; ++j) { sa += (va[j].x * va[j].x + va[j].y * va[j].y) + (va[j].z * va[j].z + va[j].w * va[j].w); sb += (vb[j].x * vb[j].x + vb[j].y * vb[j].y) + (vb[j].z * vb[j].z + vb[j].w * vb[j].w); } }
            const float rsa = rsqrtf(wave_sum(sa) * (1.f / DM) + EPS), rsb = rsqrtf(wave_sum(sb) * (1.f / DM) + EPS);
            GAS unsigned long long* oa8 = (GAS unsigned long long*)(H2 + (size_t)m * DM) + lane; GAS unsigned long long* ob8 = (GAS unsigned long long*)(H2 + (size_t)(m + 1) * DM) + lane;
            float acca[32], accb[32];
#pragma unroll
            for (int e = 0; e < 32; ++e) { acca[e] = 0.f; accb[e] = 0.f; }
#pragma unroll
            for (int j = 0; j < 4; ++j) { const f32x4 w = wr[64 * j];
                va[j].x *= rsa * w.x; va[j].y *= rsa * w.y; va[j].z *= rsa * w.z; va[j].w *= rsa * w.w; vb[j].x *= rsb * w.x; vb[j].y *= rsb * w.y; vb[j].z *= rsb * w.z; vb[j].w *= rsb * w.w;
                oa8[64 * j] = (unsigned long long)pk2(va[j].x, va[j].y) | ((unsigned long long)pk2(va[j].z, va[j].w) << 32);
                ob8[64 * j] = (unsigned long long)pk2(vb[j].x, vb[j].y) | ((unsigned long long)pk2(vb[j].z, vb[j].w) << 32);
#pragma unroll
                for (int q = 0; q < 4; ++q) { const float ha = va[j][q], hb = vb[j][q]; const LAS f32x4* rp = (const LAS f32x4*)rw + ((4 * j + q) * 64 + lane) * 8; const int sw = (lane >> 1) & 7;
#pragma unroll
                    for (int e4 = 0; e4 < 8; ++e4) { const f32x4 r4 = rp[e4 ^ sw];
                        acca[4 * e4] += ha * r4.x; acca[4 * e4 + 1] += ha * r4.y; acca[4 * e4 + 2] += ha * r4.z; acca[4 * e4 + 3] += ha * r4.w;
                        accb[4 * e4] += hb * r4.x; accb[4 * e4 + 1] += hb * r4.y; accb[4 * e4 + 2] += hb * r4.z; accb[4 * e4 + 3] += hb * r4.w; } } }
            float r32[32], r16[16], r8[8], r4[4], r2[2], lg;
            { const bool hi = (lane >> 5) & 1;
#pragma unroll
              for (int q = 0; q < 32; ++q) { const float keep = hi ? accb[q] : acca[q], send = hi ? acca[q] : accb[q]; r32[q] = keep + __shfl_xor(send, 32); } }
            { const bool hi = (lane >> 4) & 1;
#pragma unroll
              for (int q = 0; q < 16; ++q) { const float keep = hi ? r32[16 + q] : r32[q], send = hi ? r32[q] : r32[16 + q]; r16[q] = keep + __shfl_xor(send, 16); } }
            { const bool hi = (lane >> 3) & 1;
#pragma unroll
              for (int q = 0; q < 8; ++q) { const float keep = hi ? r16[8 + q] : r16[q], send = hi ? r16[q] : r16[8 + q]; r8[q] = keep + __shfl_xor(send, 8); } }
            { const bool hi = (lane >> 2) & 1;
#pragma unroll
              for (int q = 0; q < 4; ++q) { const float keep = hi ? r8[4 + q] : r8[q], send = hi ? r8[q] : r8[4 + q]; r4[q] = keep + __shfl_xor(send, 4); } }
            { const bool hi = (lane >> 1) & 1;
#pragma unroll
              for (int q = 0; q < 2; ++q) { const float keep = hi ? r4[2 + q] : r4[q], send = hi ? r4[q] : r4[2 + q]; r2[q] = keep + __shfl_xor(send, 2); } }
            { const bool hi = lane & 1; const float keep = hi ? r2[1] : r2[0], send = hi ? r2[0] : r2[1]; lg = keep + __shfl_xor(send, 1); }
            const int e = lane & 31, half = lane >> 5; lg += P.router_b[e];
            float lv[4]; int li[4]; float cur = lg;
#pragma unroll
            for (int r = 0; r < 4; ++r) { float bv = cur; int bi = e;
#pragma unroll
                for (int o = 1; o < 32; o <<= 1) { const float ov = __shfl_xor(bv, o); const int oi = __shfl_xor(bi, o); if (ov > bv || (ov == bv && oi < bi)) { bv = ov; bi = oi; } }
                lv[r] = bv; li[r] = bi; if (e == bi) cur = -3.0e38f; }
            const float e1 = __expf(lv[1] - lv[0]), e2 = __expf(lv[2] - lv[0]), e3 = __expf(lv[3] - lv[0]);
            const float inv = 1.f / (1.f + e1 + e2 + e3);
            if (e < 4) {
                const float g = (e == 0 ? 1.f : e == 1 ? e1 : e == 2 ? e2 : e3) * inv;
                const int ee = e == 0 ? li[0] : e == 1 ? li[1] : e == 2 ? li[2] : li[3];
                const int rank = atomicAdd((int*)(hist + ee), 1);
                const int a = (lrow + half) * 4 + e;
                asg[a] = ee | (rank << 8); asg[256 + a] = __float_as_int(g); asg[512 + a] = (m + half) * 4 + e;
            }
        }
        LDS_WAIT(); __syncthreads();
        if (tid < 32) hist[32 + tid] = VAR ? 0 : (int)__hip_atomic_fetch_add(CNT + tid, (unsigned)hist[tid], __ATOMIC_RELAXED, __HIP_MEMORY_SCOPE_AGENT);
        LDS_WAIT(); __syncthreads();
        if (tid < 256 && !VAR) { const int w = asg[tid], ee = w & 255, pos = hist[32 + ee] + (w >> 8); const int tk = asg[512 + tid];
            LIST[(size_t)ee * M + pos] = tk >> 2; GATEL[(size_t)ee * M + pos] = __int_as_float(asg[256 + tid]); ASG[tk] = (ee << 16) | pos; }
        LDS_WAIT(); __syncthreads();
    }
}

template <int VAR> __device__ __forceinline__ void p10_final(const Ptrs& P, LAS unsigned char* lds, int G, int tid, int wave, int lane) {
    LAS int* etab = (LAS int*)(lds + ETAB_OFF);
    build_etab((const unsigned*)(P.ws + WS_CTL) + CW_CNT, etab, tid);
    const int* ASG = (const int*)(P.ws + WS_ASG); const bf16* YEXP = (const bf16*)(P.ws + WS_YEXP);
    const int gw = blockIdx.x * NWAVES + wave, NGW = G * NWAVES;
    typedef unsigned u32x2 __attribute__((ext_vector_type(2)));
    const GAS f32x4* wr = (const GAS f32x4*)P.normf_w + lane;
    for (int m0 = gw; m0 < M; m0 += 2 * NGW) {
        const int m1 = m0 + NGW < M ? m0 + NGW : m0;
        int slot[2][4];
#pragma unroll
        for (int q = 0; q < 2; ++q) { const int4 a4 = *(const int4*)(ASG + (size_t)(q ? m1 : m0) * 4);
            slot[q][0] = etab[a4.x >> 16] * 256 + (a4.x & 0xffff); slot[q][1] = etab[a4.y >> 16] * 256 + (a4.y & 0xffff); slot[q][2] = etab[a4.z >> 16] * 256 + (a4.z & 0xffff); slot[q][3] = etab[a4.w >> 16] * 256 + (a4.w & 0xffff); }
        f32x4 v[2][4]; u32x2 y[2][4][4];
#pragma unroll
        for (int q = 0; q < 2; ++q) { const GAS f32x4* xr = (const GAS f32x4*)(P.out + (size_t)(q ? m1 : m0) * DM) + lane;
#pragma unroll
            for (int j = 0; j < 4; ++j) v[q][j] = xr[64 * j];
#pragma unroll
            for (int k = 0; k < 4; ++k) { const GAS u32x2* yr = (const GAS u32x2*)(YEXP + (size_t)slot[q][k] * DM) + lane;
#pragma unroll
                for (int j = 0; j < 4; ++j) y[q][k][j] = yr[64 * j]; } }
#pragma unroll
        for (int q = 0; q < 2; ++q) {
            float s = 0.f;
#pragma unroll
            for (int j = 0; j < 4; ++j) {
#pragma unroll
                for (int k = 0; k < 4; ++k) { const u32x2 yy = y[q][k][j]; v[q][j].x += __uint_as_float(yy.x << 16); v[q][j].y += __uint_as_float(yy.x & 0xffff0000u); v[q][j].z += __uint_as_float(yy.y << 16); v[q][j].w += __uint_as_float(yy.y & 0xffff0000u); }
                s += (v[q][j].x * v[q][j].x + v[q][j].y * v[q][j].y) + (v[q][j].z * v[q][j].z + v[q][j].w * v[q][j].w); }
            const float rstd = rsqrtf(wave_sum(s) * (1.f / DM) + EPS);
            if (q == 0 || m1 != m0) { GAS f32x4* xo = (GAS f32x4*)((VAR ? (float*)(P.ws + WS_ACT) : P.out) + (size_t)(q ? m1 : m0) * DM) + lane;
#pragma unroll
                for (int j = 0; j < 4; ++j) { const f32x4 w = wr[64 * j]; xo[64 * j] = (f32x4){v[q][j].x * rstd * w.x, v[q][j].y * rstd * w.y, v[q][j].z * rstd * w.z, v[q][j].w * rstd * w.w}; } }
        }
    }
}

typedef float f32x16 __attribute__((ext_vector_type(16)));
typedef short v4i16_t __attribute__((ext_vector_type(4)));
typedef float f32x2_t __attribute__((ext_vector_type(2))); typedef __bf16 bf16x2_t __attribute__((ext_vector_type(2)));
__device__ __forceinline__ unsigned cvtpk(float lo, float hi) { f32x2_t v = {lo, hi}; bf16x2_t b = __builtin_convertvector(v, bf16x2_t); return __builtin_bit_cast(unsigned, b); }
constexpr int ATT_VPITCH = 144;
constexpr int ATT_WAVE_LDS = 32 * ATT_VPITCH;
__device__ __forceinline__ void attn_unit(const bf16* proj, bf16* OP, float* LSE, LAS unsigned char* vt, int unit, int lane) {
    const int q128 = unit & 127, p = (unit >> 7) % 3, bh = unit / 384, b = bh >> 3, h = bh & 7;
    const int r = p == 0 ? 1 : (p == 1 ? 4 : 16), gpc = 128 / r, c = q128 / gpc, g = q128 % gpc, L = SEQ / r, u0 = 32 * g;
    int lq = lane & 31, hi = lane >> 5;
    asm volatile("" : "+v"(lq), "+v"(hi));
    const bf16* base = proj + ((size_t)b * SEQ + c) * NINP + h * 64;
    const size_t ustride = (size_t)r * NINP;
    const int vrow = lane >> 3, vch = lane & 7;
    v4u qst[4], kst[5][4];
#pragma unroll
    for (int i = 0; i < 4; ++i) qst[i] = *(const v4u*)(base + (size_t)(u0 + vrow + 8 * i) * ustride + P_QA + 8 * vch);
#define ATT_KLOAD(t) do { _Pragma("unroll") for (int i = 0; i < 4; ++i) { int uk_ = u0 - 64 + 32 * (t) + vrow + 8 * i; uk_ = uk_ < 0 ? 0 : (uk_ > L - 1 ? L - 1 : uk_); kst[t][i] = *(const v4u*)(base + (size_t)uk_ * ustride + P_KA + 8 * vch); } } while (0)
    ATT_KLOAD(0); ATT_KLOAD(1); ATT_KLOAD(2);
    bf16x8 qf[4];
#pragma unroll
    for (int i = 0; i < 4; ++i) *(LAS v4u*)(vt + (vrow + 8 * i) * ATT_VPITCH + vch * 16) = qst[i];
    asm volatile("" ::: "memory");
#pragma unroll
    for (int d0 = 0; d0 < 4; ++d0) qf[d0] = *(const LAS bf16x8*)(vt + lq * ATT_VPITCH + (16 * d0 + 8 * hi) * 2);
    asm volatile("" ::: "memory");
    f32x16 sc[5];
#pragma unroll
    for (int t = 0; t < 5; ++t) {
#pragma unroll
        for (int i = 0; i < 4; ++i) *(LAS v4u*)(vt + (vrow + 8 * i) * ATT_VPITCH + vch * 16) = kst[t][i];
        asm volatile("" ::: "memory");
        if (t == 0) ATT_KLOAD(3);
        if (t == 1) ATT_KLOAD(4);
        f32x16 a = {};
#pragma unroll
        for (int d0 = 0; d0 < 4; ++d0) a = __builtin_amdgcn_mfma_f32_32x32x16_bf16(*(const LAS bf16x8*)(vt + lq * ATT_VPITCH + (16 * d0 + 8 * hi) * 2), qf[d0], a, 0, 0, 0);
        sc[t] = a;
        asm volatile("" ::: "memory");
    }
#undef ATT_KLOAD
    v4u vst[5][4];
#define ATT_VLOAD(t) do { _Pragma("unroll") for (int i = 0; i < 4; ++i) { int uk_ = u0 - 64 + 32 * (t) + vrow + 8 * i; uk_ = uk_ < 0 ? 0 : (uk_ > L - 1 ? L - 1 : uk_); vst[t][i] = *(const v4u*)(base + (size_t)uk_ * ustride + P_VA + 8 * vch); } } while (0)
    ATT_VLOAD(0); ATT_VLOAD(1);
    const float slope2 = exp2f(-(float)(h + 1)) * (float)r * 1.4426950408889634f, qs = 0.125f * 1.4426950408889634f;
    const float Df = (float)(4 * hi - lq);
    float mx = -1e30f;
#pragma unroll
    for (int t = 0; t < 5; ++t)
#pragma unroll
        for (int i = 0; i < 16; ++i) {
            const float diff = (float)(32 * t + (i & 3) + 8 * (i >> 2) - 64) + Df;
            float v = fmaf(sc[t][i], qs, -slope2 * fabsf(diff));
            if (t == 0) v = diff >= -64.f ? v : -1e30f;
            if (t == 4) v = diff <= 64.f ? v : -1e30f;
            sc[t][i] = v;
        }
    if (u0 < 64 || u0 + 96 > L) {
#pragma unroll
        for (int t = 0; t < 5; ++t)
#pragma unroll
            for (int i = 0; i < 16; ++i) { const int uk = u0 - 64 + 32 * t + (i & 3) + 8 * (i >> 2) + 4 * hi; if (uk < 0 || uk >= L) sc[t][i] = -1e30f; }
    }
#pragma unroll
    for (int t = 0; t < 5; ++t)
#pragma unroll
        for (int i = 0; i < 16; ++i) mx = fmaxf(mx, sc[t][i]);
    mx = fmaxf(mx, __shfl_xor(mx, 32));
    float l = 0.f;
#pragma unroll
    for (int t = 0; t < 5; ++t)
#pragma unroll
        for (int i = 0; i < 16; ++i) { const float e = __builtin_amdgcn_exp2f(sc[t][i] - mx); sc[t][i] = e; l += e; }
    l += __shfl_xor(l, 32);
    const float il = __builtin_amdgcn_rcpf(l);
    unsigned pf[5][2][4];
#pragma unroll
    for (int t = 0; t < 5; ++t)
#pragma unroll
        for (int s = 0; s < 2; ++s)
#pragma unroll
            for (int w = 0; w < 4; ++w) pf[t][s][w] = cvtpk(sc[t][8 * s + 2 * w], sc[t][8 * s + 2 * w + 1]);
    f32x16 o0 = {}, o1 = {};
    const int i16 = lane & 15, g16 = (lane >> 4) & 1;
    const LAS unsigned char* trb = vt + (4 * hi + (i16 >> 2)) * ATT_VPITCH + (16 * g16 + 4 * (i16 & 3)) * 2;
#pragma unroll
    for (int t = 0; t < 5; ++t) {
#pragma unroll
        for (int i = 0; i < 4; ++i) *(LAS v4u*)(vt + (vrow + 8 * i) * ATT_VPITCH + vch * 16) = vst[t][i];
        asm volatile("" ::: "memory");
        if (t == 0) ATT_VLOAD(2);
        if (t == 1) ATT_VLOAD(3);
        if (t == 2) ATT_VLOAD(4);
#pragma unroll
        for (int s = 0; s < 2; ++s) {
#pragma unroll
            for (int dt = 0; dt < 2; ++dt) {
                const LAS unsigned char* pa = trb + (16 * s) * ATT_VPITCH + dt * 64;
                const v4i16_t lo = __builtin_amdgcn_ds_read_tr16_b64_v4i16((LAS v4i16_t*)pa);
                const v4i16_t hh = __builtin_amdgcn_ds_read_tr16_b64_v4i16((LAS v4i16_t*)(pa + 8 * ATT_VPITCH));
                const bf16x8 vf = (bf16x8){lo[0], lo[1], lo[2], lo[3], hh[0], hh[1], hh[2], hh[3]};
                const v4u pw = (v4u){pf[t][s][0], pf[t][s][1], pf[t][s][2], pf[t][s][3]};
                if (dt == 0) o0 = __builtin_amdgcn_mfma_f32_32x32x16_bf16(vf, __builtin_bit_cast(bf16x8, pw), o0, 0, 0, 0);
                else o1 = __builtin_amdgcn_mfma_f32_32x32x16_bf16(vf, __builtin_bit_cast(bf16x8, pw), o1, 0, 0, 0);
            }
        }
        asm volatile("" ::: "memory");
    }
#undef ATT_VLOAD
    const size_t tok = (size_t)b * SEQ + (size_t)(u0 + lq) * r + c;
    typedef unsigned u32x2 __attribute__((ext_vector_type(2)));
#pragma unroll
    for (int qd = 0; qd < 4; ++qd) {
        *(LAS u32x2*)(vt + lq * ATT_VPITCH + (4 * hi + 8 * qd) * 2) = (u32x2){cvtpk(o0[4 * qd] * il, o0[4 * qd + 1] * il), cvtpk(o0[4 * qd + 2] * il, o0[4 * qd + 3] * il)};
        *(LAS u32x2*)(vt + lq * ATT_VPITCH + (32 + 4 * hi + 8 * qd) * 2) = (u32x2){cvtpk(o1[4 * qd] * il, o1[4 * qd + 1] * il), cvtpk(o1[4 * qd + 2] * il, o1[4 * qd + 3] * il)};
    }
    asm volatile("" ::: "memory");
#pragma unroll
    for (int i = 0; i < 4; ++i) {
        const v4u ov = *(const LAS v4u*)(vt + (vrow + 8 * i) * ATT_VPITCH + vch * 16);
        *(v4u*)(OP + ((size_t)p * M + (size_t)b * SEQ + (size_t)(u0 + vrow + 8 * i) * r + c) * 512 + h * 64 + 8 * vch) = ov;
    }
    asm volatile("" ::: "memory");
    if (hi == 0) LSE[((size_t)p * M + tok) * 8 + h] = (mx + __builtin_amdgcn_logf(l)) * 0.6931471805599453f;
}
__device__ __forceinline__ void attn_phase(const Ptrs& P, LAS unsigned char* lds, int vcu, int G, int wave, int lane, int i0 = 0, int i1 = 1 << 30) {
    const bf16* proj = (const bf16*)(P.ws + WS_PROJ); bf16* OP = (bf16*)(P.ws + WS_OP); float* LSE = (float*)(P.ws + WS_LSE);
    LAS unsigned char* vt = lds + RING_OFF + wave * ATT_WAVE_LDS;
    for (int i = i0, unit = (vcu + i0 * G) * NWAVES + wave; i < i1 && unit < BATCH * 8 * 3 * 128; ++i, unit += G * NWAVES) attn_unit(proj, OP, LSE, vt, unit, lane);
}
__device__ __forceinline__ void merge_attn(const Ptrs& P, int G, int wave, int lane) {
    const bf16* OP = (const bf16*)(P.ws + WS_OP); const float* LSE = (const float*)(P.ws + WS_LSE); bf16* YAB = (bf16*)(P.ws + WS_YAB);
    for (int m = blockIdx.x * NWAVES + wave; m < M; m += G * NWAVES) {
        const int h = lane >> 3;
        const float l0 = LSE[(size_t)m * 8 + h], l1 = LSE[((size_t)M + m) * 8 + h], l2 = LSE[((size_t)2 * M + m) * 8 + h];
        const float mx = fmaxf(l0, fmaxf(l1, l2)), e0 = __expf(l0 - mx), e1 = __expf(l1 - mx), e2 = __expf(l2 - mx), inv = 1.f / (e0 + e1 + e2);
        const float w0 = e0 * inv, w1 = e1 * inv, w2 = e2 * inv;
        const v4u a = *(const v4u*)(OP + (size_t)m * 512 + lane * 8), bb = *(const v4u*)(OP + ((size_t)M + m) * 512 + lane * 8), cc = *(const v4u*)(OP + ((size_t)2 * M + m) * 512 + lane * 8);
        v4u o;
#define MG(x) pk2(w0 * __uint_as_float(a.x << 16) + w1 * __uint_as_float(bb.x << 16) + w2 * __uint_as_float(cc.x << 16), w0 * __uint_as_float(a.x & 0xffff0000u) + w1 * __uint_as_float(bb.x & 0xffff0000u) + w2 * __uint_as_float(cc.x & 0xffff0000u))
        o.x = MG(x); o.y = MG(y); o.z = MG(z); o.w = MG(w);
#undef MG
        *(v4u*)(YAB + (size_t)m * KAB + lane * 8) = o;
    }
}
constexpr int GL_QN = 0, GL_KN = 18432, GL_KT = 36864, GL_VT = 57472;
constexpr int GTS = 2576;
__device__ __forceinline__ constexpr int gl_mat(int d, int which) { return d == 0 ? 78080 + which * 10240 : (which < 2 ? 108800 + which * 10240 : 140800); }
static_assert(GL_VT + 8 * GTS == 78080 && gl_mat(1, 1) + 10240 <= RING_BYTES && GTAB_OFF + 7680 <= 140800 && 140800 + 10240 <= LDS_BYTES, "prep LDS map");
constexpr int GP128 = 288, GP64 = 160;
__device__ __forceinline__ bf16x8 ldfrag(const LAS unsigned char* base, int pitch, int r0, int k0, int lane) { return *(const LAS bf16x8*)(base + (r0 + (lane & 15)) * pitch + (k0 + 8 * (lane >> 4)) * 2); }
typedef unsigned u32x2 __attribute__((ext_vector_type(2)));
#define WG_BAR() do { asm volatile("s_waitcnt lgkmcnt(0)" ::: "memory"); __builtin_amdgcn_s_barrier(); asm volatile("" ::: "memory"); } while (0)
__device__ __forceinline__ float softplusf_(float x) { return x > 20.f ? x : log1pf(__expf(x)); }

struct CvIn { f32x4 v[8]; };
__device__ __forceinline__ void cv_decode(int p, const Ptrs& P, const float*& W, bf16*& WT, int& N, int& k0, int& n0, int& d0) {
    if (p < 32768) { const int e = p >> 10, r = p & 1023, kb = r >> 6, nb = r & 63; N = 2048; k0 = 64 * kb; n0 = 32 * nb;
        W = P.w_gu + (size_t)e * 1024 * 2048; WT = (bf16*)(P.ws + WS_WGU) + (size_t)e * 2048 * 1024;
        d0 = n0 < 1024 ? 256 * (n0 / 128) + (n0 % 128) : 256 * ((n0 - 1024) / 128) + 128 + ((n0 - 1024) % 128);
    } else { const int pp = p - 32768, e = pp >> 9, r = pp & 511, kb = r >> 5, nb = r & 31; N = 1024; k0 = 64 * kb; n0 = 32 * nb;
        W = P.w_d + (size_t)e * 1024 * 1024; WT = (bf16*)(P.ws + WS_WD) + (size_t)e * 1024 * 1024; d0 = n0; }
}
__device__ __forceinline__ void cv_load(CvIn& C, const Ptrs& P, int p, int lane) {
    const float* W; bf16* WT; int N, k0, n0, d0; cv_decode(p, P, W, WT, N, k0, n0, d0);
    const float* src = W + (size_t)(k0 + 4 * (lane >> 3)) * N + n0 + 4 * (lane & 7);
#pragma unroll
    for (int b = 0; b < 2; ++b)
#pragma unroll
        for (int j = 0; j < 4; ++j) C.v[b * 4 + j] = *(const f32x4*)(src + (size_t)(32 * b + j) * N);
}
__device__ __forceinline__ void cv_store(const CvIn& C, const Ptrs& P, int p, int lane, LAS unsigned char* buf) {
    const float* W; bf16* WT; int N, k0, n0, d0; cv_decode(p, P, W, WT, N, k0, n0, d0);
    const int r8 = lane >> 3, c4 = lane & 7;
#pragma unroll
    for (int b = 0; b < 2; ++b)
#pragma unroll
        for (int e = 0; e < 4; ++e)
            *(LAS u32x2*)(buf + (4 * c4 + e) * 128 + 16 * (((r8 >> 1) + 4 * b) ^ c4) + 8 * (r8 & 1)) = (u32x2){pk2(C.v[b * 4][e], C.v[b * 4 + 1][e]), pk2(C.v[b * 4 + 2][e], C.v[b * 4 + 3][e])};
    asm volatile("" ::: "memory");
#pragma unroll
    for (int t = 0; t < 4; ++t) { const int n = 8 * t + r8;
        const v4u d = *(const LAS v4u*)(buf + n * 128 + 16 * (c4 ^ ((n >> 2) & 7)));
        *(v4u*)(WT + (size_t)(d0 + n) * 1024 + k0 + 8 * c4) = d; }
    asm volatile("" ::: "memory");
}
constexpr int CV_PAIRS = 49152;
__device__ __forceinline__ void st_rowmajor(LAS unsigned char* mat, const f32x4& p, int rb, int c) {
#pragma unroll
    for (int rho = 0; rho < 4; ++rho) *(LAS bf16*)(mat + (rb + rho) * GP64 + c * 2) = (bf16)f2bf(p[rho]);
}
__device__ __forceinline__ void gdn_prep_item(const Ptrs& P, LAS unsigned char* lds, int bh, int n, int cvbase, bool has_next, unsigned (&TCH)[4], int tid, int wave, int lane, int pmode = 0) {
    const bool nost = pmode & 1, nold = pmode & 2, junk = pmode & 8;
#define JNK(T, p) (junk ? (T)(P.ws + ((size_t)504 << 20) + ((size_t)((unsigned char*)(p) - P.ws) & (((size_t)64 << 20) - 1))) : (p))
    asm volatile("" : "+v"(tid), "+v"(lane));
    const int b = bh >> 3, h = bh & 7, item = bh * 64 + n; const size_t m0 = (size_t)b * SEQ + n * 64;
    const bf16* proj = (const bf16*)(P.ws + WS_PROJ);
    LAS float* SM = (LAS float*)(lds + ETAB_OFF);
    const LAS float* CW = (const LAS float*)(lds + GTAB_OFF);
    float* EG = (float*)(P.ws + WS_GEG);
    const int rp = tid >> 4, part = tid & 15;
    v4u xn[6];
#pragma unroll
    for (int i = 0; i < 6; ++i) { const int t = n * 64 + 2 * rp + i - 2; xn[i] = (v4u){0u, 0u, 0u, 0u};
        if (t >= 0 && t < SEQ && !nold) xn[i] = *(const v4u*)(proj + ((size_t)b * SEQ + t) * NINP + P_QB + h * 128 + part * 8); }
    asm volatile("" ::: "memory");
    if (wave == 0 && !(pmode & 16)) {
        const bf16* pr = proj + (m0 + lane) * NINP;
        const float gf = -__expf(P.a_log_f[h]) * softplusf_(bf2f(pr[P_AF + h]) + P.dtb_f[h]);
        const float gb = -__expf(P.a_log_b[h]) * softplusf_(bf2f(pr[P_AB + h]) + P.dtb_b[h]);
        float cf = gf, cb = gb;
#pragma unroll
        for (int o = 1; o < 64; o <<= 1) { const float t1 = __shfl_up(cf, o), t2 = __shfl_down(cb, o); if (lane >= o) cf += t1; if (lane + o < 64) cb += t2; }
        SM[lane] = cf; SM[64 + lane] = cb; SM[128 + lane] = 1.f / (1.f + __expf(-bf2f(pr[P_BF + h]))); SM[192 + lane] = 1.f / (1.f + __expf(-bf2f(pr[P_BB + h])));
        const float cfl = __shfl(cf, 63), cb0 = __shfl(cb, 0);
        if (!nost && !junk) { EG[(size_t)item * 64 + lane] = __expf(cf); EG[(size_t)(2048 + item) * 64 + lane] = __expf(cb);
        EG[(size_t)(4096 + item) * 64 + lane] = __expf(cfl - cf); EG[(size_t)(6144 + item) * 64 + lane] = __expf(cb0 - cb); }
    }
    {
        bf16* Qg = (bf16*)(P.ws + WS_GQ);
#pragma unroll
        for (int which = 0; which < 3; ++which) {
            v4u x[6];
#pragma unroll
            for (int i = 0; i < 6; ++i) x[i] = xn[i];
            asm volatile("" ::: "memory");
            if (which < 2) {
#pragma unroll
                for (int i = 0; i < 6; ++i) { const int t = n * 64 + 2 * rp + i - 2; xn[i] = (v4u){0u, 0u, 0u, 0u};
                    if (t >= 0 && t < SEQ && !nold) xn[i] = *(const v4u*)(proj + ((size_t)b * SEQ + t) * NINP + P_QB + (which + 1) * 1024 + h * 128 + part * 8); }
            }
            asm volatile("" ::: "memory");
            float a[2][8];
#pragma unroll
            for (int o = 0; o < 2; ++o)
#pragma unroll
                for (int c = 0; c < 8; ++c) a[o][c] = 0.f;
#pragma unroll
            for (int j = 0; j < 5; ++j) {
                const LAS f32x4* wp = (const LAS f32x4*)(CW + (j * 3 + which) * 128 + part * 8);
                const f32x4 w0 = wp[0], w1 = wp[1];
#pragma unroll
                for (int o = 0; o < 2; ++o) { const v4u xv = x[o + j];
                    a[o][0] += __uint_as_float(xv.x << 16) * w0.x; a[o][1] += __uint_as_float(xv.x & 0xffff0000u) * w0.y; a[o][2] += __uint_as_float(xv.y << 16) * w0.z; a[o][3] += __uint_as_float(xv.y & 0xffff0000u) * w0.w;
                    a[o][4] += __uint_as_float(xv.z << 16) * w1.x; a[o][5] += __uint_as_float(xv.z & 0xffff0000u) * w1.y; a[o][6] += __uint_as_float(xv.w << 16) * w1.z; a[o][7] += __uint_as_float(xv.w & 0xffff0000u) * w1.w; }
            }
#pragma unroll
            for (int o = 0; o < 2; ++o) {
                float ss = 0.f;
#pragma unroll
                for (int c = 0; c < 8; ++c) { a[o][c] = a[o][c] * __builtin_amdgcn_rcpf(1.f + __expf(-a[o][c])); ss += a[o][c] * a[o][c]; }
                if (which < 2) {
                    ss += __shfl_xor(ss, 1); ss += __shfl_xor(ss, 2); ss += __shfl_xor(ss, 4); ss += __shfl_xor(ss, 8);
                    const float rn = rsqrtf(ss + EPS) * (which == 0 ? 0.08838834764831845f : 1.f);
#pragma unroll
                    for (int c = 0; c < 8; ++c) a[o][c] *= rn;
                    v4u ov; ov.x = pk2(a[o][0], a[o][1]); ov.y = pk2(a[o][2], a[o][3]); ov.z = pk2(a[o][4], a[o][5]); ov.w = pk2(a[o][6], a[o][7]);
                    *(LAS v4u*)(lds + (which == 0 ? GL_QN : GL_KN) + (2 * rp + o) * GP128 + part * 16) = ov;
                    if (which == 0 && !nost) *JNK(v4u*, (v4u*)(Qg + (m0 + 2 * rp + o) * 1024 + h * 128 + part * 8)) = ov;
                }
            }
            if (which >= 1) {
                LAS unsigned char* tp = lds + (which == 1 ? GL_KT : GL_VT) + (part >> 1) * GTS + ((part & 1) * 8) * GP64 + (2 * rp) * 2;
#pragma unroll
                for (int c = 0; c < 8; ++c) *(LAS unsigned*)(tp + c * GP64) = pk2(a[0][c], a[1][c]);
            }
        }
    }
    WG_BAR();
    if (has_next && !(pmode & 4)) {
        const bf16* tp_;
        if (tid < 408) { const int row = tid / 6, seg = tid % 6; int t = (n + 1) * 64 + row - 2; t = t < 0 ? 0 : (t > SEQ - 1 ? SEQ - 1 : t);
            tp_ = proj + ((size_t)b * SEQ + t) * NINP + P_QB + (seg >> 1) * 1024 + h * 128 + (seg & 1) * 64; }
        else { const int row = tid < 472 ? tid - 408 : 0; tp_ = proj + ((size_t)b * SEQ + (n + 1) * 64 + row) * NINP + P_AF; }
        asm volatile("global_load_dword %0, %1, off" : "+v"(TCH[0]) : "v"(tp_) : "memory");
    }
    { const int dk = tid >> 2, seg = tid & 3; bf16* KTg = (bf16*)(P.ws + WS_GKT) + (size_t)item * 8192 + dk * 64 + seg * 16;
      const LAS v4u* sp = (const LAS v4u*)(lds + GL_KT + (dk >> 4) * GTS + (dk & 15) * GP64 + seg * 32); if (!nost) { *JNK(v4u*, (v4u*)KTg) = sp[0]; *JNK(v4u*, (v4u*)(KTg + 8)) = sp[1]; } }
    const int q4 = lane >> 4, l16 = lane & 15;
    f32x4 accR[2][2];
#pragma unroll 1
    for (int rep2_ = 0; rep2_ < ((PREP_PROBE & 6) ? 2 : 1); ++rep2_) {
    if (rep2_ == 1) WG_BAR();
#pragma unroll
    for (int x = 0; x < 2; ++x) {
        const int tl = 2 * wave + x, mi = tl >> 2, nj = tl & 3, c = nj * 16 + l16, rb = mi * 16 + 4 * q4;
        f32x4 g = {0.f, 0.f, 0.f, 0.f}, qk = {0.f, 0.f, 0.f, 0.f};
#pragma unroll
        for (int kk = 0; kk < 4; ++kk) {
            const bf16x8 am = ldfrag(lds + GL_KN, GP128, mi * 16, kk * 32, lane), bn = ldfrag(lds + GL_KN, GP128, nj * 16, kk * 32, lane), qn = ldfrag(lds + GL_QN, GP128, nj * 16, kk * 32, lane);
            g = __builtin_amdgcn_mfma_f32_16x16x32_bf16(am, bn, g, 0, 0, 0);
            qk = __builtin_amdgcn_mfma_f32_16x16x32_bf16(am, qn, qk, 0, 0, 0);
        }
#pragma unroll
        for (int d = 0; d < 2; ++d) {
            const float gcc = SM[64 * d + c], bc = SM[128 + 64 * d + c];
            const f32x4 gcr = *(const LAS f32x4*)(SM + 64 * d + rb), br = *(const LAS f32x4*)(SM + 128 + 64 * d + rb);
            float at[4], am2[4], qv[4];
#pragma unroll
            for (int rho = 0; rho < 4; ++rho) {
                const int rr = rb + rho;
                const bool low = d == 0 ? (rr > c) : (rr < c);
                const bool upp = d == 0 ? (c > rr) : (c < rr);
                const float e1 = __expf(fminf(gcr[rho] - gcc, 0.f)), e2 = __expf(fminf(gcc - gcr[rho], 0.f));
                at[rho] = low ? br[rho] * e1 * g[rho] : 0.f;
                am2[rho] = upp ? bc * e2 * g[rho] : 0.f;
                const bool qm = d == 0 ? (rr <= c) : (rr >= c);
                qv[rho] = qm ? e2 * qk[rho] : 0.f;
                accR[d][x][rho] = (rr == c ? 1.f : 0.f) - at[rho];
            }
            *(LAS u32x2*)(lds + gl_mat(d, 1) + c * GP64 + rb * 2) = (u32x2){pk2(at[0], at[1]), pk2(at[2], at[3])};
            *(LAS u32x2*)(lds + gl_mat(d, 0) + c * GP64 + rb * 2) = (u32x2){pk2(am2[0], am2[1]), pk2(am2[2], am2[3])};
            *(LAS u32x2*)(lds + gl_mat(d, 2) + c * GP64 + rb * 2) = (u32x2){pk2((rb == c ? 1.f : 0.f) - am2[0], (rb + 1 == c ? 1.f : 0.f) - am2[1]), pk2((rb + 2 == c ? 1.f : 0.f) - am2[2], (rb + 3 == c ? 1.f : 0.f) - am2[3])};
            bf16* qg = (bf16*)(P.ws + WS_GQK) + ((size_t)(d * 2048 + item) * 64 + c) * 64 + rb;
            if (!nost) *JNK(u32x2*, (u32x2*)qg) = (u32x2){pk2(qv[0], qv[1]), pk2(qv[2], qv[3])};
        }
    }
    WG_BAR();
    if ((PREP_PROBE & 2) && rep2_ == 0) continue;
    const int cvb = (rep2_ == ((PREP_PROBE & 6) ? 1 : 0)) ? cvbase : -1;
    CvIn CV;
#pragma unroll
    for (int j = 0; j < 8; ++j) CV.v[j] = (f32x4){0.f, 0.f, 0.f, 0.f};
    auto stage = [&](const int s) __attribute__((always_inline)) {
        f32x4 accP[2][2];
#pragma unroll
        for (int d = 0; d < 2; ++d) {
#pragma unroll
            for (int x = 0; x < 2; ++x) {
                const int tl = 2 * wave + x, mi = tl >> 2, nj = tl & 3;
                f32x4 p = {0.f, 0.f, 0.f, 0.f}; f32x4 rr = accR[d][x];
                if (d == 0 ? (mi >= nj) : (mi <= nj))
#pragma unroll
                for (int kk = 0; kk < 2; ++kk) {
                    const bf16x8 pm = ldfrag(lds + gl_mat(d, 0), GP64, mi * 16, kk * 32, lane), pt = ldfrag(lds + gl_mat(d, 1), GP64, nj * 16, kk * 32, lane), rm = ldfrag(lds + gl_mat(d, 2), GP64, mi * 16, kk * 32, lane);
                    p = __builtin_amdgcn_mfma_f32_16x16x32_bf16(pm, pt, p, 0, 0, 0);
                    rr = __builtin_amdgcn_mfma_f32_16x16x32_bf16(rm, pt, rr, 0, 0, 0);
                }
                accP[d][x] = p; if (s >= 2) accR[d][x] = rr;
            }
        }
        WG_BAR();
#pragma unroll
        for (int d = 0; d < 2; ++d) {
#pragma unroll
            for (int x = 0; x < 2; ++x) {
                const int tl = 2 * wave + x, mi = tl >> 2, nj = tl & 3, c = nj * 16 + l16, rb = mi * 16 + 4 * q4;
                if (!(d == 0 ? (mi >= nj) : (mi <= nj))) continue;
                if (s < 6) {
                    const f32x4 p = accP[d][x];
                    *(LAS u32x2*)(lds + gl_mat(d, 1) + c * GP64 + rb * 2) = (u32x2){pk2(p[0], p[1]), pk2(p[2], p[3])};
                    st_rowmajor(lds + gl_mat(d, 0), p, rb, c); st_rowmajor(lds + gl_mat(d, 2), accR[d][x], rb, c);
                } else {
                    const float bc = SM[128 + 64 * d + c], bg = bc * __expf(SM[64 * d + c]);
                    st_rowmajor(lds + gl_mat(d, 2), accR[d][x] * bc, rb, c); st_rowmajor(lds + gl_mat(d, 0), accR[d][x] * bg, rb, c);
                }
            }
        }
        WG_BAR();
    };
#pragma unroll 1
    for (int sp = 0; sp < 3; ++sp) {
        if (cvb >= 0) cv_load(CV, P, cvb + sp * 2048, lane);
        stage(2 * sp + 1); stage(2 * sp + 2);
        asm volatile("" :: "v"(CV.v[0]), "v"(CV.v[1]), "v"(CV.v[2]), "v"(CV.v[3]), "v"(CV.v[4]), "v"(CV.v[5]), "v"(CV.v[6]), "v"(CV.v[7]));
        if (cvb >= 0) cv_store(CV, P, cvb + sp * 2048, lane, lds + GL_QN + wave * 4096);
    }
    }
#pragma unroll 1
    for (int rep3_ = 0; rep3_ < ((PREP_PROBE & 8) ? 2 : 1); ++rep3_)
#pragma unroll
    for (int d = 0; d < 2; ++d) {
        bf16* UTg = (bf16*)(P.ws + WS_GUT) + (size_t)(d * 2048 + item) * 8192; bf16* Wg = (bf16*)(P.ws + WS_GW) + (size_t)(d * 2048 + item) * 8192;
#pragma unroll
        for (int xp = 0; xp < 2; ++xp) {
            unsigned ua[2][2], wa[2][2];
#pragma unroll
            for (int xx = 0; xx < 2; ++xx) {
                const int tl = wave + 8 * (2 * xp + xx);
                { const int mi = tl >> 3, nj = tl & 7;
                  f32x4 u = {0.f, 0.f, 0.f, 0.f};
#pragma unroll
                  for (int kk = 0; kk < 2; ++kk) u = __builtin_amdgcn_mfma_f32_16x16x32_bf16(ldfrag(lds + gl_mat(d, 2), GP64, mi * 16, kk * 32, lane), ldfrag(lds + GL_VT + nj * GTS, GP64, 0, kk * 32, lane), u, 0, 0, 0);
                  ua[xx][0] = pk2(u[0], u[1]); ua[xx][1] = pk2(u[2], u[3]); }
                { const int md = tl >> 2, ni = tl & 3;
                  f32x4 w = {0.f, 0.f, 0.f, 0.f};
#pragma unroll
                  for (int kk = 0; kk < 2; ++kk) w = __builtin_amdgcn_mfma_f32_16x16x32_bf16(ldfrag(lds + GL_KT + md * GTS, GP64, 0, kk * 32, lane), ldfrag(lds + gl_mat(d, 0), GP64, ni * 16, kk * 32, lane), w, 0, 0, 0);
                  wa[xx][0] = pk2(w[0], w[1]); wa[xx][1] = pk2(w[2], w[3]); }
            }
            const int odd = q4 & 1, p8 = q4 >> 1, tls = wave + 8 * (2 * xp + odd);
            { const auto r0 = __builtin_amdgcn_permlane16_swap(ua[0][0], ua[1][0], false, false), r1 = __builtin_amdgcn_permlane16_swap(ua[0][1], ua[1][1], false, false);
              const int mi = tls >> 3, nj = tls & 7;
              if (!nost) *JNK(v4u*, (v4u*)(UTg + (nj * 16 + l16) * 64 + mi * 16 + 8 * p8)) = (v4u){r0[0], r1[0], r0[1], r1[1]}; }
            { const auto r0 = __builtin_amdgcn_permlane16_swap(wa[0][0], wa[1][0], false, false), r1 = __builtin_amdgcn_permlane16_swap(wa[0][1], wa[1][1], false, false);
              const int md = tls >> 2, ni = tls & 3;
              if (!nost) *JNK(v4u*, (v4u*)(Wg + (ni * 16 + l16) * 128 + md * 16 + 8 * p8)) = (v4u){r0[0], r1[0], r0[1], r1[1]}; }
        }
    }
    WG_BAR();
}
__device__ __forceinline__ void gdn_prep_phase(const Ptrs& P, LAS unsigned char* lds, int vcu, int G, int tid, int wave, int lane, bool ride = true, int pmode = 0) {
    unsigned TCH[4] = {0u, 0u, 0u, 0u};
    for (int it = vcu * 8; it < 2048; it += G * 8) {
        const int bh = it >> 6;
        LAS float* CW = (LAS float*)(lds + GTAB_OFF); const int h = bh & 7;
        __syncthreads();
        for (int i = tid; i < 5 * 3 * 128; i += 512) { const int j = i / 384, rem = i % 384, which = rem >> 7, ch = rem & 127; CW[i] = P.conv_w[j * 3072 + which * 1024 + h * 128 + ch]; }
        WG_BAR();
        for (int k = 0; k < 8; ++k) gdn_prep_item(P, lds, bh, (it & 63) + k, (G == 256 && ride) ? k * 3 * 2048 + vcu * 8 + wave : -1, k < 7, TCH, tid, wave, lane, pmode);
    }
    asm volatile("s_waitcnt vmcnt(0)" : "+v"(TCH[0]), "+v"(TCH[1]), "+v"(TCH[2]), "+v"(TCH[3]) :: "memory");
}

template <int MODE>
__device__ __forceinline__ void store_probe(const Ptrs& P, int vcu, int wave, int lane) {
    unsigned char* junk = P.ws + ((size_t)504 << 20);
    const int q4 = lane >> 4, l16 = lane & 15;
    v4u val = {(unsigned)lane, 1u, 2u, 3u};
#pragma unroll 1
    for (int rep = 0; rep < 4; ++rep)
#pragma unroll 1
    for (int k = 0; k < 8; ++k) {
        const size_t ibase = (((size_t)((rep * 8 + k) * 256 + vcu)) * 65536) & (((size_t)64 << 20) - 1);
        asm volatile("" : "+v"(val));
        if (MODE == 1) {
#pragma unroll
            for (int j = 0; j < 8; ++j) { const int jj = (wave * 8 + j) >> 1; *(v4u*)(junk + ibase + (size_t)(jj * 16 + l16) * 128 + (j & 1) * 64 + q4 * 16) = val; }
        } else if (MODE == 2) {
#pragma unroll
            for (int j = 0; j < 8; ++j) *(v4u*)(junk + ibase + (size_t)((wave * 8 + j) * 8 + (lane >> 3)) * 128 + (lane & 7) * 16) = val;
        } else if (MODE == 3) {
#pragma unroll
            for (int j = 0; j < 16; ++j) { const int jj = (wave * 16 + j) >> 2; *(u32x2*)(junk + ibase + (size_t)(jj * 16 + l16) * 128 + (j & 3) * 32 + q4 * 8) = (u32x2){val.x, val.y}; }
        } else if (MODE == 5) {
#pragma unroll
            for (int j = 0; j < 8; ++j) { const int jj = (wave * 8 + j) >> 1; *(v4u*)(junk + ibase + (size_t)(jj * 16 + (lane >> 2)) * 128 + (j & 1) * 64 + (lane & 3) * 16) = val; }
        } else if (MODE == 6) {
#pragma unroll
            for (int j = 0; j < 8; ++j) *(v4u*)(junk + ((ibase * 64) & (((size_t)64 << 20) - 1)) + (size_t)l16 * 4096 + (size_t)(wave * 8 + j) * 64 + q4 * 16) = val;
        } else if (MODE == 7) {
#pragma unroll
            for (int j = 0; j < 8; ++j) *(v4u*)(junk + ((ibase * 64) & (((size_t)64 << 20) - 1)) + (size_t)(lane >> 2) * 4096 + (size_t)(wave * 8 + j) * 64 + (lane & 3) * 16) = val;
        } else if (MODE == 4) {
#pragma unroll
            for (int j = 0; j < 8; ++j) { const int row = (wave * 4 + (j >> 1)) * 32 + (lane & 31); *(v4u*)(junk + ((ibase * 4) & (((size_t)64 << 20) - 1)) + (size_t)row * 2048 / 8 * 8 + (lane >> 5) * 32 + (j & 1) * 16) = val; }
        }
    }
}
constexpr int SC_SLOT = 62464, SC_W = 0, SC_Q = 16384, SC_KT = 32768, SC_QK = 49152, SC_UT = 57344, SC_EG = 61440;
constexpr int SL_ST = GTAB_OFF, SL_VN = SL_ST + 32 * GP128, SL_VS = SL_VN + 32 * GP64;
constexpr int SL_OB = SL_VS + 32 * GP64;
static_assert(2 * SC_SLOT <= RING_BYTES && SL_OB + 4096 <= LDS_BYTES && SL_OB % 16 == 0, "scan LDS map");
#define SC_GLDS(src, dst) __builtin_amdgcn_global_load_lds((const unsigned*)(src), (LAS unsigned*)(dst), 16, 0, 0)
__device__ __forceinline__ void scan_issue(const Ptrs& P, LAS unsigned char* lds, int slot, int bh, int d, int sl, int n, int wave, int lane) {
    if (wave >= 7) return;
    const int item = bh * 64 + n, b = bh >> 3, h = bh & 7;
    const char* Wb = (const char*)(P.ws + WS_GW) + ((size_t)(d * 2048 + item) * 8192) * 2;
    const char* Qb = (const char*)(P.ws + WS_GQ) + (((size_t)b * SEQ + n * 64) * 1024 + h * 128) * 2;
    const char* KTb = (const char*)(P.ws + WS_GKT) + ((size_t)item * 8192) * 2;
    const char* QKb = (const char*)(P.ws + WS_GQK) + ((size_t)(d * 2048 + item) * 4096) * 2;
    const char* UTb = (const char*)(P.ws + WS_GUT) + ((size_t)(d * 2048 + item) * 8192 + (sl * 32) * 64) * 2;
    LAS unsigned char* sb = lds + slot * SC_SLOT;
    const int r4 = lane >> 4, s16 = lane & 15, r8 = lane >> 3, s8 = lane & 7;
#pragma unroll
    for (int i = 0; i < 9; ++i) {
        const int pc = wave + 7 * i;
        if (pc < 32) {
            const int pp = pc & 15, row = pp * 4 + r4, c = (s16 - row) & 15;
            if (pc < 16) SC_GLDS(Wb + row * 256 + c * 16, sb + SC_W + pp * 1024); else SC_GLDS(Qb + (size_t)row * 2048 + c * 16, sb + SC_Q + pp * 1024);
        } else if (pc < 60) {
            const int pp = pc < 48 ? pc - 32 : (pc < 56 ? pc - 48 : pc - 56), row = pp * 8 + r8, c = (s8 - (row >> 1)) & 7;
            const char* src = (pc < 48 ? KTb : (pc < 56 ? QKb : UTb)) + row * 128 + c * 16;
            SC_GLDS(src, sb + (pc < 48 ? SC_KT : (pc < 56 ? SC_QK : SC_UT)) + pp * 1024);
        } else if (pc == 60) { const char* EGb = (const char*)(P.ws + WS_GEG) + ((size_t)((lane & 16 ? 2 + d : d) * 2048 + item) * 64) * 4 + (lane & 15) * 16; SC_GLDS(EGb, sb + SC_EG); }
    }
}
__device__ __forceinline__ bf16x8 frag256(const LAS unsigned char* t, int row, int c) { return *(const LAS bf16x8*)(t + row * 256 + (((c + row) & 15) << 4)); }
__device__ __forceinline__ bf16x8 frag128(const LAS unsigned char* t, int row, int c) { return *(const LAS bf16x8*)(t + row * 128 + (((c + (row >> 1)) & 7) << 4)); }
template <int VAR> __device__ __forceinline__ void scan_step(f32x4 (&accS)[2], f32x4& opend, const Ptrs& P, LAS unsigned char* lds, int slot, int d, int wave, int lane) {
    const int mi = wave >> 1, nj = wave & 1, l16 = lane & 15, q4 = lane >> 4;
    const LAS unsigned char* sb = lds + slot * SC_SLOT;
    const f32x4 r_eg = *(const LAS f32x4*)(sb + SC_EG + (mi * 16 + 4 * q4) * 4), r_ek = *(const LAS f32x4*)(sb + SC_EG + 256 + (mi * 16 + 4 * q4) * 4); const float r_gl = *(const LAS float*)(sb + SC_EG + (d == 0 ? 63 : 0) * 4);
    f32x4 x = {0.f, 0.f, 0.f, 0.f}, oa = {0.f, 0.f, 0.f, 0.f};
#pragma unroll
    for (int kk = 0; kk < 4; ++kk) { const bf16x8 bs = ldfrag(lds + SL_ST, GP128, nj * 16, kk * 32, lane);
        x = __builtin_amdgcn_mfma_f32_16x16x32_bf16(frag256(sb + SC_W, mi * 16 + l16, kk * 4 + q4), bs, x, 0, 0, 0);
        oa = __builtin_amdgcn_mfma_f32_16x16x32_bf16(frag256(sb + SC_Q, mi * 16 + l16, kk * 4 + q4), bs, oa, 0, 0, 0); }
    const int ur = nj * 16 + l16;
    const u32x2 u = *(const LAS u32x2*)(sb + SC_UT + ur * 128 + (((mi * 2 + (q4 >> 1) + (ur >> 1)) & 7) << 4) + (q4 & 1) * 8);
    f32x4 vn; vn[0] = __uint_as_float(u.x << 16) - x[0]; vn[1] = __uint_as_float(u.x & 0xffff0000u) - x[1]; vn[2] = __uint_as_float(u.y << 16) - x[2]; vn[3] = __uint_as_float(u.y & 0xffff0000u) - x[3];
    const int vo = (nj * 16 + l16) * GP64 + (mi * 16 + 4 * q4) * 2;
    *(LAS u32x2*)(lds + SL_VN + vo) = (u32x2){pk2(vn[0], vn[1]), pk2(vn[2], vn[3])};
    *(LAS u32x2*)(lds + SL_VS + vo) = (u32x2){pk2(vn[0] * r_ek[0], vn[1] * r_ek[1]), pk2(vn[2] * r_ek[2], vn[3] * r_ek[3])};
    WG_BAR();
    f32x4 o = oa * r_eg;
#pragma unroll
    for (int kk = 0; kk < 2; ++kk) o = __builtin_amdgcn_mfma_f32_16x16x32_bf16(frag128(sb + SC_QK, mi * 16 + l16, kk * 4 + q4), ldfrag(lds + SL_VN, GP64, nj * 16, kk * 32, lane), o, 0, 0, 0);
#pragma unroll
    for (int rho = 0; rho < 4; ++rho) *(LAS bf16*)(lds + SL_OB + (mi * 16 + 4 * q4 + rho) * 64 + ((((nj * 16 + l16) >> 3) ^ q4) << 4) + (l16 & 7) * 2) = (bf16)f2bf(o[rho]);
    opend = o;
#pragma unroll
    for (int n2 = 0; n2 < 2; ++n2) {
        f32x4 s = accS[n2] * r_gl;
#pragma unroll
        for (int kk = 0; kk < 2; ++kk) s = __builtin_amdgcn_mfma_f32_16x16x32_bf16(frag128(sb + SC_KT, wave * 16 + l16, kk * 4 + q4), ldfrag(lds + SL_VS, GP64, n2 * 16, kk * 32, lane), s, 0, 0, 0);
        accS[n2] = s;
        *(LAS u32x2*)(lds + SL_ST + (n2 * 16 + l16) * GP128 + (wave * 16 + 4 * q4) * 2) = (u32x2){pk2(s[0], s[1]), pk2(s[2], s[3])};
    }
    if (wave < 7) asm volatile("s_waitcnt vmcnt(0)" ::: "memory");
    WG_BAR();
}
template <int VAR> __device__ __forceinline__ void scan_store(const f32x4& o, const Ptrs& P, LAS unsigned char* lds, int bh, int d, int sl, int n, int wave, int lane) {
    if constexpr (!(VAR & 2)) {
        if (wave == 7) {
            const int b = bh >> 3, h = bh & 7;
            bf16* Og = (bf16*)(P.ws + ((VAR & 4) ? WS_MERGED : (d == 0 ? WS_OF : WS_OB))) + ((size_t)b * SEQ + n * 64) * 1024 + h * 128 + sl * 32;
#pragma unroll
            for (int j = 0; j < 4; ++j) { const int row = 16 * j + (lane >> 2), c = lane & 3;
                const v4u dv = *(const LAS v4u*)(lds + SL_OB + row * 64 + ((c ^ ((row >> 2) & 3)) << 4));
                *(v4u*)(Og + (size_t)row * 1024 + c * 8) = dv; }
        }
    }
}
__device__ __forceinline__ const char* scan_touch(const Ptrs& P, int bh, int d, int sl, int n, int j, int lane) {
    const int item = bh * 64 + n, b = bh >> 3, h = bh & 7;
    int id = j * 64 + lane; id = id < 144 ? id : 143;
    const char* p;
    if (id < 112) { const int L = 4 * id + sl;
        if (L < 128) p = (const char*)(P.ws + WS_GW) + ((size_t)(d * 2048 + item) * 8192) * 2 + L * 128;
        else if (L < 256) p = (const char*)(P.ws + WS_GKT) + ((size_t)item * 8192) * 2 + (L - 128) * 128;
        else if (L < 320) p = (const char*)(P.ws + WS_GQK) + ((size_t)(d * 2048 + item) * 4096) * 2 + (L - 256) * 128;
        else { const int idx = L - 320; p = (const char*)(P.ws + WS_GQ) + (((size_t)b * SEQ + n * 64 + (idx >> 1)) * 1024 + h * 128) * 2 + (idx & 1) * 128; }
    } else p = (const char*)(P.ws + WS_GUT) + ((size_t)(d * 2048 + item) * 8192 + (sl * 32) * 64) * 2 + (id - 112) * 128;
    return p;
}
template <int VAR> __device__ __forceinline__ void gdn_scan_phase(const Ptrs& P, LAS unsigned char* lds, int vcu, int G, int tid, int wave, int lane) {
    for (int wk = vcu; wk < 256; wk += G) {
        const int sl = wk & 3, d = (wk >> 2) & 1, bh = wk >> 3;
        __syncthreads();
        for (int i = tid; i < 32 * GP128 / 4; i += 512) ((LAS unsigned*)(lds + SL_ST))[i] = 0u;
        f32x4 accS[2] = {{0.f, 0.f, 0.f, 0.f}, {0.f, 0.f, 0.f, 0.f}};
        f32x4 opend = {0.f, 0.f, 0.f, 0.f};
#define SCN(s) (d == 0 ? (s) : 63 - (s))
#define SCT(s) ((s) + 4 < 64 ? (s) + 4 : 63)
#define TOUCH_LD(T, n_) do { if (wave == 7) { _Pragma("unroll") for (int j_ = 0; j_ < 3; ++j_) { const char* tp_ = scan_touch(P, bh, d, sl, (n_), j_, lane); asm volatile("global_load_dword %0, %1, off" : "+v"(T[j_]) : "v"(tp_) : "memory"); } } } while (0)
        unsigned T0[3] = {0u, 0u, 0u}, T1[3] = {0u, 0u, 0u}, T2[3] = {0u, 0u, 0u}, T3[3] = {0u, 0u, 0u};
        TOUCH_LD(T0, SCN(1)); TOUCH_LD(T1, SCN(2)); TOUCH_LD(T2, SCN(3));
        scan_issue(P, lds, 0, bh, d, sl, SCN(0), wave, lane);
        asm volatile("s_waitcnt vmcnt(0)" ::: "memory"); WG_BAR();
#define SC_STEP(s, T) do { if ((s) > 0) scan_store<VAR>(opend, P, lds, bh, d, sl, SCN((s) - 1), wave, lane); \
            if (!(VAR & 1)) scan_issue(P, lds, ((s) + 1) & 1, bh, d, sl, SCN((s) + 1 < 64 ? (s) + 1 : 63), wave, lane); \
            asm volatile("" ::: "memory"); TOUCH_LD(T, SCN(SCT(s))); \
            scan_step<VAR>(accS, opend, P, lds, (s) & 1, d, wave, lane); } while (0)
#pragma unroll 1
        for (int st = 0; st < 64; st += 4) { SC_STEP(st, T3); SC_STEP(st + 1, T0); SC_STEP(st + 2, T1); SC_STEP(st + 3, T2); }
        scan_store<VAR>(opend, P, lds, bh, d, sl, SCN(63), wave, lane);
        asm volatile("s_waitcnt vmcnt(0)" : "+v"(T0[0]), "+v"(T0[1]), "+v"(T0[2]), "+v"(T1[0]), "+v"(T1[1]), "+v"(T1[2]), "+v"(T2[0]), "+v"(T2[1]), "+v"(T2[2]), "+v"(T3[0]), "+v"(T3[1]), "+v"(T3[2]) :: "memory"); asm volatile("" :: "v"(accS[0]), "v"(accS[1]));
#undef SC_STEP
#undef TOUCH_LD
#undef SCT
#undef SCN
    }
}
__device__ __forceinline__ void gdn_out_phase(const Ptrs& P, int G, int wave, int lane) {
    const bf16* OF = (const bf16*)(P.ws + WS_OF); const bf16* OB = (const bf16*)(P.ws + WS_OB); const bf16* proj = (const bf16*)(P.ws + WS_PROJ); bf16* YAB = (bf16*)(P.ws + WS_YAB);
    float nw[16];
#pragma unroll
    for (int c = 0; c < 16; ++c) nw[c] = P.gdn_nw[(lane & 7) * 16 + c];
    for (int m = blockIdx.x * NWAVES + wave; m < M; m += G * NWAVES) {
        const v4u a0 = *(const v4u*)(OF + (size_t)m * 1024 + lane * 16), a1 = *(const v4u*)(OF + (size_t)m * 1024 + lane * 16 + 8);
        const v4u b0 = *(const v4u*)(OB + (size_t)m * 1024 + lane * 16), b1 = *(const v4u*)(OB + (size_t)m * 1024 + lane * 16 + 8);
        const v4u z0 = *(const v4u*)(proj + (size_t)m * NINP + P_ZB + lane * 16), z1 = *(const v4u*)(proj + (size_t)m * NINP + P_ZB + lane * 16 + 8);
        float v[16], z[16];
#define UNP(dst, s0, s1, op, t0, t1) dst[0] op (__uint_as_float(s0.x << 16) + __uint_as_float(t0.x << 16)); dst[1] op (__uint_as_float(s0.x & 0xffff0000u) + __uint_as_float(t0.x & 0xffff0000u)); \
        dst[2] op (__uint_as_float(s0.y << 16) + __uint_as_float(t0.y << 16)); dst[3] op (__uint_as_float(s0.y & 0xffff0000u) + __uint_as_float(t0.y & 0xffff0000u)); \
        dst[4] op (__uint_as_float(s0.z << 16) + __uint_as_float(t0.z << 16)); dst[5] op (__uint_as_float(s0.z & 0xffff0000u) + __uint_as_float(t0.z & 0xffff0000u)); \
        dst[6] op (__uint_as_float(s0.w << 16) + __uint_as_float(t0.w << 16)); dst[7] op (__uint_as_float(s0.w & 0xffff0000u) + __uint_as_float(t0.w & 0xffff0000u)); \
        dst[8] op (__uint_as_float(s1.x << 16) + __uint_as_float(t1.x << 16)); dst[9] op (__uint_as_float(s1.x & 0xffff0000u) + __uint_as_float(t1.x & 0xffff0000u)); \
        dst[10] op (__uint_as_float(s1.y << 16) + __uint_as_float(t1.y << 16)); dst[11] op (__uint_as_float(s1.y & 0xffff0000u) + __uint_as_float(t1.y & 0xffff0000u)); \
        dst[12] op (__uint_as_float(s1.z << 16) + __uint_as_float(t1.z << 16)); dst[13] op (__uint_as_float(s1.z & 0xffff0000u) + __uint_as_float(t1.z & 0xffff0000u)); \
        dst[14] op (__uint_as_float(s1.w << 16) + __uint_as_float(t1.w << 16)); dst[15] op (__uint_as_float(s1.w & 0xffff0000u) + __uint_as_float(t1.w & 0xffff0000u));
        const v4u zz = {0u, 0u, 0u, 0u};
        UNP(v, a0, a1, =, b0, b1)
        UNP(z, z0, z1, =, zz, zz)
#undef UNP
        float ss = 0.f;
#pragma unroll
        for (int c = 0; c < 16; ++c) ss += v[c] * v[c];
        ss += __shfl_xor(ss, 1); ss += __shfl_xor(ss, 2); ss += __shfl_xor(ss, 4);
        const float r = rsqrtf(ss * (1.f / 128.f) + EPS);
        float o[16];
#pragma unroll
        for (int c = 0; c < 16; ++c) o[c] = v[c] * r * nw[c] * z[c] * __builtin_amdgcn_rcpf(1.f + __expf(-z[c]));
        v4u o0, o1;
        o0.x = pk2(o[0], o[1]); o0.y = pk2(o[2], o[3]); o0.z = pk2(o[4], o[5]); o0.w = pk2(o[6], o[7]); o1.x = pk2(o[8], o[9]); o1.y = pk2(o[10], o[11]); o1.z = pk2(o[12], o[13]); o1.w = pk2(o[14], o[15]);
        *(v4u*)(YAB + (size_t)m * KAB + 512 + lane * 16) = o0; *(v4u*)(YAB + (size_t)m * KAB + 512 + lane * 16 + 8) = o1;
    }
}
__global__ void __launch_bounds__(NWAVES * 64, 2) mega_fwd(Args args) {
    extern __shared__ __attribute__((aligned(16))) unsigned char lds_raw[];
    LAS unsigned char* lds = (LAS unsigned char*)lds_raw;
    const Ptrs& P = args.p;
    const int tid = threadIdx.x, lane = tid & 63, wave = __builtin_amdgcn_readfirstlane(tid >> 6);
    const int G = gridDim.x; const int bx = blockIdx.x; const int vcu = (G % 8 == 0) ? (bx % 8) * (G / 8) + bx / 8 : bx;
    gu32* ctl = (gu32*)(P.ws + WS_CTL);
    for (int u = tid; u < (GTAB_OFF - LDSCTL_OFF) / 4; u += NWAVES * 64) ((LAS unsigned*)(lds + LDSCTL_OFF))[u] = 0u;
    __syncthreads();
    XcdBarrier bar = xcd_barrier_post((unsigned*)(ctl + CW_BAR) + args.li * XCD_BAR_WORDS, (volatile LAS unsigned*)(lds + MISC_OFF) + 8);
    const int lo = args.ph_lo, hi = args.ph_hi;
#ifndef PH_MASK
#define PH_MASK 0xffff
#endif
#define IN(k) (((PH_MASK >> (k)) & 1) && lo <= (k) && (k) < hi)
#define BOTH(k) (IN(k) && IN((k) + 1))
#ifndef PH_TWICE
#define PH_TWICE 0
#endif
#define REP(k) for (int rep_ = 0; rep_ < (((PH_TWICE >> (k)) & 1) ? 2 : 1); ++rep_)
#ifndef PH_AGAIN
#define PH_AGAIN 0
#endif
#define AGAIN(k) if ((PH_AGAIN >> (k)) & 1)
    LAS unsigned* gtab = (LAS unsigned*)(lds + GTAB_OFF);
    LAS int* etab = (LAS int*)(lds + ETAB_OFF);

    if (IN(0)) { REP(0) p0_prologue(P, lds, vcu, G, wave, lane); if (BOTH(0)) xcd_barrier(bar); }

    if (IN(1)) {
        pg8::DenseOrder S; S.so.init(M, NINP, G, bx); S.A = (const char*)(P.ws + WS_XN); S.Bt = (const char*)(P.ws + WS_WIN); S.tstep = (size_t)256 * 1024 * 2;
        pg8::EpiBf16<0> E{(pg8::bf16_t*)(P.ws + WS_PROJ), NINP, nullptr, 0, 0, 1.f, lds + EPISCR_OFF};
        pg8::gemm_phase<pg8::EpiBf16<0>, pg8::DenseOrder, true, true>(lds + RING_OFF, 1024, S, E, gtab);
        AGAIN(1) pg8::gemm_phase<pg8::EpiBf16<0>, pg8::DenseOrder, true, true>(lds + RING_OFF, 1024, S, E, gtab);
        if (BOTH(1)) xcd_barrier(bar);
    }
    if (IN(2)) {
        const int pre_ = (vcu & 1) ? STAG_PRE : 1 << 30;
#pragma unroll 1
        for (int part_ = 0; part_ < 2; ++part_) {
            attn_phase(P, lds, vcu, G, wave, lane, part_ == 0 ? 0 : pre_, part_ == 0 ? pre_ : 1 << 30);
            if (part_ == 0) gdn_prep_phase(P, lds, vcu, G, tid, wave, lane, !RIDE_OFF);
        }
#if STORE_PROBE
        store_probe<STORE_PROBE>(P, vcu, wave, lane);
#endif
        AGAIN(12) gdn_prep_phase(P, lds, vcu, G, tid, wave, lane, !((PH_AGAIN >> 13) & 1), PMODE); if (BOTH(2)) xcd_barrier(bar); }
    #ifndef SCAN_PROBE
#define SCAN_PROBE 0
#endif
    if (IN(3)) { gdn_scan_phase<0>(P, lds, vcu, G, tid, wave, lane); AGAIN(3) gdn_scan_phase<0>(P, lds, vcu, G, tid, wave, lane); if (SCAN_PROBE) gdn_scan_phase<SCAN_PROBE>(P, lds, vcu, G, tid, wave, lane); if (BOTH(3)) xcd_barrier(bar); }
    if (IN(4)) { REP(4) { merge_attn(P, G, wave, lane); gdn_out_phase(P, G, wave, lane); } if (BOTH(4)) xcd_barrier(bar); }

    if (IN(5)) {
        pg8::DenseOrder S; S.so.init(M, 1024, G, bx); S.A = (const char*)(P.ws + WS_YAB); S.Bt = (const char*)(P.ws + WS_WAB); S.tstep = (size_t)256 * KAB * 2;
        pg8::EpiMerged E{(const pg8::bf16_t*)(P.ws + WS_PROJ), (pg8::bf16_t*)(P.ws + WS_MERGED), NINP, P_GA, P_GB, lds + EPISCR_OFF};
        pg8::gemm_phase<pg8::EpiMerged, pg8::DenseOrder, true, true>(lds + RING_OFF, KAB, S, E, gtab);
        AGAIN(5) pg8::gemm_phase<pg8::EpiMerged, pg8::DenseOrder, true, true>(lds + RING_OFF, KAB, S, E, gtab);
        if (BOTH(5)) xcd_barrier(bar);
    }
    if (IN(6)) {
        pg8::DenseOrder S; S.so.init(M, 1024, G, bx); S.A = (const char*)(P.ws + WS_MERGED); S.Bt = (const char*)(P.ws + WS_WOUT); S.tstep = (size_t)256 * 1024 * 2;
        pg8::EpiResid E{P.x, P.out};
        pg8::gemm_phase<pg8::EpiResid, pg8::DenseOrder, true, true>(lds + RING_OFF, 1024, S, E, gtab);
        AGAIN(6) pg8::gemm_phase<pg8::EpiResid, pg8::DenseOrder, true, true>(lds + RING_OFF, 1024, S, E, gtab);
        if (BOTH(6)) xcd_barrier(bar);
    }
    if (IN(7)) { p7_router<0>(P, lds, G, tid, wave, lane); AGAIN(7) { __syncthreads(); p7_router<1>(P, lds, G, tid, wave, lane); } if (BOTH(7)) xcd_barrier(bar); }
    if (IN(8)) {
        build_etab((const unsigned*)(ctl + CW_CNT), etab, tid);
        pg8::MoeOrder<8, true> S; S.etab = etab; S.G = G; S.c = bx; S.K = 1024; S.A = (const char*)(P.ws + WS_XN); S.W = (const char*)(P.ws + WS_WGU); S.wstride = (size_t)2048 * 1024 * 2; S.list = (const int*)(P.ws + WS_LIST);
        pg8::EpiSwiglu E{(pg8::bf16_t*)(P.ws + WS_ACT), P.b_gu, lds + EPISCR_OFF};
        REP(8) pg8::gemm_phase<pg8::EpiSwiglu, pg8::MoeOrder<8, true>, true, true>(lds + RING_OFF, 1024, S, E, gtab);
        if (BOTH(8)) xcd_barrier(bar);
    }
    if (IN(9)) {
        build_etab((const unsigned*)(ctl + CW_CNT), etab, tid);
        pg8::MoeOrder<4, false> S; S.etab = etab; S.G = G; S.c = bx; S.K = 1024; S.A = (const char*)(P.ws + WS_ACT); S.W = (const char*)(P.ws + WS_WD); S.wstride = (size_t)1024 * 1024 * 2; S.list = (const int*)(P.ws + WS_LIST);
        pg8::EpiDown E{(pg8::bf16_t*)(P.ws + WS_YEXP), P.b_d, (const float*)(P.ws + WS_GATEL), lds + EPISCR_OFF};
        REP(9) pg8::gemm_phase<pg8::EpiDown, pg8::MoeOrder<4, false>, true, true>(lds + RING_OFF, 1024, S, E, gtab);
        if (BOTH(9)) xcd_barrier(bar);
    }
    if (IN(10)) { p10_final<0>(P, lds, G, tid, wave, lane); AGAIN(10) { __syncthreads(); p10_final<1>(P, lds, G, tid, wave, lane); } }
#undef IN
#undef BOTH
}

extern "C" void kernel_launch(void* const* d_in, const int* in_sizes, int n_in, void* d_out, int out_size, void* d_ws, size_t ws_size, hipStream_t stream) {
    static int grid = 0;
    if (grid == 0) {
        if (n_in != 20 || out_size != M * DM || ws_size < WS_END) { fprintf(stderr, "kernel_launch: unexpected shapes (n_in %d out %d ws %zu)\n", n_in, out_size, ws_size); grid = -1; return; }
        int dev = 0, cus = 0;
        if (hipGetDevice(&dev) != hipSuccess || hipDeviceGetAttribute(&cus, hipDeviceAttributeMultiprocessorCount, dev) != hipSuccess) { grid = -1; return; }
        if (hipFuncSetAttribute((const void*)mega_fwd, hipFuncAttributeMaxDynamicSharedMemorySize, LDS_BYTES) != hipSuccess) { fprintf(stderr, "kernel_launch: hipFuncSetAttribute failed\n"); grid = -1; return; }
        (void)hipGetLastError();
        grid = cus;
    }
    if (grid < 0) return;
    (void)hipMemsetAsync((char*)d_ws + WS_CTL, 0, CTL_ZERO_BYTES, stream);
    Args a{};
    const float** pp = (const float**)&a.p;
    for (int i = 0; i < 20; ++i) pp[i] = (const float*)d_in[i];
    a.p.out = (float*)d_out; a.p.ws = (unsigned char*)d_ws;
    a.ph_lo = 0; a.ph_hi = 11; a.li = 0;
    hipLaunchKernelGGL(mega_fwd, dim3(grid), dim3(NWAVES * 64), LDS_BYTES, stream, a);
}
```

```cpp
#include <hip/hip_runtime.h>
#include <cstdint>
#include <cstdio>

constexpr int BATCH = 4, SEQ = 4096, DM = 1024, M = BATCH * SEQ;
constexpr int NIN = 7712;
constexpr int NINP = 7936;
constexpr int P_QA = 0, P_KA = 512, P_VA = 1024, P_QB = 1536, P_ZB = 4608, P_GA = 5632, P_GB = 6656, P_AF = 7680, P_AB = 7688, P_BF = 7696, P_BB = 7704;
constexpr int NE = 32, DFF = 1024;
constexpr float EPS = 1e-6f;
constexpr int KAB = 1536;
constexpr float F8_SW = 512.f, F8_SA = 32.f, F8_SC = 8.f, F8_SY = 32.f;
#ifndef P1_FP8
#define P1_FP8 1
#endif
constexpr int MAXBLK = 288;

#define PREP_PROBE 0
#define RIDE_OFF 0
#define MOE_ROT 1
#define MOE_SC1 1
#define MOE_HANDOFF 1
#define ATT_DUAL 0
#define SCAN_RIDE 0
#define ATT_RIDE 1
#define PMODE 0
#define STAG_PRE 3
#define STORE_PROBE 0
#define BAR_PROBE 0
#define XB_NOSLEEP 0
#if XB_NOSLEEP
#define XB_SLEEP 0
#endif
#define SCAN_HALF 0
#define SCAN_STAG 0
#define ATT_PROBE 0
#ifndef P1_DLY0
#define P1_DLY0 8
#define P1_DLY1 8
#endif
#ifndef P8_FP8
#define P8_FP8 2
#endif
#ifndef P9_FP8
#define P9_FP8 2
#endif
namespace pg8 {
#define PG8_LAS __attribute__((address_space(3)))
typedef unsigned short bf16_t;
typedef short bf16x8 __attribute__((ext_vector_type(8)));
typedef float f32x4 __attribute__((ext_vector_type(4)));
typedef unsigned u32x4 __attribute__((ext_vector_type(4)));
constexpr int BM = 256, BK = 64, HALF = 128, HTB = HALF * BK * 2  , STAGE_BYTES = 8 * HTB, NXCD = 8, WGM = 8;

__host__ __device__ __forceinline__ int lds_byte(int r, int c) { const int st = (r >> 4) * 2 + (c >> 5), rr = r & 15, cc = c & 31, ob = rr * 64 + cc * 2; return st * 1024 + (ob ^ (((ob >> 9) & 1) << 5)); }
__host__ __device__ __forceinline__ void stage_rc(int b, int& R, int& C) { const int st = b / 1024, sb = b % 1024, swz = sb ^ (((sb >> 9) & 1) << 5); R = (st >> 1) * 16 + swz / 64; C = (st & 1) * 32 + (swz % 64) / 2; }
__host__ __device__ __forceinline__ int perm32(int rho) { const int n = rho >> 4, i = rho & 15; return 8 * (i >> 2) + 4 * n + (i & 3); }

struct Unit { int pm, pn; };
struct Gemm { const bf16_t* A; const bf16_t* Bt; int M, N, K; };

struct StaticOrder {
    int nM, nN, nwg, G, c;
    __host__ __device__ void init(int M, int N, int G_, int c_) { nM = M / BM; nN = N / BM; nwg = nM * nN; G = G_; c = c_; }
    __host__ __device__ bool next(int i, Unit& u) const {
        const long L = (long)i * G + c; if (L >= nwg) return false;
        int wgid = (int)L; { const int q = nwg / NXCD, r = nwg % NXCD, xcd = wgid % NXCD, off = wgid / NXCD; wgid = (xcd < r ? xcd * (q + 1) : r * (q + 1) + (xcd - r) * q) + off; }
        const int nig = WGM * nN, gid = wgid / nig, fm = gid * WGM, gsz = (nM - fm) < WGM ? (nM - fm) : WGM;
        u.pm = fm + ((wgid % nig) % gsz); u.pn = (wgid % nig) / gsz; return true;
    }
    __device__ __forceinline__ void a_ready(const Unit&) const {}
    __device__ __forceinline__ void done(const Unit&) const {}
};

__device__ __forceinline__ unsigned cvt_pk_bf16(float lo, float hi) { unsigned r; asm volatile("v_cvt_pk_bf16_f32 %0, %1, %2" : "=v"(r) : "v"(lo), "v"(hi)); return r; }
typedef float f32x2 __attribute__((ext_vector_type(2)));
__device__ __forceinline__ unsigned pk4_fp8(float a, float b, float c, float d) {
    a = __builtin_amdgcn_fmed3f(a, -448.f, 448.f); b = __builtin_amdgcn_fmed3f(b, -448.f, 448.f); c = __builtin_amdgcn_fmed3f(c, -448.f, 448.f); d = __builtin_amdgcn_fmed3f(d, -448.f, 448.f);
    int p = __builtin_amdgcn_cvt_pk_fp8_f32(a, b, 0, false); p = __builtin_amdgcn_cvt_pk_fp8_f32(c, d, p, true); return (unsigned)p;
}
__device__ __forceinline__ f32x2 gelu_pk(f32x2 v) {
    const f32x2 av = __builtin_elementwise_abs(v), d = av * 0.2316418882f + 1.0f;
    f32x2 t; t.x = __builtin_amdgcn_rcpf(d.x); t.y = __builtin_amdgcn_rcpf(d.y);
    f32x2 q = t * 0.5307027145f + (-0.7265760135f); q = q * t + 0.7107068705f; q = q * t + (-0.142248368f); q = q * t + 0.127414796f; q = q * t;
    const f32x2 s = (v * v) * (-0.72134752044f);
    f32x2 e; e.x = __builtin_amdgcn_exp2f(s.x); e.y = __builtin_amdgcn_exp2f(s.y);
    const f32x2 m = v * (q * e), r = v - m;
    f32x2 o; o.x = v.x < 0.f ? m.x : r.x; o.y = v.y < 0.f ? m.y : r.y; return o;
}

template <int ACT  > struct EpiBf16 {
    static constexpr bool PERM = true, AFTER_DRAIN = false, HAS_MID = false; static_assert(ACT == 0 || ACT == 1, "EpiBf16: ACT is 0 (none) or 1 (gelu_pk)");
    bf16_t* O; int ldc; const float* bias; int split_cols; size_t split_stride; float scale0; PG8_LAS unsigned char* scr; float inv = 1.f;
    __device__ __forceinline__ void operator()(const f32x4 (&acc)[2][2][4][2], const Unit& u, int wr, int wc, int fr, int fq) const {
        const int row0 = u.pm * BM + wr * 64 + fr; int colt = u.pn * BM; bf16_t* base = O;
        float sc = 1.f; if (split_cols) { const int t = colt / split_cols; base += (size_t)t * split_stride; colt -= t * split_cols; if (t == 0) sc = scale0; }
        const int bcol0 = u.pn * BM + wc * 32 + 8 * fq;
        PG8_LAS unsigned char* sp = scr + (wr * 4 + wc) * 1280; const int ln = fq * 16 + fr, r2 = ln >> 2, c2 = ln & 3;
        PG8_LAS unsigned char* spw = sp + fr * 80 + fq * 16; const PG8_LAS unsigned char* spr = sp + r2 * 80 + c2 * 16;
        const int row0p = u.pm * BM + wr * 64 + r2, col0 = colt + wc * 32 + 8 * c2;
        f32x4 bv[2][2];
#pragma unroll
        for (int bj = 0; bj < 2; ++bj)
#pragma unroll
            for (int n = 0; n < 2; ++n) bv[bj][n] = bias ? *(const f32x4*)(bias + bcol0 + bj * HALF + 4 * n) : (f32x4){0.f, 0.f, 0.f, 0.f};
        u32x4 w[2][4][2];
#pragma unroll
        for (int ai = 0; ai < 2; ++ai)
#pragma unroll
            for (int m = 0; m < 4; ++m)
#pragma unroll
                for (int bj = 0; bj < 2; ++bj) { f32x4 v0 = acc[ai][bj][m][0], v1 = acc[ai][bj][m][1];
                    if (bias) { v0 = v0 + bv[bj][0]; v1 = v1 + bv[bj][1]; }
                    if (ACT == 1) { f32x2 a = gelu_pk((f32x2){v0[0], v0[1]}), b = gelu_pk((f32x2){v0[2], v0[3]}), c = gelu_pk((f32x2){v1[0], v1[1]}), d = gelu_pk((f32x2){v1[2], v1[3]});
                        v0 = (f32x4){a.x, a.y, b.x, b.y}; v1 = (f32x4){c.x, c.y, d.x, d.y}; }
                    if (split_cols || inv != 1.0f) { v0 = v0 * (sc * inv); v1 = v1 * (sc * inv); }
                    w[ai][m][bj].x = cvt_pk_bf16(v0[0], v0[1]); w[ai][m][bj].y = cvt_pk_bf16(v0[2], v0[3]); w[ai][m][bj].z = cvt_pk_bf16(v1[0], v1[1]); w[ai][m][bj].w = cvt_pk_bf16(v1[2], v1[3]); }
#pragma unroll
        for (int ai = 0; ai < 2; ++ai)
#pragma unroll
            for (int m = 0; m < 4; ++m)
#pragma unroll
                for (int bj = 0; bj < 2; ++bj) { *(PG8_LAS u32x4*)spw = w[ai][m][bj]; asm volatile("" ::: "memory"); w[ai][m][bj] = *(const PG8_LAS u32x4*)spr; asm volatile("" ::: "memory"); }
#pragma unroll
        for (int ai = 0; ai < 2; ++ai)
#pragma unroll
            for (int m = 0; m < 4; ++m) { bf16_t* rowp = base + (size_t)(row0p + ai * HALF + m * 16) * ldc + col0;
#pragma unroll
                for (int bj = 0; bj < 2; ++bj) *(u32x4*)(rowp + bj * HALF) = w[ai][m][bj]; }
    }
};
__device__ __forceinline__ float bflo(unsigned w) { return __uint_as_float(w << 16); }
__device__ __forceinline__ float bfhi(unsigned w) { return __uint_as_float(w & 0xffff0000u); }
__device__ __forceinline__ float sigm(float x) { return __builtin_amdgcn_rcpf(1.0f + __expf(-fmaxf(x, -30.0f))); }

struct DenseOrder {
    typedef Unit UnitT; static constexpr bool GATHER = false; static constexpr int A_AUX = 0;
    StaticOrder so; const char* A; const char* Bt; size_t tstep;
    __device__ __forceinline__ bool next(int i, Unit& u) const { return so.next(i, u); }
    __device__ __forceinline__ const char* ptrA(const Unit& u) const { return A + (size_t)u.pm * tstep; }
    __device__ __forceinline__ const char* ptrB(const Unit& u) const { return Bt + (size_t)u.pn * tstep; }
    __device__ __forceinline__ unsigned rowoff(const Unit&, int) const { return 0u; }
    __device__ __forceinline__ void a_ready(const Unit&) const {}
    __device__ __forceinline__ void done(const Unit&) const {}
};
struct DenseOrderG {
    typedef Unit UnitT; static constexpr bool GATHER = true; static constexpr int A_AUX = 0;
    StaticOrder so; const char* A; const char* Bt; size_t tstep; int K;
    __device__ __forceinline__ bool next(int i, Unit& u) const { return so.next(i, u); }
    __device__ __forceinline__ const char* ptrA(const Unit&) const { return A; }
    __device__ __forceinline__ const char* ptrB(const Unit& u) const { return Bt + (size_t)u.pn * tstep; }
    __device__ __forceinline__ unsigned rowoff(const Unit& u, int r) const { return (unsigned)(u.pm * 256 + r) * (unsigned)K * 2u; }
    __device__ __forceinline__ void a_ready(const Unit&) const {}
    __device__ __forceinline__ void done(const Unit&) const {}
};
struct MUnit { int pm, pn, e, j, rows, slot0, ui; };
template <int NT, bool GATHER_, bool LIN = false> struct MoeOrder {
    typedef MUnit UnitT; static constexpr bool GATHER = GATHER_; static constexpr int A_AUX = (LIN && MOE_HANDOFF) ? 16 : 0;
    const PG8_LAS int* etab; int G, c, K; const char* A; const char* W; size_t wstride; const int* list;
    __device__ __forceinline__ bool next(int i, MUnit& u) const {
        const int L = i * G + c; if (L >= __builtin_amdgcn_readfirstlane(etab[32]) * NT) return false;
        const int blk = L / NT; int e = 0;
#pragma unroll
        for (int q = 1; q < 32; ++q) e += (etab[q] <= blk) ? 1 : 0;
        e = __builtin_amdgcn_readfirstlane(e);
        u.e = e; u.j = __builtin_amdgcn_readfirstlane(blk - etab[e]); u.pm = blk; u.pn = L % NT; const int left = __builtin_amdgcn_readfirstlane(etab[40 + e]) - 256 * u.j; u.rows = left < 256 ? left : 256; u.slot0 = blk * 256; u.ui = i; return true;
    }
    __device__ __forceinline__ const char* ptrA(const MUnit& u) const { return GATHER_ ? A : A + (size_t)u.slot0 * K * 2; }
    __device__ __forceinline__ const char* ptrB(const MUnit& u) const { return W + (size_t)u.e * wstride + (size_t)u.pn * 256 * K * 2; }
    __device__ __forceinline__ unsigned rowoff(const MUnit& u, int r) const { if constexpr (LIN) return (unsigned)(u.slot0 + r) * (unsigned)K * 2u; const int pos = u.j * 256 + r; const int tok = list[(size_t)u.e * 16384 + (pos < etab[40 + u.e] ? pos : 0)]; return (unsigned)tok * (unsigned)K * 2u; }
    unsigned* rdy = nullptr; mutable int pend = -1;
    static __device__ __forceinline__ void wait_ready(const unsigned* p) { unsigned sp = 0;
        while (__hip_atomic_load(p, __ATOMIC_RELAXED, __HIP_MEMORY_SCOPE_AGENT) < 64u) { __builtin_amdgcn_s_sleep(4); if (++sp > (1u << 22)) break; } }
    __device__ __forceinline__ void a_ready(const MUnit& u) const {
        if constexpr (LIN) { if (MOE_HANDOFF && rdy && u.ui >= 3) { wait_ready(rdy + u.pm * 16); asm volatile("" ::: "memory"); } } }
    __device__ __forceinline__ void done(const MUnit& u) const {
        if constexpr (!LIN) { if (MOE_HANDOFF && rdy) { if (pend >= 0 && (threadIdx.x & 63) == 0) (void)__hip_atomic_fetch_add(rdy + pend * 16, 1u, __ATOMIC_RELAXED, __HIP_MEMORY_SCOPE_AGENT); pend = u.pm; } } }
    __device__ __forceinline__ void flush() const {
        if (MOE_HANDOFF && rdy) { asm volatile("s_waitcnt vmcnt(0)" ::: "memory"); if (pend >= 0 && (threadIdx.x & 63) == 0) (void)__hip_atomic_fetch_add(rdy + pend * 16, 1u, __ATOMIC_RELAXED, __HIP_MEMORY_SCOPE_AGENT); pend = -1; } }
};

struct EpiMerged {
    static constexpr bool PERM = true, AFTER_DRAIN = false, HAS_MID = true; static constexpr int TMID = 8;
    const bf16_t* proj; bf16_t* out; int ld, ga_off, gb_off; PG8_LAS unsigned char* scr;
    __device__ __forceinline__ void mid(f32x4 (&acc)[2][2][4][2], const Unit& u, int wr, int wc, int fr, int fq) const {
        int row0 = u.pm * BM + wr * 64 + fr, c0 = u.pn * BM + wc * 32 + 8 * fq;
        asm volatile("" : "+v"(row0), "+v"(c0));
#pragma unroll
        for (int ai = 0; ai < 2; ++ai)
#pragma unroll
            for (int mp = 0; mp < 2; ++mp) {
                u32x4 gav[2][2], gbv[2][2];
#pragma unroll
                for (int mm = 0; mm < 2; ++mm) { const bf16_t* rp = proj + (size_t)(row0 + ai * HALF + (2 * mp + mm) * 16) * ld + c0;
#pragma unroll
                    for (int bj = 0; bj < 2; ++bj) { gav[mm][bj] = *(const u32x4*)(rp + ga_off + bj * HALF); gbv[mm][bj] = *(const u32x4*)(rp + gb_off + bj * HALF); } }
#pragma unroll
                for (int mm = 0; mm < 2; ++mm) { const int m = 2 * mp + mm;
#pragma unroll
                    for (int bj = 0; bj < 2; ++bj) { const u32x4 ga = gav[mm][bj], gb = gbv[mm][bj];
#define EM_R(a, b) ((1.0f + __expf(-fmaxf((b), -30.0f))) * __builtin_amdgcn_rcpf(1.0f + __expf(-fmaxf((a), -30.0f))))
                        acc[ai][bj][m][0][0] *= EM_R(bflo(ga.x), bflo(gb.x)); acc[ai][bj][m][0][1] *= EM_R(bfhi(ga.x), bfhi(gb.x));
                        acc[ai][bj][m][0][2] *= EM_R(bflo(ga.y), bflo(gb.y)); acc[ai][bj][m][0][3] *= EM_R(bfhi(ga.y), bfhi(gb.y));
                        acc[ai][bj][m][1][0] *= EM_R(bflo(ga.z), bflo(gb.z)); acc[ai][bj][m][1][1] *= EM_R(bfhi(ga.z), bfhi(gb.z));
                        acc[ai][bj][m][1][2] *= EM_R(bflo(ga.w), bflo(gb.w)); acc[ai][bj][m][1][3] *= EM_R(bfhi(ga.w), bfhi(gb.w));
#undef EM_R
                    }
                    asm volatile("" : "+v"(acc[ai][0][m][0]), "+v"(acc[ai][0][m][1]), "+v"(acc[ai][1][m][0]), "+v"(acc[ai][1][m][1])); }
                asm volatile("" ::: "memory"); }
    }
    __device__ __forceinline__ void operator()(const f32x4 (&acc)[2][2][4][2], const Unit& u, int wr, int wc, int fr, int fq) const {
        const int row0 = u.pm * BM + wr * 64 + fr, c0 = u.pn * BM + wc * 32 + 8 * fq;
        PG8_LAS unsigned char* sp = scr + (wr * 4 + wc) * 1280; const int ln = fq * 16 + fr, r2 = ln >> 2, c2 = ln & 3;
        PG8_LAS unsigned char* spw = sp + fr * 80 + fq * 16; const PG8_LAS unsigned char* spr = sp + r2 * 80 + c2 * 16;
        const int row0p = u.pm * BM + wr * 64 + r2, c0p = u.pn * BM + wc * 32 + 8 * c2;
#pragma unroll
        for (int ai = 0; ai < 2; ++ai) {
            u32x4 gbv[4][2];
#pragma unroll
            for (int m = 0; m < 4; ++m)
#pragma unroll
                for (int bj = 0; bj < 2; ++bj) gbv[m][bj] = *(const u32x4*)(proj + (size_t)(row0 + ai * HALF + m * 16) * ld + gb_off + c0 + bj * HALF);
#pragma unroll
            for (int m = 0; m < 4; ++m) { const size_t row = (size_t)(row0 + ai * HALF + m * 16);
#pragma unroll
                for (int bj = 0; bj < 2; ++bj) { const u32x4 gb = gbv[m][bj];
                    const f32x4 v0 = acc[ai][bj][m][0], v1 = acc[ai][bj][m][1]; u32x4 w;
                    w.x = cvt_pk_bf16(v0[0] * sigm(bflo(gb.x)), v0[1] * sigm(bfhi(gb.x))); w.y = cvt_pk_bf16(v0[2] * sigm(bflo(gb.y)), v0[3] * sigm(bfhi(gb.y)));
                    w.z = cvt_pk_bf16(v1[0] * sigm(bflo(gb.z)), v1[1] * sigm(bfhi(gb.z))); w.w = cvt_pk_bf16(v1[2] * sigm(bflo(gb.w)), v1[3] * sigm(bfhi(gb.w)));
                    *(PG8_LAS u32x4*)spw = w; asm volatile("" ::: "memory"); const u32x4 w2 = *(const PG8_LAS u32x4*)spr; asm volatile("" ::: "memory");
                    *(u32x4*)(out + (size_t)(row0p + ai * HALF + m * 16) * 1024 + c0p + bj * HALF) = w2; } }
            asm volatile("" ::: "memory"); }
    }
};
struct EpiResid {
    static constexpr bool PERM = false, AFTER_DRAIN = false, HAS_MID = false;
    const float* base; float* out; PG8_LAS unsigned char* scr;
    __device__ __forceinline__ void operator()(const f32x4 (&acc)[2][2][4][2], const Unit& u, int wr, int wc, int fr, int fq) const {
        PG8_LAS unsigned char* sp = scr + (wr * 4 + wc) * 1280; const int ln = fq * 16 + fr, r2 = ln >> 2, c2 = ln & 3;
        PG8_LAS unsigned char* spw = sp + fr * 80 + fq * 16; const PG8_LAS unsigned char* spr = sp + r2 * 80 + c2 * 16;
        const int row0 = u.pm * BM + wr * 64 + r2, col0 = u.pn * BM + wc * 32 + 4 * c2;
#pragma unroll
        for (int ai = 0; ai < 2; ++ai)
#pragma unroll
            for (int m = 0; m < 4; ++m) { const size_t off = (size_t)(row0 + ai * HALF + m * 16) * 1024 + col0;
                f32x4 xb[2][2];
#pragma unroll
                for (int bj = 0; bj < 2; ++bj)
#pragma unroll
                    for (int n = 0; n < 2; ++n) xb[bj][n] = *(const f32x4*)(base + off + bj * HALF + n * 16);
#pragma unroll
                for (int bj = 0; bj < 2; ++bj)
#pragma unroll
                    for (int n = 0; n < 2; ++n) { *(PG8_LAS f32x4*)spw = acc[ai][bj][m][n]; asm volatile("" ::: "memory"); const f32x4 w2 = *(const PG8_LAS f32x4*)spr; asm volatile("" ::: "memory");
                        *(f32x4*)(out + off + bj * HALF + n * 16) = xb[bj][n] + w2; } }
    }
};
typedef unsigned u32x2_ __attribute__((ext_vector_type(2)));
constexpr float F8_SC_ = 8.f, F8_SY_ = 32.f;
struct EpiSwiglu {
    static constexpr bool PERM = true, AFTER_DRAIN = false, HAS_MID = false;
    unsigned char* act; const float* bgu; PG8_LAS unsigned char* scr; float inv; const PG8_LAS float* tab;
    __device__ __forceinline__ void operator()(const f32x4 (&acc)[2][2][4][2], const MUnit& u, int wr, int wc, int fr, int fq) const {
        const int r0 = wr * 64 + fr, j0 = u.pn * HALF + wc * 32 + 8 * fq;
        PG8_LAS unsigned char* sp = scr + (wr * 4 + wc) * 1280; const int ln = fq * 16 + fr, r2 = ln >> 2, c2 = ln & 3;
        PG8_LAS unsigned char* spw = sp + fr * 40 + fq * 8; const PG8_LAS unsigned char* spr = sp + r2 * 40 + c2 * 8;
        const int r0p = wr * 64 + r2, j0p = u.pn * HALF + wc * 32 + 8 * c2;
        const PG8_LAS float* bp = tab + u.ui * 256 + wc * 32 + 8 * fq;
        const f32x4 bg0 = *(const PG8_LAS f32x4*)(bp), bg1 = *(const PG8_LAS f32x4*)(bp + 4), bl0 = *(const PG8_LAS f32x4*)(bp + 128), bl1 = *(const PG8_LAS f32x4*)(bp + 132);
#pragma unroll
        for (int ai = 0; ai < 2; ++ai)
#pragma unroll
            for (int m = 0; m < 4; ++m) { const int r = r0p + ai * HALF + m * 16;
                if (ai * HALF + m * 16 + wr * 64 < u.rows) {
                    const f32x4 g0 = acc[ai][0][m][0] + bg0, g1 = acc[ai][0][m][1] + bg1, l0 = acc[ai][1][m][0] + bl0, l1 = acc[ai][1][m][1] + bl1;
                    float o[8];
#pragma unroll
                    for (int i = 0; i < 4; ++i) { const float g = fminf(g0[i], 7.0f), l = __builtin_amdgcn_fmed3f(l0[i], -7.0f, 7.0f);
                        o[i] = (g * __builtin_amdgcn_rcpf(1.0f + __builtin_amdgcn_exp2f(g * (-1.702f * 1.4426950408889634f)))) * __builtin_fmaf(l, F8_SC_, F8_SC_); }
#pragma unroll
                    for (int i = 0; i < 4; ++i) { const float g = fminf(g1[i], 7.0f), l = __builtin_amdgcn_fmed3f(l1[i], -7.0f, 7.0f);
                        o[4 + i] = (g * __builtin_amdgcn_rcpf(1.0f + __builtin_amdgcn_exp2f(g * (-1.702f * 1.4426950408889634f)))) * __builtin_fmaf(l, F8_SC_, F8_SC_); }
                    u32x2_ w; { int p0 = __builtin_amdgcn_cvt_pk_fp8_f32(o[0], o[1], 0, false); p0 = __builtin_amdgcn_cvt_pk_fp8_f32(o[2], o[3], p0, true);
                                int p1 = __builtin_amdgcn_cvt_pk_fp8_f32(o[4], o[5], 0, false); p1 = __builtin_amdgcn_cvt_pk_fp8_f32(o[6], o[7], p1, true); w.x = (unsigned)p0; w.y = (unsigned)p1; }
                    *(PG8_LAS u32x2_*)spw = w; asm volatile("" ::: "memory"); const u32x2_ w2 = *(const PG8_LAS u32x2_*)spr; asm volatile("" ::: "memory");
                    if (r < u.rows) { unsigned char* dp = act + (size_t)(u.slot0 + r) * 1024 + j0p;
                        if (MOE_SC1) asm volatile("global_store_dwordx2 %0, %1, off sc1" :: "v"(dp), "v"(w2) : "memory");
                        else *(u32x2_*)dp = w2; } } }
    }
};
struct EpiDown {
    static constexpr bool PERM = true, AFTER_DRAIN = false, HAS_MID = false;
    unsigned char* yexp; const float* bd; const float* gatel; PG8_LAS unsigned char* scr; float inv; const PG8_LAS float* tab;
    __device__ __forceinline__ void operator()(const f32x4 (&acc)[2][2][4][2], const MUnit& u, int wr, int wc, int fr, int fq) const {
        asm volatile("" : "+v"(fr), "+v"(fq));
        PG8_LAS unsigned char* sp = scr + (wr * 4 + wc) * 1280; const int ln = fq * 16 + fr, r2 = ln >> 2, c2 = ln & 3;
        PG8_LAS unsigned char* spw = sp + fr * 40 + fq * 8; const PG8_LAS unsigned char* spr = sp + r2 * 40 + c2 * 8;
        const int r0p = wr * 64 + r2, c0p = u.pn * BM + wc * 32 + 8 * c2;
        f32x4 bv[2][2];
#pragma unroll
        for (int bj = 0; bj < 2; ++bj)
#pragma unroll
            for (int n = 0; n < 2; ++n) bv[bj][n] = *(const PG8_LAS f32x4*)(tab + u.ui * 256 + wc * 32 + 8 * fq + bj * HALF + 4 * n);
#pragma unroll
        for (int ai = 0; ai < 2; ++ai)
#pragma unroll
            for (int m = 0; m < 4; ++m) { const int r = r0p + ai * HALF + m * 16;
                if (ai * HALF + m * 16 + wr * 64 < u.rows) {
#pragma unroll
                    for (int bj = 0; bj < 2; ++bj) { const f32x4 v0 = acc[ai][bj][m][0] + bv[bj][0], v1 = acc[ai][bj][m][1] + bv[bj][1];
                        u32x2_ w; w.x = pk4_fp8(v0[0], v0[1], v0[2], v0[3]); w.y = pk4_fp8(v1[0], v1[1], v1[2], v1[3]);
                        *(PG8_LAS u32x2_*)spw = w; asm volatile("" ::: "memory"); const u32x2_ w2 = *(const PG8_LAS u32x2_*)spr; asm volatile("" ::: "memory");
                        if (r < u.rows) *(u32x2_*)(yexp + (size_t)(u.slot0 + r) * 1024 + c0p + bj * HALF) = w2; } } }
    }
};

typedef int v8i_t __attribute__((ext_vector_type(8)));
typedef long v2l_t __attribute__((ext_vector_type(2)));
#ifndef FP8_MX
#define FP8_MX 0
#endif
template <class Epi, class Sched, bool ALIGN_EPI = false, bool SP2 = false, int FP8 = 0, int SCW = 0x7f7f7f7f, int SCX = 0x7f7f7f7f>
__device__ __forceinline__ void gemm_phase(PG8_LAS unsigned char* lds, const int K, const Sched& S, const Epi& E, PG8_LAS unsigned* gtab) {
    const int tid = threadIdx.x, wid = __builtin_amdgcn_readfirstlane(tid >> 6), lane = tid & 63, wr = wid >> 2, wc = wid & 3, fr = lane & 15, fq = lane >> 4;
    const int nt = K / BK;
    unsigned voffA[2], voffB[2]; unsigned voffG[2][2] = {{0u, 0u}, {0u, 0u}}; int gR[2]; unsigned gC2[2];
#pragma unroll
    for (int i = 0; i < 2; ++i) { int R, C; stage_rc(tid * 16 + i * 8192, R, C); const int Rb = Epi::PERM ? ((R & ~31) + perm32(R & 31)) : R;
        gR[i] = R; gC2[i] = (unsigned)C * 2u; voffA[i] = (unsigned)(R * K + C) * 2u; voffB[i] = (unsigned)(Rb * K + C) * 2u; }
    const size_t kstep = (size_t)(BK * 2);
    const size_t hstep = (size_t)HALF * K * 2;
    const size_t tstep = 2 * hstep;
    const unsigned ldsw = (unsigned)wid * 1024u;
    const int aoff = lds_byte(wr * 64 + fr, fq * 8), boff = lds_byte(wc * 32 + fr, fq * 8);
#define PG8_SA(b, h) (((b) * 2 + (h)) * HTB)
#define PG8_SB(b, h) ((4 + (b) * 2 + (h)) * HTB)
#define PG8_STAGE(bufoff, gbase, voff) do { _Pragma("unroll") for (int _i = 0; _i < 2; ++_i) \
        __builtin_amdgcn_global_load_lds((const unsigned*)((const char*)(gbase) + (voff)[_i]), (PG8_LAS unsigned*)(lds + (bufoff) + ldsw + _i * 8192), 16, 0, 0); } while (0)
#define PG8_STAGE_A(bufoff, gbase, h) do { _Pragma("unroll") for (int _i = 0; _i < 2; ++_i) { const char* _src; \
        if constexpr (Sched::GATHER) _src = (const char*)(gbase) + voffG[h][_i]; else _src = (const char*)(gbase) + (size_t)(h) * hstep + voffA[_i]; \
        __builtin_amdgcn_global_load_lds((const unsigned*)_src, (PG8_LAS unsigned*)(lds + (bufoff) + ldsw + _i * 8192), 16, 0, Sched::A_AUX); } } while (0)
#define PG8_LOADG(uidx) do { _Pragma("unroll") for (int _h = 0; _h < 2; ++_h) _Pragma("unroll") for (int _i = 0; _i < 2; ++_i) voffG[_h][_i] = gtab[(uidx) * 256 + _h * 128 + gR[_i]] + gC2[_i]; } while (0)
#define PG8_GSWITCH do { if constexpr (Sched::GATHER) { if (last && has_next) PG8_LOADG(ui + 1); } } while (0)
#define PG8_LDA(dst, b, h) do { _Pragma("unroll") for (int m = 0; m < 4; ++m) _Pragma("unroll") for (int k = 0; k < 2; ++k) dst[m][k] = *(const PG8_LAS bf16x8*)(lds + PG8_SA(b, h) + aoff + m * 2048 + k * 1024); } while (0)
#define PG8_LDB(dst, b, h) do { _Pragma("unroll") for (int n = 0; n < 2; ++n) _Pragma("unroll") for (int k = 0; k < 2; ++k) dst[n][k] = *(const PG8_LAS bf16x8*)(lds + PG8_SB(b, h) + boff + n * 2048 + k * 1024); } while (0)
#define PG8_CAT(x_) __builtin_bit_cast(v8i_t, __builtin_shufflevector((x_)[0], (x_)[1], 0, 1, 2, 3, 4, 5, 6, 7, 8, 9, 10, 11, 12, 13, 14, 15))
#define PG8_MMA(ai, bj, At, Bt) do { __builtin_amdgcn_s_setprio(1); \
        if constexpr (FP8 == 2) { _Pragma("unroll") for (int m = 0; m < 4; ++m) _Pragma("unroll") for (int n = 0; n < 2; ++n) \
            acc[ai][bj][m][n] = __builtin_amdgcn_mfma_scale_f32_16x16x128_f8f6f4(PG8_CAT(Bt[n]), PG8_CAT(At[m]), acc[ai][bj][m][n], 0, 0, 0, SCW, 0, SCX); } \
        else if constexpr (FP8 == 1) { _Pragma("unroll") for (int m = 0; m < 4; ++m) _Pragma("unroll") for (int n = 0; n < 2; ++n) _Pragma("unroll") for (int k = 0; k < 2; ++k) { \
            const v2l_t b2_ = __builtin_bit_cast(v2l_t, Bt[n][k]), a2_ = __builtin_bit_cast(v2l_t, At[m][k]); \
            acc[ai][bj][m][n] = __builtin_amdgcn_mfma_f32_16x16x32_fp8_fp8(b2_[0], a2_[0], acc[ai][bj][m][n], 0, 0, 0); \
            acc[ai][bj][m][n] = __builtin_amdgcn_mfma_f32_16x16x32_fp8_fp8(b2_[1], a2_[1], acc[ai][bj][m][n], 0, 0, 0); } } \
        else { _Pragma("unroll") for (int m = 0; m < 4; ++m) _Pragma("unroll") for (int n = 0; n < 2; ++n) _Pragma("unroll") for (int k = 0; k < 2; ++k) \
            acc[ai][bj][m][n] = __builtin_amdgcn_mfma_f32_16x16x32_bf16(Bt[n][k], At[m][k], acc[ai][bj][m][n], 0, 0, 0); } \
        __builtin_amdgcn_s_setprio(0); } while (0)
#define PG8_WAIT_V(n) asm volatile("s_waitcnt vmcnt(" #n ")" ::: "memory")
#define PG8_WAIT_L(n) asm volatile("s_waitcnt lgkmcnt(" #n ")" ::: "memory")
#define PG8_BAR __builtin_amdgcn_s_barrier()
#define PG8_SCHED __builtin_amdgcn_sched_barrier(0)
    typename Sched::UnitT cur, nxt; int ui = 0;
    if (!S.next(0, cur)) return;
    f32x4 acc[2][2][4][2];
#pragma unroll
    for (int a = 0; a < 2; ++a)
#pragma unroll
        for (int b = 0; b < 2; ++b)
#pragma unroll
            for (int m = 0; m < 4; ++m)
#pragma unroll
                for (int n = 0; n < 2; ++n) acc[a][b][m][n] = (f32x4){0.f, 0.f, 0.f, 0.f};
    bf16x8 At[4][2], B0[2][2], B1[2][2];
    const char* cA = S.ptrA(cur); const char* cB = S.ptrB(cur);
    if constexpr (Sched::GATHER) {
        for (int i0 = 0; ; i0 += 4) {
            typename Sched::UnitT gu[4]; bool ok[4]; unsigned rv[4];
#pragma unroll
            for (int q = 0; q < 4; ++q) ok[q] = S.next(i0 + q, gu[q]);
#pragma unroll
            for (int q = 0; q < 4; ++q) rv[q] = (ok[q] && tid < 256) ? S.rowoff(gu[q], tid) : 0u;
#pragma unroll
            for (int q = 0; q < 4; ++q) if (ok[q] && tid < 256) gtab[(i0 + q) * 256 + tid] = rv[q];
            if (!ok[3]) break;
        }
        asm volatile("s_waitcnt vmcnt(0) lgkmcnt(0)" ::: "memory"); __builtin_amdgcn_s_barrier(); asm volatile("" ::: "memory");
        PG8_LOADG(0);
    }
    S.a_ready(cur);
    if constexpr (SP2) {
        PG8_STAGE(PG8_SB(0, 0), cB, voffB); PG8_STAGE(PG8_SB(0, 1), cB + hstep, voffB); PG8_STAGE_A(PG8_SA(0, 0), cA, 0); PG8_STAGE_A(PG8_SA(0, 1), cA, 1);
        if (wr == 1) PG8_BAR;
        PG8_WAIT_V(2); PG8_BAR;
        PG8_STAGE(PG8_SB(1, 0), cB + kstep, voffB); PG8_STAGE_A(PG8_SA(1, 0), cA + kstep, 0); PG8_STAGE(PG8_SB(1, 1), cB + hstep + kstep, voffB);
        PG8_WAIT_V(6); PG8_BAR;
    } else {
        PG8_STAGE(PG8_SB(0, 0), cB, voffB); PG8_STAGE_A(PG8_SA(0, 0), cA, 0); PG8_STAGE(PG8_SB(0, 1), cB + hstep, voffB); PG8_STAGE_A(PG8_SA(0, 1), cA, 1);
        if (wr == 1) PG8_BAR;
        PG8_WAIT_V(4); PG8_BAR;
        PG8_STAGE(PG8_SB(1, 0), cB + kstep, voffB); PG8_STAGE_A(PG8_SA(1, 0), cA + kstep, 0); PG8_STAGE(PG8_SB(1, 1), cB + hstep + kstep, voffB);
        PG8_WAIT_V(6); PG8_BAR;
    }
    for (;;) {
        const bool has_next = S.next(ui + 1, nxt);
        const char* nA = has_next ? S.ptrA(nxt) : cA; const char* nB = has_next ? S.ptrB(nxt) : cB;
#pragma unroll 1
        for (int t = 0; t < nt; t += 2) {
            if constexpr (Epi::HAS_MID) { if (t == Epi::TMID) E.mid(acc, cur, wr, wc, fr, fq); }
            const bool last = (t == nt - 2);
            const char* a1 = cA + (size_t)(t + 1) * kstep;
            const char* a2 = last ? nA : cA + (size_t)(t + 2) * kstep; const char* b2 = last ? nB : cB + (size_t)(t + 2) * kstep;
            const char* a3 = a2 + kstep; const char* b3 = b2 + kstep;
            if (last && has_next) S.a_ready(nxt);
            if constexpr (SP2) {
            PG8_LDB(B0, 0, 0); PG8_LDB(B1, 0, 1); PG8_SCHED; PG8_LDA(At, 0, 0); PG8_STAGE_A(PG8_SA(1, 1), a1, 1); PG8_GSWITCH;
            PG8_WAIT_V(8); PG8_WAIT_L(0); PG8_BAR; PG8_MMA(0, 0, At, B0); PG8_MMA(0, 1, At, B1); PG8_BAR; PG8_SCHED;
            PG8_LDA(At, 0, 1); PG8_STAGE(PG8_SB(0, 0), b2, voffB); PG8_STAGE(PG8_SB(0, 1), b2 + hstep, voffB); PG8_STAGE_A(PG8_SA(0, 0), a2, 0);
            PG8_WAIT_V(8); PG8_WAIT_L(0); PG8_BAR; PG8_MMA(1, 0, At, B0); PG8_MMA(1, 1, At, B1); PG8_BAR; PG8_SCHED;
            PG8_LDB(B0, 1, 0); PG8_LDB(B1, 1, 1); PG8_SCHED; PG8_LDA(At, 1, 0); PG8_STAGE_A(PG8_SA(0, 1), a2, 1);
            PG8_WAIT_V(8); PG8_WAIT_L(0); PG8_BAR; PG8_MMA(0, 0, At, B0); PG8_MMA(0, 1, At, B1); PG8_BAR; PG8_SCHED;
            PG8_LDA(At, 1, 1); PG8_STAGE(PG8_SB(1, 0), b3, voffB); PG8_STAGE(PG8_SB(1, 1), b3 + hstep, voffB); PG8_STAGE_A(PG8_SA(1, 0), a3, 0);
            PG8_WAIT_V(8); PG8_WAIT_L(0); PG8_BAR; PG8_MMA(1, 0, At, B0); PG8_MMA(1, 1, At, B1); PG8_BAR; PG8_SCHED;
            } else {
            PG8_LDB(B0, 0, 0); PG8_SCHED; PG8_LDA(At, 0, 0); PG8_STAGE_A(PG8_SA(1, 1), a1, 1); PG8_GSWITCH;
            PG8_WAIT_L(8); PG8_BAR; PG8_WAIT_L(0); PG8_MMA(0, 0, At, B0); PG8_BAR; PG8_SCHED;
            PG8_LDB(B1, 0, 1); PG8_STAGE(PG8_SB(0, 0), b2, voffB);
            PG8_BAR; PG8_WAIT_L(0); PG8_MMA(0, 1, At, B1); PG8_BAR;
            PG8_LDA(At, 0, 1); PG8_STAGE_A(PG8_SA(0, 0), a2, 0);
            PG8_BAR; PG8_WAIT_L(0); PG8_MMA(1, 0, At, B0); PG8_BAR; PG8_SCHED;
            PG8_STAGE(PG8_SB(0, 1), b2 + hstep, voffB);
            PG8_WAIT_V(6); PG8_BAR; PG8_MMA(1, 1, At, B1); PG8_BAR;
            PG8_LDB(B0, 1, 0); PG8_SCHED; PG8_LDA(At, 1, 0); PG8_STAGE_A(PG8_SA(0, 1), a2, 1);
            PG8_WAIT_L(8); PG8_BAR; PG8_WAIT_L(0); PG8_MMA(0, 0, At, B0); PG8_BAR; PG8_SCHED;
            PG8_LDB(B1, 1, 1); PG8_STAGE(PG8_SB(1, 0), b3, voffB);
            PG8_BAR; PG8_WAIT_L(0); PG8_MMA(0, 1, At, B1); PG8_BAR;
            PG8_LDA(At, 1, 1); PG8_STAGE_A(PG8_SA(1, 0), a3, 0);
            PG8_BAR; PG8_WAIT_L(0); PG8_MMA(1, 0, At, B0); PG8_BAR; PG8_SCHED;
            PG8_STAGE(PG8_SB(1, 1), b3 + hstep, voffB);
            PG8_WAIT_V(6); PG8_BAR; PG8_MMA(1, 1, At, B1); PG8_BAR;
            }
        }
        if constexpr (ALIGN_EPI) { if (wr == 0) PG8_BAR; }
        if constexpr (!Epi::AFTER_DRAIN) { E(acc, cur, wr, wc, fr, fq); S.done(cur); }
        if (!has_next) break;
#pragma unroll
        for (int a = 0; a < 2; ++a)
#pragma unroll
            for (int b = 0; b < 2; ++b)
#pragma unroll
                for (int m = 0; m < 4; ++m)
#pragma unroll
                    for (int n = 0; n < 2; ++n) acc[a][b][m][n] = (f32x4){0.f, 0.f, 0.f, 0.f};
        cur = nxt; cA = nA; cB = nB; ++ui;
        if constexpr (ALIGN_EPI) { if (wr == 1) PG8_BAR; }
    }
    PG8_WAIT_V(0);
    if constexpr (!ALIGN_EPI) { if (wr == 0) PG8_BAR; }
    PG8_BAR;
    if constexpr (Epi::AFTER_DRAIN) { E.fused(acc, cur, wr, wc, fr, fq, lds, wid, lane); S.done(cur); }
#undef PG8_SA
#undef PG8_SB
#undef PG8_STAGE
#undef PG8_STAGE_A
#undef PG8_LOADG
#undef PG8_GSWITCH
#undef PG8_LDA
#undef PG8_LDB
#undef PG8_MMA
#undef PG8_CAT
#undef PG8_WAIT_V
#undef PG8_WAIT_L
#undef PG8_BAR
#undef PG8_SCHED
}
}
constexpr size_t MiB = 1u << 20;
constexpr size_t WS_CTL = 0, CTL_ZERO_BYTES = 128 * 1024;
constexpr size_t WS_WIN = 2 * MiB;
constexpr size_t WS_WAB = 18 * MiB;
constexpr size_t WS_WOUT = 21 * MiB;
constexpr size_t WS_GATEL = 23 * MiB;
constexpr size_t WS_LIST = 25 * MiB;
constexpr size_t WS_ASG = 27 * MiB;
constexpr size_t WS_WGU = 32 * MiB;
constexpr size_t WS_WD = 160 * MiB;
constexpr size_t WS_XN = 224 * MiB;
constexpr size_t WS_PROJ = 256 * MiB;
constexpr size_t WS_YAB = 504 * MiB;
constexpr size_t WS_MERGED = 552 * MiB;
constexpr size_t WS_ACT = 256 * MiB;
constexpr size_t WS_GQ = 584 * MiB;
constexpr size_t WS_GKT = 616 * MiB;
constexpr size_t WS_GUT = 648 * MiB;
constexpr size_t WS_GW = 712 * MiB;
constexpr size_t WS_GQK = 776 * MiB;
constexpr size_t WS_GEG = 808 * MiB;
constexpr size_t WS_OF = 890 * MiB;
constexpr size_t WS_OB = 922 * MiB;
constexpr size_t WS_YEXP = 840 * MiB;
constexpr size_t WS_OP = 840 * MiB;
constexpr size_t WS_LSE = 888 * MiB;
constexpr size_t WS_END = 984 * MiB;
constexpr int CW_RDY = 20480;
constexpr int CW_TMO = 0, CW_CODE = 1, CW_BAR = 4096, CW_CNT = 16384;
constexpr int N_BAR_REGIONS = 3;
static_assert((CW_RDY + 288 * 16) * 4 <= (int)CTL_ZERO_BYTES && CW_RDY >= CW_CNT + 64 && (CW_CNT + 64) * 4 <= (int)CTL_ZERO_BYTES && (CW_BAR + 3 * 3456) * 4 <= CW_CNT * 4, "control words inside the per-call memset");

constexpr int RING_OFF = 0, RING_BYTES = 131072;
constexpr int LDSCTL_OFF = RING_BYTES, MISC_OFF = LDSCTL_OFF + 320;
constexpr int ETAB_OFF = LDSCTL_OFF + 1024;
constexpr int GTAB_OFF = LDSCTL_OFF + 2048;
constexpr int LDS_BYTES = 163840;
constexpr int EPITAB_OFF = GTAB_OFF + 10 * 1024;
constexpr int EPISCR_OFF = EPITAB_OFF + 10 * 1024;
static_assert(EPISCR_OFF + 8 * 1280 <= LDS_BYTES, "LDS map");
constexpr int NWAVES = 8;

#define GAS __attribute__((address_space(1)))
#define LAS __attribute__((address_space(3)))
typedef unsigned short bf16;
typedef unsigned v4u __attribute__((ext_vector_type(4)));
typedef float f32x4 __attribute__((ext_vector_type(4)));
typedef short bf16x8 __attribute__((ext_vector_type(8)));
typedef GAS unsigned gu32;
typedef GAS unsigned long long gu64;
#define RLX_AGENT __ATOMIC_RELAXED, __HIP_MEMORY_SCOPE_AGENT
#define LDS_WAIT() asm volatile("s_waitcnt lgkmcnt(0)" ::: "memory")
#define VM_WAIT() asm volatile("s_waitcnt vmcnt(0)" ::: "memory")
__device__ __forceinline__ unsigned long long rt() { return __builtin_amdgcn_s_memrealtime(); }
typedef float pk_f32x2_t __attribute__((ext_vector_type(2))); typedef __bf16 pk_bf16x2_t __attribute__((ext_vector_type(2)));
__device__ __forceinline__ unsigned pk2(float lo, float hi) { pk_f32x2_t v = {lo, hi}; pk_bf16x2_t b = __builtin_convertvector(v, pk_bf16x2_t); return __builtin_bit_cast(unsigned, b); }
__device__ __forceinline__ unsigned f2bf(float f) { return pk2(f, 0.f) & 0xffffu; }

#define XB_TMO      128
#define XB_XCNT(j)  (256  + 64 * (j))
#define XB_XSUB(j)  (1280 + 64 * (j))
#define XB_XGEN(j)  (2304 + 64 * (j))
#define XB_TOP      3328
#define XB_TOPGEN   3392
#define XCD_BAR_WORDS 3456
#define XB_SPIN_CAP (1u << 18)
#ifndef XB_SLEEP
#define XB_SLEEP 1
#endif

__device__ __forceinline__ unsigned xb_ld(unsigned* p)              { return __hip_atomic_load(p, __ATOMIC_RELAXED, __HIP_MEMORY_SCOPE_AGENT); }
__device__ __forceinline__ unsigned xb_add(unsigned* p, unsigned v) { return __hip_atomic_fetch_add(p, v, __ATOMIC_RELAXED, __HIP_MEMORY_SCOPE_AGENT); }
__device__ __forceinline__ unsigned xb_xcc_id() { return (unsigned)__builtin_amdgcn_s_getreg((3 << 11) | 20) & 0xFu; }
#define XB_SPIN(cond, bar) do { unsigned _sp = 0; while (cond) { if (XB_SLEEP) __builtin_amdgcn_s_sleep(1); \
    if ((++_sp & 255u) == 0u) { if (xb_ld(&(bar)[XB_TMO])) break; if (_sp > XB_SPIN_CAP) { atomicAdd(&(bar)[XB_TMO], 1u); break; } } } } while (0)

struct XcdBarrier {
    unsigned* bar; unsigned x;
    volatile LAS unsigned* st;
};

__device__ __forceinline__ XcdBarrier xcd_barrier_post(unsigned* bar, volatile LAS unsigned* st) {
    XcdBarrier b; b.bar = bar; b.x = xb_xcc_id(); b.st = st;
    if (threadIdx.x == 0) (void)xb_add(&bar[XB_XCNT(b.x)], 1u);
    return b;
}
__device__ __forceinline__ void xcd_barrier_complete(unsigned* bar, unsigned x, unsigned& nloc, unsigned& nx) {
    const unsigned G = gridDim.x * gridDim.y * gridDim.z;
    unsigned sum, cnt, mine, sp = 0u;
    for (;;) {
        sum = 0u; cnt = 0u; mine = 0u;
#pragma unroll
        for (unsigned j = 0; j < 16; ++j) { const unsigned c = xb_ld(&bar[XB_XCNT(j)]); sum += c; cnt += (c > 0u) ? 1u : 0u; mine = (j == x) ? c : mine; }
        if (sum == G) break;
        __builtin_amdgcn_s_sleep(1);
        if ((++sp & 255u) == 0u) { if (xb_ld(&bar[XB_TMO])) break; if (sp > XB_SPIN_CAP) { atomicAdd(&bar[XB_TMO], 1u); break; } }
    }
    nloc = mine > 0u ? mine : 1u; nx = cnt > 0u ? cnt : 1u;
}

__device__ __forceinline__ void xcd_barrier(const XcdBarrier& b) {
    asm volatile("s_waitcnt vmcnt(0)" ::: "memory");
    __syncthreads();
    if (threadIdx.x == 0) {
        unsigned* bar = b.bar;
        __builtin_amdgcn_s_waitcnt(0);
        unsigned nloc = b.st[0], nx = b.st[1];
        if (nloc == 0u) { xcd_barrier_complete(bar, b.x, nloc, nx); b.st[0] = nloc; b.st[1] = nx; }
        const unsigned old = xb_add(&bar[XB_XSUB(b.x)], 1u);
        const unsigned gen = old / nloc;
        if (old + 1u == (gen + 1u) * nloc) {
            __builtin_amdgcn_fence(__ATOMIC_RELEASE, "agent");
            asm volatile("s_waitcnt vmcnt(0)" ::: "memory");
            const unsigned og = xb_add(&bar[XB_TOP], 1u);
            const unsigned tg = og / nx;
            if (og + 1u == (tg + 1u) * nx) xb_add(&bar[XB_TOPGEN], 1u);
            else XB_SPIN(xb_ld(&bar[XB_TOPGEN]) == tg, bar);
            __builtin_amdgcn_fence(__ATOMIC_ACQUIRE, "agent");
            xb_add(&bar[XB_XGEN(b.x)], 1u);
            asm volatile("s_waitcnt vmcnt(0)" ::: "memory");
        } else {
            XB_SPIN(xb_ld(&bar[XB_XGEN(b.x)]) == gen, bar);
            __builtin_amdgcn_fence(__ATOMIC_ACQUIRE, "agent");
            asm volatile("s_waitcnt vmcnt(0)" ::: "memory");
        }
    }
    __syncthreads();
}
__device__ __forceinline__ float wave_sum(float v) {
#pragma unroll
    for (int o = 1; o < 64; o <<= 1) v += __shfl_xor(v, o);
    return v;
}
__device__ __forceinline__ float bf2f(unsigned short b) { return __uint_as_float((unsigned)b << 16); }

__device__ __forceinline__ void tr_item(const float* W, int N, bf16* WT, int pitch, int kcol0, int k0, int n0, int drow0, LAS float* scr, int lane) {
#pragma unroll 8
    for (int i = 0; i < 32; ++i) { const int kk = 2 * i + (lane >> 5); scr[kk * 33 + (lane & 31)] = W[(size_t)(k0 + kk) * N + n0 + (lane & 31)]; }
    LDS_WAIT(); asm volatile("" ::: "memory");
    const int c = lane & 7;
#pragma unroll
    for (int j = 0; j < 4; ++j) { const int n = (lane >> 3) + 8 * j; const LAS float* s = scr + (8 * c) * 33 + n;
        v4u o; o.x = pk2(s[0 * 33], s[1 * 33]); o.y = pk2(s[2 * 33], s[3 * 33]); o.z = pk2(s[4 * 33], s[5 * 33]); o.w = pk2(s[6 * 33], s[7 * 33]);
        *(GAS v4u*)(WT + (size_t)(drow0 + n) * pitch + kcol0 + k0 + 8 * c) = o; }
    LDS_WAIT(); asm volatile("" ::: "memory");
}

__device__ __forceinline__ void tr_item8(const float* W, int N, unsigned char* WT, int pitch, int k0, int n0, int drow0, LAS float* scr, int lane) {
#pragma unroll 8
    for (int i = 0; i < 32; ++i) { const int kk = 2 * i + (lane >> 5); scr[kk * 33 + (lane & 31)] = W[(size_t)(k0 + kk) * N + n0 + (lane & 31)]; }
    LDS_WAIT(); asm volatile("" ::: "memory");
    const int c = lane & 7;
    typedef unsigned u32x2t __attribute__((ext_vector_type(2)));
#pragma unroll
    for (int j = 0; j < 4; ++j) { const int n = (lane >> 3) + 8 * j; const LAS float* s = scr + (8 * c) * 33 + n;
        u32x2t o; o.x = pg8::pk4_fp8(s[0 * 33] * F8_SW, s[1 * 33] * F8_SW, s[2 * 33] * F8_SW, s[3 * 33] * F8_SW); o.y = pg8::pk4_fp8(s[4 * 33] * F8_SW, s[5 * 33] * F8_SW, s[6 * 33] * F8_SW, s[7 * 33] * F8_SW);
        *(GAS u32x2t*)(WT + (size_t)(drow0 + n) * pitch + k0 + 8 * c) = o; }
    LDS_WAIT(); asm volatile("" ::: "memory");
}

struct Ptrs {
    const float *x, *norm1_w, *w_in, *conv_w, *a_log_f, *a_log_b, *dtb_f, *dtb_b, *gdn_nw, *w_ba, *w_bb, *w_out, *norm2_w, *router_w, *router_b, *w_gu, *b_gu, *w_d, *b_d, *normf_w;
    float* out; unsigned char* ws;
};
struct Args { Ptrs p; int ph_lo, ph_hi, li, pad; };

__device__ __forceinline__ void p0_prologue(const Ptrs& P, LAS unsigned char* lds, int vcu, int G, int wave, int lane) {
    LAS float* scr = (LAS float*)(lds + RING_OFF + wave * 16384);
    const int gw = vcu * NWAVES + wave, NGW = G * NWAVES;
    bf16* WIN = (bf16*)(P.ws + WS_WIN); bf16* WAB = (bf16*)(P.ws + WS_WAB); bf16* WOUT = (bf16*)(P.ws + WS_WOUT); bf16* WGU = (bf16*)(P.ws + WS_WGU); bf16* WD = (bf16*)(P.ws + WS_WD);
    constexpr int I_IN = 16 * 241, I_BA = 8 * 32, I_BB = 16 * 32, I_OUT = 16 * 32, I_GU = 32 * 16 * 64, I_D = 32 * 16 * 32;
    constexpr int NITEMS = I_IN + I_BA + I_BB + I_OUT + I_GU + I_D;
    const int nitems = (G == 256 && !RIDE_OFF) ? I_IN + I_BA + I_BB + I_OUT : NITEMS;
    for (int it = gw; it < nitems; it += NGW) {
        int r = it;
        if (r < I_IN) { const int kb = r / 241, nb = r % 241, n0 = 32 * nb;
            const int d0 = n0 < 5632 ? n0 : (n0 < 5664 ? P_AF + (n0 - 5632) : P_GA + (n0 - 5664));
#if P1_FP8
            tr_item8(P.w_in, NIN, P.ws + WS_WIN, 1024, 64 * kb, n0, d0, scr, lane); continue; } r -= I_IN;
#else
            tr_item(P.w_in, NIN, WIN, 1024, 0, 64 * kb, n0, d0, scr, lane); continue; } r -= I_IN;
#endif
        if (r < I_BA) { tr_item(P.w_ba, 1024, WAB, KAB, 0, 64 * (r / 32), 32 * (r % 32), 32 * (r % 32), scr, lane); continue; } r -= I_BA;
        if (r < I_BB) { tr_item(P.w_bb, 1024, WAB, KAB, 512, 64 * (r / 32), 32 * (r % 32), 32 * (r % 32), scr, lane); continue; } r -= I_BB;
        if (r < I_OUT) { tr_item(P.w_out, 1024, WOUT, 1024, 0, 64 * (r / 32), 32 * (r % 32), 32 * (r % 32), scr, lane); continue; } r -= I_OUT;
        if (r < I_GU) { const int e = r / 1024, q = r % 1024, kb = q / 64, nb = q % 64, n0 = 32 * nb;
            const int d0 = n0 < 1024 ? 256 * (n0 / 128) + (n0 % 128) : 256 * ((n0 - 1024) / 128) + 128 + ((n0 - 1024) % 128);
            tr_item8(P.w_gu + (size_t)e * 1024 * 2048, 2048, P.ws + WS_WGU + (size_t)e * 2048 * 1024, 1024, 64 * kb, n0, d0, scr, lane); continue; } r -= I_GU;
        { const int e = r / 512, q = r % 512;
            tr_item8(P.w_d + (size_t)e * 1024 * 1024, 1024, P.ws + WS_WD + (size_t)e * 1024 * 1024, 1024, 64 * (q / 32), 32 * (q % 32), 32 * (q % 32), scr, lane); }
    }
    for (int i = gw * 64 + lane; i < 224 * 1024 / (P1_FP8 ? 16 : 8); i += NGW * 64) ((GAS v4u*)(P.ws + WS_WIN + (size_t)7712 * 1024 * (P1_FP8 ? 1 : 2)))[i] = (v4u){0u, 0u, 0u, 0u};
    bf16* XN = (bf16*)(P.ws + WS_XN);
    for (int m = gw; m < M; m += NGW) {
        const GAS f32x4* xr = (const GAS f32x4*)(P.x + (size_t)m * DM) + lane; const GAS f32x4* wr = (const GAS f32x4*)P.norm1_w + lane;
        f32x4 v[4]; float s = 0.f;
#pragma unroll
        for (int j = 0; j < 4; ++j) { v[j] = xr[64 * j]; s += (v[j].x * v[j].x + v[j].y * v[j].y) + (v[j].z * v[j].z + v[j].w * v[j].w); }
        const float rstd = rsqrtf(wave_sum(s) * (1.f / DM) + EPS);
        GAS unsigned long long* o8 = (GAS unsigned long long*)(XN + (size_t)m * DM) + lane;
#pragma unroll
        for (int j = 0; j < 4; ++j) { const f32x4 w = wr[64 * j];
#if P1_FP8
            const float rs = rstd * F8_SA; ((GAS unsigned*)(P.ws + WS_XN + (size_t)m * DM))[64 * j + lane] = pg8::pk4_fp8(v[j].x * rs * w.x, v[j].y * rs * w.y, v[j].z * rs * w.z, v[j].w * rs * w.w);
#else
            o8[64 * j] = (unsigned long long)pk2(v[j].x * rstd * w.x, v[j].y * rstd * w.y) | ((unsigned long long)pk2(v[j].z * rstd * w.z, v[j].w * rstd * w.w) << 32);
#endif
        }
    }
}

__device__ __forceinline__ void build_etab(const unsigned* cnt, LAS int* etab, int tid) {
    if (tid < 32) etab[40 + tid] = (int)__hip_atomic_load(cnt + tid, __ATOMIC_RELAXED, __HIP_MEMORY_SCOPE_AGENT);
    LDS_WAIT(); __syncthreads();
    if (tid == 0) { int s = 0; for (int e = 0; e < 32; ++e) { etab[e] = s; s += (etab[40 + e] + 255) >> 8; } etab[32] = s; }
    LDS_WAIT(); __syncthreads();
}

template <int VAR> __device__ __forceinline__ void p7_router(const Ptrs& P, LAS unsigned char* lds, int G, int tid, int wave, int lane) {
    LAS float* rw = (LAS float*)(lds + RING_OFF);
    LAS int* hist = (LAS int*)(lds + ETAB_OFF);
    LAS int* asg = (LAS int*)(lds + GTAB_OFF);
    const float* X1 = P.out; unsigned char* H2 = P.ws + (VAR ? WS_ACT : WS_XN);
    unsigned* CNT = (unsigned*)(P.ws + WS_CTL) + CW_CNT; int* LIST = (int*)(P.ws + WS_LIST); float* GATEL = (float*)(P.ws + WS_GATEL); int* ASG = (int*)(P.ws + WS_ASG);
    for (int i = tid; i < 1024 * 8; i += 512) { const int c = i >> 3, e4 = i & 7, rho = ((((c >> 8) << 2) + (c & 3)) << 6) + ((c >> 2) & 63);
        ((LAS f32x4*)rw)[rho * 8 + (e4 ^ ((rho >> 1) & 7))] = ((const GAS f32x4*)P.router_w)[i]; }
    for (int grp = blockIdx.x; grp < M / 64; grp += G) {
        const int r0 = grp * 64;
        if (tid < 64) hist[tid] = 0;
        LDS_WAIT(); __syncthreads();
        f32x4 na[4], nb[4];
        { const GAS f32x4* xa = (const GAS f32x4*)(X1 + (size_t)(r0 + wave * 8) * DM) + lane; const GAS f32x4* xb = xa + DM / 4;
#pragma unroll
          for (int j = 0; j < 4; ++j) { na[j] = xa[64 * j]; nb[j] = xb[64 * j]; } }
#pragma unroll 1
        for (int i = 0; i < 8; i += 2) {
            const int lrow = wave * 8 + i, m = r0 + lrow;
            const GAS f32x4* wr = (const GAS f32x4*)P.norm2_w + lane;
            f32x4 va[4], vb[4]; float sa = 0.f, sb = 0.f;
            {
#pragma unroll
              for (int j = 0; j < 4; ++j) { va[j] = na[j]; vb[j] = nb[j]; }
              if (i + 2 < 8) { const GAS f32x4* xa = (const GAS f32x4*)(X1 + (size_t)(m + 2) * DM) + lane; const GAS f32x4* xb = xa + DM / 4;
#pragma unroll
                for (int j = 0; j < 4; ++j) { na[j] = xa[64 * j]; nb[j] = xb[64 * j]; } }
#pragma unroll
              for (int j = 0; j < 4; ++j) { sa += (va[j].x * va[j].x + va[j].y * va[j].y) + (va[j].z * va[j].z + va[j].w * va[j].w); sb += (vb[j].x * vb[j].x + vb[j].y * vb[j].y) + (vb[j].z * vb[j].z + vb[j].w * vb[j].w); } }
            const float rsa = rsqrtf(wave_sum(sa) * (1.f / DM) + EPS), rsb = rsqrtf(wave_sum(sb) * (1.f / DM) + EPS);
            GAS unsigned* oa8 = (GAS unsigned*)(H2 + (size_t)m * DM) + lane; GAS unsigned* ob8 = (GAS unsigned*)(H2 + (size_t)(m + 1) * DM) + lane;
            float acca[32], accb[32];
#pragma unroll
            for (int e = 0; e < 32; ++e) { acca[e] = 0.f; accb[e] = 0.f; }
#pragma unroll
            for (int j = 0; j < 4; ++j) { const f32x4 w = wr[64 * j];
                va[j].x *= rsa * w.x; va[j].y *= rsa * w.y; va[j].z *= rsa * w.z; va[j].w *= rsa * w.w; vb[j].x *= rsb * w.x; vb[j].y *= rsb * w.y; vb[j].z *= rsb * w.z; vb[j].w *= rsb * w.w;
                oa8[64 * j] = pg8::pk4_fp8(va[j].x * F8_SA, va[j].y * F8_SA, va[j].z * F8_SA, va[j].w * F8_SA);
                ob8[64 * j] = pg8::pk4_fp8(vb[j].x * F8_SA, vb[j].y * F8_SA, vb[j].z * F8_SA, vb[j].w * F8_SA);
#pragma unroll
                for (int q = 0; q < 4; ++q) { const float ha = va[j][q], hb = vb[j][q]; const LAS f32x4* rp = (const LAS f32x4*)rw + ((4 * j + q) * 64 + lane) * 8; const int sw = (lane >> 1) & 7;
#pragma unroll
                    for (int e4 = 0; e4 < 8; ++e4) { const f32x4 r4 = rp[e4 ^ sw];
                        acca[4 * e4] += ha * r4.x; acca[4 * e4 + 1] += ha * r4.y; acca[4 * e4 + 2] += ha * r4.z; acca[4 * e4 + 3] += ha * r4.w;
                        accb[4 * e4] += hb * r4.x; accb[4 * e4 + 1] += hb * r4.y; accb[4 * e4 + 2] += hb * r4.z; accb[4 * e4 + 3] += hb * r4.w; } } }
            float r32[32], r16[16], r8[8], r4[4], r2[2], lg;
            { const bool hi = (lane >> 5) & 1;
#pragma unroll
              for (int q = 0; q < 32; ++q) { const float keep = hi ? accb[q] : acca[q], send = hi ? acca[q] : accb[q]; r32[q] = keep + __shfl_xor(send, 32); } }
            { const bool hi = (lane >> 4) & 1;
#pragma unroll
              for (int q = 0; q < 16; ++q) { const float keep = hi ? r32[16 + q] : r32[q], send = hi ? r32[q] : r32[16 + q]; r16[q] = keep + __shfl_xor(send, 16); } }
            { const bool hi = (lane >> 3) & 1;
#pragma unroll
              for (int q = 0; q < 8; ++q) { const float keep = hi ? r16[8 + q] : r16[q], send = hi ? r16[q] : r16[8 + q]; r8[q] = keep + __shfl_xor(send, 8); } }
            { const bool hi = (lane >> 2) & 1;
#pragma unroll
              for (int q = 0; q < 4; ++q) { const float keep = hi ? r8[4 + q] : r8[q], send = hi ? r8[q] : r8[4 + q]; r4[q] = keep + __shfl_xor(send, 4); } }
            { const bool hi = (lane >> 1) & 1;
#pragma unroll
              for (int q = 0; q < 2; ++q) { const float keep = hi ? r4[2 + q] : r4[q], send = hi ? r4[q] : r4[2 + q]; r2[q] = keep + __shfl_xor(send, 2); } }
            { const bool hi = lane & 1; const float keep = hi ? r2[1] : r2[0], send = hi ? r2[0] : r2[1]; lg = keep + __shfl_xor(send, 1); }
            const int e = lane & 31, half = lane >> 5; lg += P.router_b[e];
            float lv[4]; int li[4]; float cur = lg;
#pragma unroll
            for (int r = 0; r < 4; ++r) { float bv = cur; int bi = e;
#pragma unroll
                for (int o = 1; o < 32; o <<= 1) { const float ov = __shfl_xor(bv, o); const int oi = __shfl_xor(bi, o); if (ov > bv || (ov == bv && oi < bi)) { bv = ov; bi = oi; } }
                lv[r] = bv; li[r] = bi; if (e == bi) cur = -3.0e38f; }
            const float e1 = __expf(lv[1] - lv[0]), e2 = __expf(lv[2] - lv[0]), e3 = __expf(lv[3] - lv[0]);
            const float inv = 1.f / (1.f + e1 + e2 + e3);
            if (e < 4) {
                const float g = (e == 0 ? 1.f : e == 1 ? e1 : e == 2 ? e2 : e3) * inv;
                const int ee = e == 0 ? li[0] : e == 1 ? li[1] : e == 2 ? li[2] : li[3];
                const int rank = atomicAdd((int*)(hist + ee), 1);
                const int a = (lrow + half) * 4 + e;
                asg[a] = ee | (rank << 8); asg[256 + a] = __float_as_int(g); asg[512 + a] = (m + half) * 4 + e;
            }
        }
        LDS_WAIT(); __syncthreads();
        if (tid < 32) hist[32 + tid] = VAR ? 0 : (int)__hip_atomic_fetch_add(CNT + tid, (unsigned)hist[tid], __ATOMIC_RELAXED, __HIP_MEMORY_SCOPE_AGENT);
        LDS_WAIT(); __syncthreads();
        if (tid < 256 && !VAR) { const int w = asg[tid], ee = w & 255, pos = hist[32 + ee] + (w >> 8); const int tk = asg[512 + tid];
            LIST[(size_t)ee * M + pos] = tk >> 2; GATEL[(size_t)ee * M + pos] = __int_as_float(asg[256 + tid]); ASG[tk] = (ee << 16) | pos; }
        LDS_WAIT(); __syncthreads();
    }
}

template <int VAR> __device__ __forceinline__ void p10_final(const Ptrs& P, LAS unsigned char* lds, int G, int tid, int wave, int lane) {
    LAS int* etab = (LAS int*)(lds + ETAB_OFF);
    build_etab((const unsigned*)(P.ws + WS_CTL) + CW_CNT, etab, tid);
    const int* ASG = (const int*)(P.ws + WS_ASG); const unsigned char* YEXP = P.ws + WS_YEXP;
    const int gw = blockIdx.x * NWAVES + wave, NGW = G * NWAVES;
    typedef unsigned u32x2 __attribute__((ext_vector_type(2)));
    const GAS f32x4* wr = (const GAS f32x4*)P.normf_w + lane;
    for (int m0 = gw; m0 < M; m0 += 2 * NGW) {
        const int m1 = m0 + NGW < M ? m0 + NGW : m0;
        int slot[2][4], gidx[2][4];
#pragma unroll
        for (int q = 0; q < 2; ++q) { const int4 a4 = *(const int4*)(ASG + (size_t)(q ? m1 : m0) * 4);
            slot[q][0] = etab[a4.x >> 16] * 256 + (a4.x & 0xffff); slot[q][1] = etab[a4.y >> 16] * 256 + (a4.y & 0xffff); slot[q][2] = etab[a4.z >> 16] * 256 + (a4.z & 0xffff); slot[q][3] = etab[a4.w >> 16] * 256 + (a4.w & 0xffff);
            gidx[q][0] = (a4.x >> 16) * 16384 + (a4.x & 0xffff); gidx[q][1] = (a4.y >> 16) * 16384 + (a4.y & 0xffff); gidx[q][2] = (a4.z >> 16) * 16384 + (a4.z & 0xffff); gidx[q][3] = (a4.w >> 16) * 16384 + (a4.w & 0xffff); }
        f32x4 v[2][4]; unsigned y[2][4][4]; float gk[2][4];
#pragma unroll
        for (int q = 0; q < 2; ++q) { const GAS f32x4* xr = (const GAS f32x4*)(P.out + (size_t)(q ? m1 : m0) * DM) + lane;
#pragma unroll
            for (int j = 0; j < 4; ++j) v[q][j] = xr[64 * j];
#pragma unroll
            for (int k = 0; k < 4; ++k) { gk[q][k] = ((const float*)(P.ws + WS_GATEL))[gidx[q][k]] * (1.0f / F8_SY); const GAS unsigned* yr = (const GAS unsigned*)(YEXP + (size_t)slot[q][k] * DM) + lane;
#pragma unroll
                for (int j = 0; j < 4; ++j) y[q][k][j] = yr[64 * j]; } }
#pragma unroll
        for (int q = 0; q < 2; ++q) {
            float s = 0.f;
#pragma unroll
            for (int j = 0; j < 4; ++j) {
#pragma unroll
                for (int k = 0; k < 4; ++k) { const int yy = (int)y[q][k][j]; const auto lo = __builtin_amdgcn_cvt_pk_f32_fp8(yy, false), hi = __builtin_amdgcn_cvt_pk_f32_fp8(yy, true);
                    v[q][j].x += lo[0] * gk[q][k]; v[q][j].y += lo[1] * gk[q][k]; v[q][j].z += hi[0] * gk[q][k]; v[q][j].w += hi[1] * gk[q][k]; }
                s += (v[q][j].x * v[q][j].x + v[q][j].y * v[q][j].y) + (v[q][j].z * v[q][j].z + v[q][j].w * v[q][j].w); }
            const float rstd = rsqrtf(wave_sum(s) * (1.f / DM) + EPS);
            if (q == 0 || m1 != m0) { GAS f32x4* xo = (GAS f32x4*)((VAR ? (float*)(P.ws + WS_ACT) : P.out) + (size_t)(q ? m1 : m0) * DM) + lane;
#pragma unroll
                for (int j = 0; j < 4; ++j) { const f32x4 w = wr[64 * j]; xo[64 * j] = (f32x4){v[q][j].x * rstd * w.x, v[q][j].y * rstd * w.y, v[q][j].z * rstd * w.z, v[q][j].w * rstd * w.w}; } }
        }
    }
}

struct CvIn { f32x4 v[8]; };
__device__ __forceinline__ void cv_decode(int p, const Ptrs& P, const float*& W, unsigned char*& WT, int& N, int& k0, int& n0, int& d0) {
    if (p < 32768) { const int e = p >> 10, r0 = p & 1023, r = (r0 & ~0x41) | ((r0 & 1) << 6) | ((r0 >> 6) & 1), kb = r >> 6, nb = r & 63; N = 2048; k0 = 64 * kb; n0 = 32 * nb;
        W = P.w_gu + (size_t)e * 1024 * 2048; WT = P.ws + WS_WGU + (size_t)e * 2048 * 1024;
        d0 = n0 < 1024 ? 256 * (n0 / 128) + (n0 % 128) : 256 * ((n0 - 1024) / 128) + 128 + ((n0 - 1024) % 128);
    } else { const int pp = p - 32768, e = pp >> 9, r0 = pp & 511, r = (r0 & ~0x21) | ((r0 & 1) << 5) | ((r0 >> 5) & 1), kb = r >> 5, nb = r & 31; N = 1024; k0 = 64 * kb; n0 = 32 * nb;
        W = P.w_d + (size_t)e * 1024 * 1024; WT = P.ws + WS_WD + (size_t)e * 1024 * 1024; d0 = n0; }
}
__device__ __forceinline__ void cv_load(CvIn& C, const Ptrs& P, int p, int lane) {
    const float* W; unsigned char* WT; int N, k0, n0, d0; cv_decode(p, P, W, WT, N, k0, n0, d0);
    const float* src = W + (size_t)(k0 + 4 * (lane >> 3)) * N + n0 + 4 * (lane & 7);
#pragma unroll
    for (int b = 0; b < 2; ++b)
#pragma unroll
        for (int j = 0; j < 4; ++j) C.v[b * 4 + j] = *(const f32x4*)(src + (size_t)(32 * b + j) * N);
}
__device__ __forceinline__ void cv_store(const CvIn& C, const Ptrs& P, int p, int lane, LAS unsigned char* buf) {
    const float* W; unsigned char* WT; int N, k0, n0, d0; cv_decode(p, P, W, WT, N, k0, n0, d0);
    const int r8 = lane >> 3, c4 = lane & 7;
#pragma unroll
    for (int b = 0; b < 2; ++b)
#pragma unroll
        for (int e = 0; e < 4; ++e)
            *(LAS unsigned*)(buf + (4 * c4 + e) * 64 + 16 * ((2 * b + (r8 >> 2)) ^ (c4 & 3)) + 4 * (r8 & 3)) = pg8::pk4_fp8(C.v[b * 4][e] * F8_SW, C.v[b * 4 + 1][e] * F8_SW, C.v[b * 4 + 2][e] * F8_SW, C.v[b * 4 + 3][e] * F8_SW);
    asm volatile("" ::: "memory");
#pragma unroll
    for (int t = 0; t < 2; ++t) { const int n = 16 * t + (lane >> 2), c = lane & 3;
        const v4u d = *(const LAS v4u*)(buf + n * 64 + 16 * (c ^ ((n >> 2) & 3)));
        *(v4u*)(WT + (size_t)(d0 + n) * 1024 + k0 + 16 * c) = d; }
    asm volatile("" ::: "memory");
}
constexpr int CV_PAIRS = 49152;
typedef float f32x16 __attribute__((ext_vector_type(16)));
typedef short v4i16_t __attribute__((ext_vector_type(4)));
typedef float f32x2_t __attribute__((ext_vector_type(2))); typedef __bf16 bf16x2_t __attribute__((ext_vector_type(2)));
__device__ __forceinline__ unsigned cvtpk(float lo, float hi) { f32x2_t v = {lo, hi}; bf16x2_t b = __builtin_convertvector(v, bf16x2_t); return __builtin_bit_cast(unsigned, b); }
constexpr int ATT_VPITCH = 144;
constexpr int ATT_WAVE_LDS = 32 * ATT_VPITCH;
__device__ __forceinline__ void attn_unit(const bf16* proj, bf16* OP, float* LSE, LAS unsigned char* vt, int unit, int lane) {
    const int q128 = unit & 127, p = (unit >> 7) % 3, bh = unit / 384, b = bh >> 3, h = bh & 7;
    const int r = p == 0 ? 1 : (p == 1 ? 4 : 16), gpc = 128 / r, c = q128 / gpc, g = q128 % gpc, L = SEQ / r, u0 = 32 * g;
    int lq = lane & 31, hi = lane >> 5;
    asm volatile("" : "+v"(lq), "+v"(hi));
    const bf16* base = proj + ((size_t)b * SEQ + c) * NINP + h * 64;
    const size_t ustride = (size_t)r * NINP;
    const int vrow = lane >> 3, vch = lane & 7;
    v4u qst[4], kst[5][4];
#pragma unroll
    for (int i = 0; i < 4; ++i) qst[i] = *(const v4u*)(base + (size_t)(u0 + vrow + 8 * i) * ustride + P_QA + 8 * vch);
#define ATT_KLOAD(t) do { _Pragma("unroll") for (int i = 0; i < 4; ++i) { int uk_ = u0 - 64 + 32 * (t) + vrow + 8 * i; uk_ = uk_ < 0 ? 0 : (uk_ > L - 1 ? L - 1 : uk_); kst[t][i] = *(const v4u*)(base + (size_t)uk_ * ustride + P_KA + 8 * vch); } } while (0)
    ATT_KLOAD(0); ATT_KLOAD(1); ATT_KLOAD(2);
    bf16x8 qf[4];
#pragma unroll
    for (int i = 0; i < 4; ++i) *(LAS v4u*)(vt + (vrow + 8 * i) * ATT_VPITCH + vch * 16) = qst[i];
    asm volatile("" ::: "memory");
#pragma unroll
    for (int d0 = 0; d0 < 4; ++d0) qf[d0] = *(const LAS bf16x8*)(vt + lq * ATT_VPITCH + (16 * d0 + 8 * hi) * 2);
    asm volatile("" ::: "memory");
    f32x16 sc[5];
#pragma unroll
    for (int t = 0; t < 5; ++t) {
#pragma unroll
        for (int i = 0; i < 4; ++i) *(LAS v4u*)(vt + (vrow + 8 * i) * ATT_VPITCH + vch * 16) = kst[t][i];
        asm volatile("" ::: "memory");
        if (t == 0) ATT_KLOAD(3);
        if (t == 1) ATT_KLOAD(4);
        f32x16 a = {};
#pragma unroll
        for (int d0 = 0; d0 < 4; ++d0) a = __builtin_amdgcn_mfma_f32_32x32x16_bf16(*(const LAS bf16x8*)(vt + lq * ATT_VPITCH + (16 * d0 + 8 * hi) * 2), qf[d0], a, 0, 0, 0);
        sc[t] = a;
        asm volatile("" ::: "memory");
    }
#undef ATT_KLOAD
    v4u vst[5][4];
#define ATT_VLOAD(t) do { _Pragma("unroll") for (int i = 0; i < 4; ++i) { int uk_ = u0 - 64 + 32 * (t) + vrow + 8 * i; uk_ = uk_ < 0 ? 0 : (uk_ > L - 1 ? L - 1 : uk_); vst[t][i] = *(const v4u*)(base + (size_t)uk_ * ustride + P_VA + 8 * vch); } } while (0)
    ATT_VLOAD(0); ATT_VLOAD(1);
    const float slope2 = exp2f(-(float)(h + 1)) * (float)r * 1.4426950408889634f, qs = 0.125f * 1.4426950408889634f;
    const float Df = (float)(4 * hi - lq);
    float mx = -1e30f;
#pragma unroll
    for (int t = 0; t < 5; ++t)
#pragma unroll
        for (int i = 0; i < 16; ++i) {
            const float diff = (float)(32 * t + (i & 3) + 8 * (i >> 2) - 64) + Df;
            float v = fmaf(sc[t][i], qs, -slope2 * fabsf(diff));
            if (t == 0) v = diff >= -64.f ? v : -1e30f;
            if (t == 4) v = diff <= 64.f ? v : -1e30f;
            sc[t][i] = v;
        }
    if (u0 < 64 || u0 + 96 > L) {
#pragma unroll
        for (int t = 0; t < 5; ++t)
#pragma unroll
            for (int i = 0; i < 16; ++i) { const int uk = u0 - 64 + 32 * t + (i & 3) + 8 * (i >> 2) + 4 * hi; if (uk < 0 || uk >= L) sc[t][i] = -1e30f; }
    }
#pragma unroll
    for (int t = 0; t < 5; ++t)
#pragma unroll
        for (int i = 0; i < 16; ++i) mx = fmaxf(mx, sc[t][i]);
    mx = fmaxf(mx, __shfl_xor(mx, 32));
    float l = 0.f;
#pragma unroll
    for (int t = 0; t < 5; ++t)
#pragma unroll
        for (int i = 0; i < 16; ++i) { const float e = __builtin_amdgcn_exp2f(sc[t][i] - mx); sc[t][i] = e; l += e; }
    l += __shfl_xor(l, 32);
    const float il = __builtin_amdgcn_rcpf(l);
    unsigned pf[5][2][4];
#pragma unroll
    for (int t = 0; t < 5; ++t)
#pragma unroll
        for (int s = 0; s < 2; ++s)
#pragma unroll
            for (int w = 0; w < 4; ++w) pf[t][s][w] = cvtpk(sc[t][8 * s + 2 * w], sc[t][8 * s + 2 * w + 1]);
    f32x16 o0 = {}, o1 = {};
    const int i16 = lane & 15, g16 = (lane >> 4) & 1;
    const LAS unsigned char* trb = vt + (4 * hi + (i16 >> 2)) * ATT_VPITCH + (16 * g16 + 4 * (i16 & 3)) * 2;
#pragma unroll
    for (int t = 0; t < 5; ++t) {
#pragma unroll
        for (int i = 0; i < 4; ++i) *(LAS v4u*)(vt + (vrow + 8 * i) * ATT_VPITCH + vch * 16) = vst[t][i];
        asm volatile("" ::: "memory");
        if (t == 0) ATT_VLOAD(2);
        if (t == 1) ATT_VLOAD(3);
        if (t == 2) ATT_VLOAD(4);
#pragma unroll
        for (int s = 0; s < 2; ++s) {
#pragma unroll
            for (int dt = 0; dt < 2; ++dt) {
                const LAS unsigned char* pa = trb + (16 * s) * ATT_VPITCH + dt * 64;
                const v4i16_t lo = __builtin_amdgcn_ds_read_tr16_b64_v4i16((LAS v4i16_t*)pa);
                const v4i16_t hh = __builtin_amdgcn_ds_read_tr16_b64_v4i16((LAS v4i16_t*)(pa + 8 * ATT_VPITCH));
                const bf16x8 vf = (bf16x8){lo[0], lo[1], lo[2], lo[3], hh[0], hh[1], hh[2], hh[3]};
                const v4u pw = (v4u){pf[t][s][0], pf[t][s][1], pf[t][s][2], pf[t][s][3]};
                if (dt == 0) o0 = __builtin_amdgcn_mfma_f32_32x32x16_bf16(vf, __builtin_bit_cast(bf16x8, pw), o0, 0, 0, 0);
                else o1 = __builtin_amdgcn_mfma_f32_32x32x16_bf16(vf, __builtin_bit_cast(bf16x8, pw), o1, 0, 0, 0);
            }
        }
        asm volatile("" ::: "memory");
    }
#undef ATT_VLOAD
    const size_t tok = (size_t)b * SEQ + (size_t)(u0 + lq) * r + c;
    typedef unsigned u32x2 __attribute__((ext_vector_type(2)));
#pragma unroll
    for (int qd = 0; qd < 4; ++qd) {
        *(LAS u32x2*)(vt + lq * ATT_VPITCH + (4 * hi + 8 * qd) * 2) = (u32x2){cvtpk(o0[4 * qd] * il, o0[4 * qd + 1] * il), cvtpk(o0[4 * qd + 2] * il, o0[4 * qd + 3] * il)};
        *(LAS u32x2*)(vt + lq * ATT_VPITCH + (32 + 4 * hi + 8 * qd) * 2) = (u32x2){cvtpk(o1[4 * qd] * il, o1[4 * qd + 1] * il), cvtpk(o1[4 * qd + 2] * il, o1[4 * qd + 3] * il)};
    }
    asm volatile("" ::: "memory");
#pragma unroll
    for (int i = 0; i < 4; ++i) {
        const v4u ov = *(const LAS v4u*)(vt + (vrow + 8 * i) * ATT_VPITCH + vch * 16);
        *(v4u*)(OP + ((size_t)p * M + (size_t)b * SEQ + (size_t)(u0 + vrow + 8 * i) * r + c) * 512 + h * 64 + 8 * vch) = ov;
    }
    asm volatile("" ::: "memory");
    if (hi == 0) LSE[((size_t)p * M + tok) * 8 + h] = (mx + __builtin_amdgcn_logf(l)) * 0.6931471805599453f;
}
constexpr int ATT_KS = 0, ATT_VS = 384 * ATT_VPITCH, ATT_T0 = 2 * 384 * ATT_VPITCH, ATT_T1 = GTAB_OFF;
static_assert(ATT_T0 + 4 * ATT_WAVE_LDS <= LDSCTL_OFF && ATT_T1 + 4 * ATT_WAVE_LDS <= LDS_BYTES, "attention LDS map");
struct AttKV { v4u k[6], v[6], q[4]; };
__device__ __forceinline__ void att_kv_load(AttKV& R, const bf16* proj, int unit0, int tid) {
    asm volatile("" : "+v"(tid));
    const int q128 = unit0 & 127, p = (unit0 >> 7) % 3, bh = unit0 / 384, b = bh >> 3, h = bh & 7;
    const int r = p == 0 ? 1 : (p == 1 ? 4 : 16), gpc = 128 / r, c = q128 / gpc, g0 = q128 % gpc, L = SEQ / r;
    const bf16* base = proj + ((size_t)b * SEQ + c) * NINP + h * 64; const size_t ustride = (size_t)r * NINP;
#pragma unroll
    for (int j = 0; j < 6; ++j) { const int id = tid + 512 * j, ch = id & 7; int uk = 32 * g0 - 64 + (id >> 3); uk = uk < 0 ? 0 : (uk > L - 1 ? L - 1 : uk);
        R.k[j] = *(const v4u*)(base + (size_t)uk * ustride + P_KA + 8 * ch); R.v[j] = *(const v4u*)(base + (size_t)uk * ustride + P_VA + 8 * ch); }
    const int wave = tid >> 6, vrow = (tid >> 3) & 7, vch = tid & 7;
#pragma unroll
    for (int i = 0; i < 4; ++i) R.q[i] = *(const v4u*)(base + (size_t)(32 * (g0 + wave) + vrow + 8 * i) * ustride + P_QA + 8 * vch);
}
__device__ __forceinline__ void att_kv_store(const AttKV& R, LAS unsigned char* lds, int tid) {
    asm volatile("" : "+v"(tid));
#pragma unroll
    for (int j = 0; j < 6; ++j) { const int id = tid + 512 * j, off = (id >> 3) * ATT_VPITCH + (id & 7) * 16;
        *(LAS v4u*)(lds + ATT_KS + off) = R.k[j]; *(LAS v4u*)(lds + ATT_VS + off) = R.v[j]; }
}
__device__ __forceinline__ void attn_unit_sh(const bf16* proj, bf16* OP, float* LSE, LAS unsigned char* lds, LAS unsigned char* vt, int unit, int wave, int lane, AttKV& R, int next_unit0, int tid, const Ptrs& P, int cvp, CvIn& CD, int& cdp) {
    const int q128 = unit & 127, p = (unit >> 7) % 3, bh = unit / 384, b = bh >> 3, h = bh & 7;
    const int r = p == 0 ? 1 : (p == 1 ? 4 : 16), gpc = 128 / r, c = q128 / gpc, g = q128 % gpc, L = SEQ / r, u0 = 32 * g;
    asm volatile("" : "+v"(lane));
    int lq = lane & 31, hi = lane >> 5;
    asm volatile("" : "+v"(lq), "+v"(hi));
    const bf16* base = proj + ((size_t)b * SEQ + c) * NINP + h * 64;
    const size_t ustride = (size_t)r * NINP;
    const int vrow = lane >> 3, vch = lane & 7;
    if (ATT_RIDE == 2 && cdp >= 0) { int ln0 = lane; asm volatile("" : "+v"(ln0)); cv_store(CD, P, cdp, ln0, vt); cdp = -1; }
    asm volatile("" ::: "memory");
    v4u qst[4];
#pragma unroll
    for (int i = 0; i < 4; ++i) qst[i] = R.q[i];
    bf16x8 qf[4];
#pragma unroll
    for (int i = 0; i < 4; ++i) *(LAS v4u*)(vt + (vrow + 8 * i) * ATT_VPITCH + vch * 16) = qst[i];
    asm volatile("" ::: "memory");
#pragma unroll
    for (int d0 = 0; d0 < 4; ++d0) qf[d0] = *(const LAS bf16x8*)(vt + lq * ATT_VPITCH + (16 * d0 + 8 * hi) * 2);
    asm volatile("" ::: "memory");
    CvIn CA;
    if (cvp >= 0) { int ln1 = lane; asm volatile("" : "+v"(ln1)); cv_load(CA, P, cvp, ln1); }
    CvIn CB;
    if (ATT_DUAL && cvp >= 0) { int ln6 = lane; asm volatile("" : "+v"(ln6)); cv_load(CB, P, cvp + 2048, ln6); }
    f32x16 sc[5];
#pragma unroll
    for (int t = 0; t < 5; ++t) {
        const LAS unsigned char* kt = lds + ATT_KS + (32 * wave + 32 * t + lq) * ATT_VPITCH + (8 * hi) * 2;
        f32x16 a = {};
#pragma unroll
        for (int d0 = 0; d0 < 4; ++d0) a = __builtin_amdgcn_mfma_f32_32x32x16_bf16(*(const LAS bf16x8*)(kt + 32 * d0), qf[d0], a, 0, 0, 0);
        sc[t] = a;
    }
    const float slope2 = exp2f(-(float)(h + 1)) * (float)r * 1.4426950408889634f, qs = 0.125f * 1.4426950408889634f;
    const float Df = (float)(4 * hi - lq);
    float mx = -1e30f;
#pragma unroll
    for (int t = 0; t < 5; ++t)
#pragma unroll
        for (int i = 0; i < 16; ++i) {
            const float diff = (float)(32 * t + (i & 3) + 8 * (i >> 2) - 64) + Df;
            float v = fmaf(sc[t][i], qs, -slope2 * fabsf(diff));
            if (t == 0) v = diff >= -64.f ? v : -1e30f;
            if (t == 4) v = diff <= 64.f ? v : -1e30f;
            sc[t][i] = v;
        }
    if (u0 < 64 || u0 + 96 > L) {
#pragma unroll
        for (int t = 0; t < 5; ++t)
#pragma unroll
            for (int i = 0; i < 16; ++i) { const int uk = u0 - 64 + 32 * t + (i & 3) + 8 * (i >> 2) + 4 * hi; if (uk < 0 || uk >= L) sc[t][i] = -1e30f; }
    }
#pragma unroll
    for (int t = 0; t < 5; ++t)
#pragma unroll
        for (int i = 0; i < 16; ++i) mx = fmaxf(mx, sc[t][i]);
    mx = fmaxf(mx, __shfl_xor(mx, 32));
    float l = 0.f;
#pragma unroll
    for (int t = 0; t < 5; ++t)
#pragma unroll
        for (int i = 0; i < 16; ++i) { const float e = __builtin_amdgcn_exp2f(sc[t][i] - mx); sc[t][i] = e; l += e; }
    l += __shfl_xor(l, 32);
    const float il = __builtin_amdgcn_rcpf(l);
    unsigned pf[5][2][4];
#pragma unroll
    for (int t = 0; t < 5; ++t)
#pragma unroll
        for (int s = 0; s < 2; ++s)
#pragma unroll
            for (int w = 0; w < 4; ++w) pf[t][s][w] = cvtpk(sc[t][8 * s + 2 * w], sc[t][8 * s + 2 * w + 1]);
    if (next_unit0 >= 0) att_kv_load(R, proj, next_unit0, tid);
    else {
#pragma unroll
        for (int j = 0; j < 6; ++j) { R.k[j] = (v4u){0u, 0u, 0u, 0u}; R.v[j] = (v4u){0u, 0u, 0u, 0u}; }
#pragma unroll
        for (int j = 0; j < 4; ++j) R.q[j] = (v4u){0u, 0u, 0u, 0u}; }
    asm volatile("" ::: "memory");
    if (cvp >= 0) { { int ln4 = lane; asm volatile("" : "+v"(ln4)); cv_store(CA, P, cvp, ln4, vt); } if (ATT_DUAL) { int ln7 = lane; asm volatile("" : "+v"(ln7)); cv_store(CB, P, cvp + 2048, ln7, vt + 2048); } if (ATT_RIDE == 2) { int ln2 = lane; asm volatile("" : "+v"(ln2)); cv_load(CD, P, cvp + 2048, ln2); cdp = cvp + 2048; } }
    else if (ATT_RIDE == 2) {
#pragma unroll
        for (int i = 0; i < 8; ++i) CD.v[i] = (f32x4){0.f, 0.f, 0.f, 0.f}; }
    f32x16 o0 = {}, o1 = {};
    const int i16 = lane & 15, g16 = (lane >> 4) & 1;
    const LAS unsigned char* trb = lds + ATT_VS + (32 * wave + 4 * hi + (i16 >> 2)) * ATT_VPITCH + (16 * g16 + 4 * (i16 & 3)) * 2;
#pragma unroll
    for (int t = 0; t < 5; ++t) {
#pragma unroll
        for (int s = 0; s < 2; ++s) {
#pragma unroll
            for (int dt = 0; dt < 2; ++dt) {
                const LAS unsigned char* pa = trb + (32 * t + 16 * s) * ATT_VPITCH + dt * 64;
                const v4i16_t lo = __builtin_amdgcn_ds_read_tr16_b64_v4i16((LAS v4i16_t*)pa);
                const v4i16_t hh = __builtin_amdgcn_ds_read_tr16_b64_v4i16((LAS v4i16_t*)(pa + 8 * ATT_VPITCH));
                const bf16x8 vf = (bf16x8){lo[0], lo[1], lo[2], lo[3], hh[0], hh[1], hh[2], hh[3]};
                const v4u pw = (v4u){pf[t][s][0], pf[t][s][1], pf[t][s][2], pf[t][s][3]};
                if (dt == 0) o0 = __builtin_amdgcn_mfma_f32_32x32x16_bf16(vf, __builtin_bit_cast(bf16x8, pw), o0, 0, 0, 0);
                else o1 = __builtin_amdgcn_mfma_f32_32x32x16_bf16(vf, __builtin_bit_cast(bf16x8, pw), o1, 0, 0, 0);
            }
        }
    }
    const size_t tok = (size_t)b * SEQ + (size_t)(u0 + lq) * r + c;
    typedef unsigned u32x2 __attribute__((ext_vector_type(2)));
#pragma unroll
    for (int qd = 0; qd < 4; ++qd) {
        *(LAS u32x2*)(vt + lq * ATT_VPITCH + (4 * hi + 8 * qd) * 2) = (u32x2){cvtpk(o0[4 * qd] * il, o0[4 * qd + 1] * il), cvtpk(o0[4 * qd + 2] * il, o0[4 * qd + 3] * il)};
        *(LAS u32x2*)(vt + lq * ATT_VPITCH + (32 + 4 * hi + 8 * qd) * 2) = (u32x2){cvtpk(o1[4 * qd] * il, o1[4 * qd + 1] * il), cvtpk(o1[4 * qd + 2] * il, o1[4 * qd + 3] * il)};
    }
    asm volatile("" ::: "memory");
#pragma unroll
    for (int i = 0; i < 4; ++i) {
        const v4u ov = *(const LAS v4u*)(vt + (vrow + 8 * i) * ATT_VPITCH + vch * 16);
        *(v4u*)(OP + ((size_t)p * M + (size_t)b * SEQ + (size_t)(u0 + vrow + 8 * i) * r + c) * 512 + h * 64 + 8 * vch) = ov;
    }
    asm volatile("" ::: "memory");
    if (hi == 0) LSE[((size_t)p * M + tok) * 8 + h] = (mx + __builtin_amdgcn_logf(l)) * 0.6931471805599453f;
}
__device__ __forceinline__ void attn_phase(const Ptrs& P, LAS unsigned char* lds, int vcu, int G, int wave, int lane, int i0 = 0, int i1 = 1 << 30, bool ride = false) {
    const bf16* proj = (const bf16*)(P.ws + WS_PROJ); bf16* OP = (bf16*)(P.ws + WS_OP); float* LSE = (float*)(P.ws + WS_LSE);
    const int tid = wave * 64 + lane, NU = BATCH * 8 * 3 * 128;
    LAS unsigned char* vt = lds + (wave < 4 ? ATT_T0 + wave * ATT_WAVE_LDS : ATT_T1 + (wave - 4) * ATT_WAVE_LDS);
    AttKV R; bool have = false; CvIn CD; int cdp = -1;
    for (int i = i0; i < i1; ++i) {
        const int unit0 = (vcu + i * G) * NWAVES; if (unit0 >= NU) break;
        if (!have) att_kv_load(R, proj, unit0, tid);
        asm volatile("s_waitcnt lgkmcnt(0)" ::: "memory"); __builtin_amdgcn_s_barrier(); asm volatile("" ::: "memory");
        att_kv_store(R, lds, tid);
        asm volatile("s_waitcnt lgkmcnt(0)" ::: "memory"); __builtin_amdgcn_s_barrier(); asm volatile("" ::: "memory");
        const int nu0 = (vcu + (i + 1) * G) * NWAVES; have = (i + 1 < i1) && nu0 < NU;
        attn_unit_sh(proj, OP, LSE, lds, vt, unit0 + wave, wave, lane, R, have ? nu0 : -1, tid, P, (ride && G == 256 && i < 6) ? __builtin_amdgcn_readfirstlane(i * ((ATT_RIDE == 2 || ATT_DUAL ? 2 : 1) * 2048) + vcu * 8 + wave) : -1, CD, cdp);
    }
    if (ATT_RIDE == 2 && cdp >= 0) { int ln5 = lane; asm volatile("" : "+v"(ln5)); cv_store(CD, P, cdp, ln5, vt); }
    asm volatile("s_waitcnt lgkmcnt(0)" ::: "memory"); __builtin_amdgcn_s_barrier(); asm volatile("" ::: "memory");
}
__device__ __forceinline__ void merge_attn(const Ptrs& P, int G, int wave, int lane) {
    const bf16* OP = (const bf16*)(P.ws + WS_OP); const float* LSE = (const float*)(P.ws + WS_LSE); bf16* YAB = (bf16*)(P.ws + WS_YAB);
    for (int m = blockIdx.x * NWAVES + wave; m < M; m += G * NWAVES) {
        const int h = lane >> 3;
        const float l0 = LSE[(size_t)m * 8 + h], l1 = LSE[((size_t)M + m) * 8 + h], l2 = LSE[((size_t)2 * M + m) * 8 + h];
        const float mx = fmaxf(l0, fmaxf(l1, l2)), e0 = __expf(l0 - mx), e1 = __expf(l1 - mx), e2 = __expf(l2 - mx), inv = 1.f / (e0 + e1 + e2);
        const float w0 = e0 * inv, w1 = e1 * inv, w2 = e2 * inv;
        const v4u a = *(const v4u*)(OP + (size_t)m * 512 + lane * 8), bb = *(const v4u*)(OP + ((size_t)M + m) * 512 + lane * 8), cc = *(const v4u*)(OP + ((size_t)2 * M + m) * 512 + lane * 8);
        v4u o;
#define MG(x) pk2(w0 * __uint_as_float(a.x << 16) + w1 * __uint_as_float(bb.x << 16) + w2 * __uint_as_float(cc.x << 16), w0 * __uint_as_float(a.x & 0xffff0000u) + w1 * __uint_as_float(bb.x & 0xffff0000u) + w2 * __uint_as_float(cc.x & 0xffff0000u))
        o.x = MG(x); o.y = MG(y); o.z = MG(z); o.w = MG(w);
#undef MG
        *(v4u*)(YAB + (size_t)m * KAB + lane * 8) = o;
    }
}
constexpr int GL_QN = 0, GL_KN = 18432, GL_KT = 36864, GL_VT = 57472;
constexpr int GTS = 2576;
__device__ __forceinline__ constexpr int gl_mat(int d, int which) { return d == 0 ? 78080 + which * 10240 : (which < 2 ? 108800 + which * 10240 : 140800); }
static_assert(GL_VT + 8 * GTS == 78080 && gl_mat(1, 1) + 10240 <= RING_BYTES && GTAB_OFF + 7680 <= 140800 && 140800 + 10240 <= LDS_BYTES, "prep LDS map");
constexpr int GP128 = 288, GP64 = 160;
__device__ __forceinline__ bf16x8 ldfrag(const LAS unsigned char* base, int pitch, int r0, int k0, int lane) { return *(const LAS bf16x8*)(base + (r0 + (lane & 15)) * pitch + (k0 + 8 * (lane >> 4)) * 2); }
typedef unsigned u32x2 __attribute__((ext_vector_type(2)));
#define WG_BAR() do { asm volatile("s_waitcnt lgkmcnt(0)" ::: "memory"); __builtin_amdgcn_s_barrier(); asm volatile("" ::: "memory"); } while (0)
__device__ __forceinline__ float softplusf_(float x) { return x > 20.f ? x : log1pf(__expf(x)); }

__device__ __forceinline__ void st_rowmajor(LAS unsigned char* mat, const f32x4& p, int rb, int c) {
#pragma unroll
    for (int rho = 0; rho < 4; ++rho) *(LAS bf16*)(mat + (rb + rho) * GP64 + c * 2) = (bf16)f2bf(p[rho]);
}
__device__ __forceinline__ void gdn_prep_item(const Ptrs& P, LAS unsigned char* lds, int bh, int n, int cvbase, bool has_next, unsigned (&TCH)[4], int tid, int wave, int lane, int pmode = 0, int cvn = 3) {
    const bool nost = pmode & 1, nold = pmode & 2, junk = pmode & 8;
#define JNK(T, p) (junk ? (T)(P.ws + ((size_t)504 << 20) + ((size_t)((unsigned char*)(p) - P.ws) & (((size_t)64 << 20) - 1))) : (p))
    asm volatile("" : "+v"(tid), "+v"(lane));
    const int b = bh >> 3, h = bh & 7, item = bh * 64 + n; const size_t m0 = (size_t)b * SEQ + n * 64;
    const bf16* proj = (const bf16*)(P.ws + WS_PROJ);
    LAS float* SM = (LAS float*)(lds + ETAB_OFF);
    const LAS float* CW = (const LAS float*)(lds + GTAB_OFF);
    float* EG = (float*)(P.ws + WS_GEG);
    const int rp = tid >> 4, part = tid & 15;
    v4u xn[6];
#pragma unroll
    for (int i = 0; i < 6; ++i) { const int t = n * 64 + 2 * rp + i - 2; xn[i] = (v4u){0u, 0u, 0u, 0u};
        if (t >= 0 && t < SEQ && !nold) xn[i] = *(const v4u*)(proj + ((size_t)b * SEQ + t) * NINP + P_QB + h * 128 + part * 8); }
    asm volatile("" ::: "memory");
    if (wave == 0 && !(pmode & 16)) {
        const bf16* pr = proj + (m0 + lane) * NINP;
        const float gf = -__expf(P.a_log_f[h]) * softplusf_(bf2f(pr[P_AF + h]) + P.dtb_f[h]);
        const float gb = -__expf(P.a_log_b[h]) * softplusf_(bf2f(pr[P_AB + h]) + P.dtb_b[h]);
        float cf = gf, cb = gb;
#pragma unroll
        for (int o = 1; o < 64; o <<= 1) { const float t1 = __shfl_up(cf, o), t2 = __shfl_down(cb, o); if (lane >= o) cf += t1; if (lane + o < 64) cb += t2; }
        SM[lane] = cf; SM[64 + lane] = cb; SM[128 + lane] = 1.f / (1.f + __expf(-bf2f(pr[P_BF + h]))); SM[192 + lane] = 1.f / (1.f + __expf(-bf2f(pr[P_BB + h])));
        const float cfl = __shfl(cf, 63), cb0 = __shfl(cb, 0);
        if (!nost && !junk) { EG[(size_t)item * 64 + lane] = __expf(cf); EG[(size_t)(2048 + item) * 64 + lane] = __expf(cb);
        EG[(size_t)(4096 + item) * 64 + lane] = __expf(cfl - cf); EG[(size_t)(6144 + item) * 64 + lane] = __expf(cb0 - cb); }
    }
    {
        bf16* Qg = (bf16*)(P.ws + WS_GQ);
#pragma unroll
        for (int which = 0; which < 3; ++which) {
            v4u x[6];
#pragma unroll
            for (int i = 0; i < 6; ++i) x[i] = xn[i];
            asm volatile("" ::: "memory");
            if (which < 2) {
#pragma unroll
                for (int i = 0; i < 6; ++i) { const int t = n * 64 + 2 * rp + i - 2; xn[i] = (v4u){0u, 0u, 0u, 0u};
                    if (t >= 0 && t < SEQ && !nold) xn[i] = *(const v4u*)(proj + ((size_t)b * SEQ + t) * NINP + P_QB + (which + 1) * 1024 + h * 128 + part * 8); }
            }
            asm volatile("" ::: "memory");
            float a[2][8];
#pragma unroll
            for (int o = 0; o < 2; ++o)
#pragma unroll
                for (int c = 0; c < 8; ++c) a[o][c] = 0.f;
#pragma unroll
            for (int j = 0; j < 5; ++j) {
                const LAS f32x4* wp = (const LAS f32x4*)(CW + (j * 3 + which) * 128 + part * 8);
                const f32x4 w0 = wp[0], w1 = wp[1];
#pragma unroll
                for (int o = 0; o < 2; ++o) { const v4u xv = x[o + j];
                    a[o][0] += __uint_as_float(xv.x << 16) * w0.x; a[o][1] += __uint_as_float(xv.x & 0xffff0000u) * w0.y; a[o][2] += __uint_as_float(xv.y << 16) * w0.z; a[o][3] += __uint_as_float(xv.y & 0xffff0000u) * w0.w;
                    a[o][4] += __uint_as_float(xv.z << 16) * w1.x; a[o][5] += __uint_as_float(xv.z & 0xffff0000u) * w1.y; a[o][6] += __uint_as_float(xv.w << 16) * w1.z; a[o][7] += __uint_as_float(xv.w & 0xffff0000u) * w1.w; }
            }
#pragma unroll
            for (int o = 0; o < 2; ++o) {
                float ss = 0.f;
#pragma unroll
                for (int c = 0; c < 8; ++c) { a[o][c] = a[o][c] * __builtin_amdgcn_rcpf(1.f + __expf(-a[o][c])); ss += a[o][c] * a[o][c]; }
                if (which < 2) {
                    ss += __shfl_xor(ss, 1); ss += __shfl_xor(ss, 2); ss += __shfl_xor(ss, 4); ss += __shfl_xor(ss, 8);
                    const float rn = rsqrtf(ss + EPS) * (which == 0 ? 0.08838834764831845f : 1.f);
#pragma unroll
                    for (int c = 0; c < 8; ++c) a[o][c] *= rn;
                    v4u ov; ov.x = pk2(a[o][0], a[o][1]); ov.y = pk2(a[o][2], a[o][3]); ov.z = pk2(a[o][4], a[o][5]); ov.w = pk2(a[o][6], a[o][7]);
                    *(LAS v4u*)(lds + (which == 0 ? GL_QN : GL_KN) + (2 * rp + o) * GP128 + part * 16) = ov;
                    if (which == 0 && !nost) *JNK(v4u*, (v4u*)(Qg + (m0 + 2 * rp + o) * 1024 + h * 128 + part * 8)) = ov;
                }
            }
            if (which >= 1) {
                LAS unsigned char* tp = lds + (which == 1 ? GL_KT : GL_VT) + (part >> 1) * GTS + ((part & 1) * 8) * GP64 + (2 * rp) * 2;
#pragma unroll
                for (int c = 0; c < 8; ++c) *(LAS unsigned*)(tp + c * GP64) = pk2(a[0][c], a[1][c]);
            }
        }
    }
    WG_BAR();
    if (has_next && !(pmode & 4)) {
        const bf16* tp_;
        if (tid < 408) { const int row = tid / 6, seg = tid % 6; int t = (n + 1) * 64 + row - 2; t = t < 0 ? 0 : (t > SEQ - 1 ? SEQ - 1 : t);
            tp_ = proj + ((size_t)b * SEQ + t) * NINP + P_QB + (seg >> 1) * 1024 + h * 128 + (seg & 1) * 64; }
        else { const int row = tid < 472 ? tid - 408 : 0; tp_ = proj + ((size_t)b * SEQ + (n + 1) * 64 + row) * NINP + P_AF; }
        asm volatile("global_load_dword %0, %1, off" : "+v"(TCH[0]) : "v"(tp_) : "memory");
    }
    { const int dk = tid >> 2, seg = tid & 3; bf16* KTg = (bf16*)(P.ws + WS_GKT) + (size_t)item * 8192 + dk * 64 + seg * 16;
      const LAS v4u* sp = (const LAS v4u*)(lds + GL_KT + (dk >> 4) * GTS + (dk & 15) * GP64 + seg * 32); if (!nost) { *JNK(v4u*, (v4u*)KTg) = sp[0]; *JNK(v4u*, (v4u*)(KTg + 8)) = sp[1]; } }
    const int q4 = lane >> 4, l16 = lane & 15;
    f32x4 accR[2][2];
#pragma unroll 1
    for (int rep2_ = 0; rep2_ < ((PREP_PROBE & 6) ? 2 : 1); ++rep2_) {
    if (rep2_ == 1) WG_BAR();
#pragma unroll
    for (int x = 0; x < 2; ++x) {
        const int tl = 2 * wave + x, mi = tl >> 2, nj = tl & 3, c = nj * 16 + l16, rb = mi * 16 + 4 * q4;
        f32x4 g = {0.f, 0.f, 0.f, 0.f}, qk = {0.f, 0.f, 0.f, 0.f};
#pragma unroll
        for (int kk = 0; kk < 4; ++kk) {
            const bf16x8 am = ldfrag(lds + GL_KN, GP128, mi * 16, kk * 32, lane), bn = ldfrag(lds + GL_KN, GP128, nj * 16, kk * 32, lane), qn = ldfrag(lds + GL_QN, GP128, nj * 16, kk * 32, lane);
            g = __builtin_amdgcn_mfma_f32_16x16x32_bf16(am, bn, g, 0, 0, 0);
            qk = __builtin_amdgcn_mfma_f32_16x16x32_bf16(am, qn, qk, 0, 0, 0);
        }
#pragma unroll
        for (int d = 0; d < 2; ++d) {
            const float gcc = SM[64 * d + c], bc = SM[128 + 64 * d + c];
            const f32x4 gcr = *(const LAS f32x4*)(SM + 64 * d + rb), br = *(const LAS f32x4*)(SM + 128 + 64 * d + rb);
            float at[4], am2[4], qv[4];
#pragma unroll
            for (int rho = 0; rho < 4; ++rho) {
                const int rr = rb + rho;
                const bool low = d == 0 ? (rr > c) : (rr < c);
                const bool upp = d == 0 ? (c > rr) : (c < rr);
                const float e1 = __expf(fminf(gcr[rho] - gcc, 0.f)), e2 = __expf(fminf(gcc - gcr[rho], 0.f));
                at[rho] = low ? br[rho] * e1 * g[rho] : 0.f;
                am2[rho] = upp ? bc * e2 * g[rho] : 0.f;
                const bool qm = d == 0 ? (rr <= c) : (rr >= c);
                qv[rho] = qm ? e2 * qk[rho] : 0.f;
                accR[d][x][rho] = (rr == c ? 1.f : 0.f) - at[rho];
            }
            *(LAS u32x2*)(lds + gl_mat(d, 1) + c * GP64 + rb * 2) = (u32x2){pk2(at[0], at[1]), pk2(at[2], at[3])};
            *(LAS u32x2*)(lds + gl_mat(d, 0) + c * GP64 + rb * 2) = (u32x2){pk2(am2[0], am2[1]), pk2(am2[2], am2[3])};
            *(LAS u32x2*)(lds + gl_mat(d, 2) + c * GP64 + rb * 2) = (u32x2){pk2((rb == c ? 1.f : 0.f) - am2[0], (rb + 1 == c ? 1.f : 0.f) - am2[1]), pk2((rb + 2 == c ? 1.f : 0.f) - am2[2], (rb + 3 == c ? 1.f : 0.f) - am2[3])};
            bf16* qg = (bf16*)(P.ws + WS_GQK) + ((size_t)(d * 2048 + item) * 64 + c) * 64 + rb;
            if (!nost) *JNK(u32x2*, (u32x2*)qg) = (u32x2){pk2(qv[0], qv[1]), pk2(qv[2], qv[3])};
        }
    }
    WG_BAR();
    if ((PREP_PROBE & 2) && rep2_ == 0) continue;
    const int cvb = (rep2_ == ((PREP_PROBE & 6) ? 1 : 0)) ? cvbase : -1;
    CvIn CV;
#pragma unroll
    for (int j = 0; j < 8; ++j) CV.v[j] = (f32x4){0.f, 0.f, 0.f, 0.f};
    auto stage = [&](const int s) __attribute__((always_inline)) {
        f32x4 accP[2][2];
#pragma unroll
        for (int d = 0; d < 2; ++d) {
#pragma unroll
            for (int x = 0; x < 2; ++x) {
                const int tl = 2 * wave + x, mi = tl >> 2, nj = tl & 3;
                f32x4 p = {0.f, 0.f, 0.f, 0.f}; f32x4 rr = accR[d][x];
                if (d == 0 ? (mi >= nj) : (mi <= nj))
#pragma unroll
                for (int kk = 0; kk < 2; ++kk) {
                    const bf16x8 pm = ldfrag(lds + gl_mat(d, 0), GP64, mi * 16, kk * 32, lane), pt = ldfrag(lds + gl_mat(d, 1), GP64, nj * 16, kk * 32, lane), rm = ldfrag(lds + gl_mat(d, 2), GP64, mi * 16, kk * 32, lane);
                    p = __builtin_amdgcn_mfma_f32_16x16x32_bf16(pm, pt, p, 0, 0, 0);
                    rr = __builtin_amdgcn_mfma_f32_16x16x32_bf16(rm, pt, rr, 0, 0, 0);
                }
                accP[d][x] = p; if (s >= 2) accR[d][x] = rr;
            }
        }
        WG_BAR();
#pragma unroll
        for (int d = 0; d < 2; ++d) {
#pragma unroll
            for (int x = 0; x < 2; ++x) {
                const int tl = 2 * wave + x, mi = tl >> 2, nj = tl & 3, c = nj * 16 + l16, rb = mi * 16 + 4 * q4;
                if (!(d == 0 ? (mi >= nj) : (mi <= nj))) continue;
                if (s < 6) {
                    const f32x4 p = accP[d][x];
                    *(LAS u32x2*)(lds + gl_mat(d, 1) + c * GP64 + rb * 2) = (u32x2){pk2(p[0], p[1]), pk2(p[2], p[3])};
                    st_rowmajor(lds + gl_mat(d, 0), p, rb, c); st_rowmajor(lds + gl_mat(d, 2), accR[d][x], rb, c);
                } else {
                    const float bc = SM[128 + 64 * d + c], bg = bc * __expf(SM[64 * d + c]);
                    st_rowmajor(lds + gl_mat(d, 2), accR[d][x] * bc, rb, c); st_rowmajor(lds + gl_mat(d, 0), accR[d][x] * bg, rb, c);
                }
            }
        }
        WG_BAR();
    };
#pragma unroll 1
    for (int sp = 0; sp < 3; ++sp) {
        if (cvb >= 0 && sp < cvn) cv_load(CV, P, cvb + sp * 2048, lane);
        stage(2 * sp + 1); stage(2 * sp + 2);
        asm volatile("" :: "v"(CV.v[0]), "v"(CV.v[1]), "v"(CV.v[2]), "v"(CV.v[3]), "v"(CV.v[4]), "v"(CV.v[5]), "v"(CV.v[6]), "v"(CV.v[7]));
        if (cvb >= 0 && sp < cvn) cv_store(CV, P, cvb + sp * 2048, lane, lds + GL_QN + wave * 4096);
    }
    }
#pragma unroll 1
    for (int rep3_ = 0; rep3_ < ((PREP_PROBE & 8) ? 2 : 1); ++rep3_)
#pragma unroll
    for (int d = 0; d < 2; ++d) {
        bf16* UTg = (bf16*)(P.ws + WS_GUT) + (size_t)(d * 2048 + item) * 8192; bf16* Wg = (bf16*)(P.ws + WS_GW) + (size_t)(d * 2048 + item) * 8192;
#pragma unroll
        for (int xp = 0; xp < 2; ++xp) {
            unsigned ua[2][2], wa[2][2];
#pragma unroll
            for (int xx = 0; xx < 2; ++xx) {
                const int tl = wave + 8 * (2 * xp + xx);
                { const int mi = tl >> 3, nj = tl & 7;
                  f32x4 u = {0.f, 0.f, 0.f, 0.f};
#pragma unroll
                  for (int kk = 0; kk < 2; ++kk) u = __builtin_amdgcn_mfma_f32_16x16x32_bf16(ldfrag(lds + gl_mat(d, 2), GP64, mi * 16, kk * 32, lane), ldfrag(lds + GL_VT + nj * GTS, GP64, 0, kk * 32, lane), u, 0, 0, 0);
                  ua[xx][0] = pk2(u[0], u[1]); ua[xx][1] = pk2(u[2], u[3]); }
                { const int md = tl >> 2, ni = tl & 3;
                  f32x4 w = {0.f, 0.f, 0.f, 0.f};
#pragma unroll
                  for (int kk = 0; kk < 2; ++kk) w = __builtin_amdgcn_mfma_f32_16x16x32_bf16(ldfrag(lds + GL_KT + md * GTS, GP64, 0, kk * 32, lane), ldfrag(lds + gl_mat(d, 0), GP64, ni * 16, kk * 32, lane), w, 0, 0, 0);
                  wa[xx][0] = pk2(w[0], w[1]); wa[xx][1] = pk2(w[2], w[3]); }
            }
            const int odd = q4 & 1, p8 = q4 >> 1, tls = wave + 8 * (2 * xp + odd);
            { const auto r0 = __builtin_amdgcn_permlane16_swap(ua[0][0], ua[1][0], false, false), r1 = __builtin_amdgcn_permlane16_swap(ua[0][1], ua[1][1], false, false);
              const int mi = tls >> 3, nj = tls & 7;
              if (!nost) *JNK(v4u*, (v4u*)(UTg + (nj * 16 + l16) * 64 + mi * 16 + 8 * p8)) = (v4u){r0[0], r1[0], r0[1], r1[1]}; }
            { const auto r0 = __builtin_amdgcn_permlane16_swap(wa[0][0], wa[1][0], false, false), r1 = __builtin_amdgcn_permlane16_swap(wa[0][1], wa[1][1], false, false);
              const int md = tls >> 2, ni = tls & 3;
              if (!nost) *JNK(v4u*, (v4u*)(Wg + (ni * 16 + l16) * 128 + md * 16 + 8 * p8)) = (v4u){r0[0], r1[0], r0[1], r1[1]}; }
        }
    }
    WG_BAR();
}
__device__ __forceinline__ void gdn_prep_phase(const Ptrs& P, LAS unsigned char* lds, int vcu, int G, int tid, int wave, int lane, bool ride = true, int pmode = 0) {
    unsigned TCH[4] = {0u, 0u, 0u, 0u};
    for (int it = vcu * 8; it < 2048; it += G * 8) {
        const int bh = it >> 6;
        LAS float* CW = (LAS float*)(lds + GTAB_OFF); const int h = bh & 7;
        __syncthreads();
        for (int i = tid; i < 5 * 3 * 128; i += 512) { const int j = i / 384, rem = i % 384, which = rem >> 7, ch = rem & 127; CW[i] = P.conv_w[j * 3072 + which * 1024 + h * 128 + ch]; }
        WG_BAR();
        for (int k = 0; k < 8; ++k) gdn_prep_item(P, lds, bh, (it & 63) + k, (G == 256 && ride) ? ((ATT_RIDE == 2 || ATT_DUAL) ? (12 + (k < 4 ? 2 * k : 4 + k)) * 2048 + vcu * 8 + wave : ATT_RIDE == 1 ? (6 + (k < 3 ? 2 * k : k == 3 ? 6 : k == 4 ? 9 : 2 * k + 2)) * 2048 + vcu * 8 + wave : k * 3 * 2048 + vcu * 8 + wave) : -1, k < 7, TCH, tid, wave, lane, pmode, (ATT_RIDE == 2 || ATT_DUAL) ? (k < 4 ? 2 : 1) : ATT_RIDE == 1 ? ((k == 3 || k == 4) ? 3 : 2) : 3);
    }
    asm volatile("s_waitcnt vmcnt(0)" : "+v"(TCH[0]), "+v"(TCH[1]), "+v"(TCH[2]), "+v"(TCH[3]) :: "memory");
}

template <int MODE>
__device__ __forceinline__ void store_probe(const Ptrs& P, int vcu, int wave, int lane) {
    unsigned char* junk = P.ws + ((size_t)504 << 20);
    const int q4 = lane >> 4, l16 = lane & 15;
    v4u val = {(unsigned)lane, 1u, 2u, 3u};
#pragma unroll 1
    for (int rep = 0; rep < 4; ++rep)
#pragma unroll 1
    for (int k = 0; k < 8; ++k) {
        const size_t ibase = (((size_t)((rep * 8 + k) * 256 + vcu)) * 65536) & (((size_t)64 << 20) - 1);
        asm volatile("" : "+v"(val));
        if (MODE == 1) {
#pragma unroll
            for (int j = 0; j < 8; ++j) { const int jj = (wave * 8 + j) >> 1; *(v4u*)(junk + ibase + (size_t)(jj * 16 + l16) * 128 + (j & 1) * 64 + q4 * 16) = val; }
        } else if (MODE == 2) {
#pragma unroll
            for (int j = 0; j < 8; ++j) *(v4u*)(junk + ibase + (size_t)((wave * 8 + j) * 8 + (lane >> 3)) * 128 + (lane & 7) * 16) = val;
        } else if (MODE == 3) {
#pragma unroll
            for (int j = 0; j < 16; ++j) { const int jj = (wave * 16 + j) >> 2; *(u32x2*)(junk + ibase + (size_t)(jj * 16 + l16) * 128 + (j & 3) * 32 + q4 * 8) = (u32x2){val.x, val.y}; }
        } else if (MODE == 5) {
#pragma unroll
            for (int j = 0; j < 8; ++j) { const int jj = (wave * 8 + j) >> 1; *(v4u*)(junk + ibase + (size_t)(jj * 16 + (lane >> 2)) * 128 + (j & 1) * 64 + (lane & 3) * 16) = val; }
        } else if (MODE == 6) {
#pragma unroll
            for (int j = 0; j < 8; ++j) *(v4u*)(junk + ((ibase * 64) & (((size_t)64 << 20) - 1)) + (size_t)l16 * 4096 + (size_t)(wave * 8 + j) * 64 + q4 * 16) = val;
        } else if (MODE == 7) {
#pragma unroll
            for (int j = 0; j < 8; ++j) *(v4u*)(junk + ((ibase * 64) & (((size_t)64 << 20) - 1)) + (size_t)(lane >> 2) * 4096 + (size_t)(wave * 8 + j) * 64 + (lane & 3) * 16) = val;
        } else if (MODE == 4) {
#pragma unroll
            for (int j = 0; j < 8; ++j) { const int row = (wave * 4 + (j >> 1)) * 32 + (lane & 31); *(v4u*)(junk + ((ibase * 4) & (((size_t)64 << 20) - 1)) + (size_t)row * 2048 / 8 * 8 + (lane >> 5) * 32 + (j & 1) * 16) = val; }
        }
    }
}
constexpr int SC_SLOT = 62464, SC_W = 0, SC_Q = 16384, SC_KT = 32768, SC_QK = 49152, SC_UT = 57344, SC_EG = 61440;
constexpr int SL_ST = GTAB_OFF, SL_VN = SL_ST + 32 * GP128, SL_VS = SL_VN + 32 * GP64;
constexpr int SL_OB = SL_VS + 32 * GP64;
static_assert(2 * SC_SLOT + 3 * 2048 <= RING_BYTES && SL_OB + 4096 + 3 * 2048 <= LDS_BYTES && SL_OB % 16 == 0, "scan LDS map");
#define SC_GLDS(src, dst) __builtin_amdgcn_global_load_lds((const unsigned*)(src), (LAS unsigned*)(dst), 16, 0, 0)
__device__ __forceinline__ void scan_issue(const Ptrs& P, LAS unsigned char* lds, int slot, int bh, int d, int sl, int n, int wave, int lane) {
    if (wave >= 7) return;
    const int item = bh * 64 + n, b = bh >> 3, h = bh & 7;
    const char* Wb = (const char*)(P.ws + WS_GW) + ((size_t)(d * 2048 + item) * 8192) * 2;
    const char* Qb = (const char*)(P.ws + WS_GQ) + (((size_t)b * SEQ + n * 64) * 1024 + h * 128) * 2;
    const char* KTb = (const char*)(P.ws + WS_GKT) + ((size_t)item * 8192) * 2;
    const char* QKb = (const char*)(P.ws + WS_GQK) + ((size_t)(d * 2048 + item) * 4096) * 2;
    const char* UTb = (const char*)(P.ws + WS_GUT) + ((size_t)(d * 2048 + item) * 8192 + (sl * 32) * 64) * 2;
    LAS unsigned char* sb = lds + slot * SC_SLOT;
    const int r4 = lane >> 4, s16 = lane & 15, r8 = lane >> 3, s8 = lane & 7;
#pragma unroll
    for (int i = 0; i < 9; ++i) {
        const int pc = wave + 7 * i;
        if (pc < 32) {
            const int pp = pc & 15, row = pp * 4 + r4, c = (s16 - row) & 15;
            if (pc < 16) SC_GLDS(Wb + row * 256 + c * 16, sb + SC_W + pp * 1024); else SC_GLDS(Qb + (size_t)row * 2048 + c * 16, sb + SC_Q + pp * 1024);
        } else if (pc < 60) {
            const int pp = pc < 48 ? pc - 32 : (pc < 56 ? pc - 48 : pc - 56), row = pp * 8 + r8, c = (s8 - (row >> 1)) & 7;
            const char* src = (pc < 48 ? KTb : (pc < 56 ? QKb : UTb)) + row * 128 + c * 16;
            SC_GLDS(src, sb + (pc < 48 ? SC_KT : (pc < 56 ? SC_QK : SC_UT)) + pp * 1024);
        } else if (pc == 60) { const char* EGb = (const char*)(P.ws + WS_GEG) + ((size_t)((lane & 16 ? 2 + d : d) * 2048 + item) * 64) * 4 + (lane & 15) * 16; SC_GLDS(EGb, sb + SC_EG); }
    }
}
__device__ __forceinline__ bf16x8 frag256(const LAS unsigned char* t, int row, int c) { return *(const LAS bf16x8*)(t + row * 256 + (((c + row) & 15) << 4)); }
__device__ __forceinline__ bf16x8 frag128(const LAS unsigned char* t, int row, int c) { return *(const LAS bf16x8*)(t + row * 128 + (((c + (row >> 1)) & 7) << 4)); }
template <int VAR> __device__ __forceinline__ void scan_step(f32x4 (&accS)[2], f32x4& opend, const Ptrs& P, LAS unsigned char* lds, int slot, int d, int wave, int lane, bool cvl = false) {
    const int mi = wave >> 1, nj = wave & 1, l16 = lane & 15, q4 = lane >> 4;
    const LAS unsigned char* sb = lds + slot * SC_SLOT;
    const f32x4 r_eg = *(const LAS f32x4*)(sb + SC_EG + (mi * 16 + 4 * q4) * 4), r_ek = *(const LAS f32x4*)(sb + SC_EG + 256 + (mi * 16 + 4 * q4) * 4); const float r_gl = *(const LAS float*)(sb + SC_EG + (d == 0 ? 63 : 0) * 4);
    f32x4 x = {0.f, 0.f, 0.f, 0.f}, oa = {0.f, 0.f, 0.f, 0.f};
#pragma unroll
    for (int kk = 0; kk < 4; ++kk) { const bf16x8 bs = ldfrag(lds + SL_ST, GP128, nj * 16, kk * 32, lane);
        x = __builtin_amdgcn_mfma_f32_16x16x32_bf16(frag256(sb + SC_W, mi * 16 + l16, kk * 4 + q4), bs, x, 0, 0, 0);
        oa = __builtin_amdgcn_mfma_f32_16x16x32_bf16(frag256(sb + SC_Q, mi * 16 + l16, kk * 4 + q4), bs, oa, 0, 0, 0); }
    const int ur = nj * 16 + l16;
    const u32x2 u = *(const LAS u32x2*)(sb + SC_UT + ur * 128 + (((mi * 2 + (q4 >> 1) + (ur >> 1)) & 7) << 4) + (q4 & 1) * 8);
    f32x4 vn; vn[0] = __uint_as_float(u.x << 16) - x[0]; vn[1] = __uint_as_float(u.x & 0xffff0000u) - x[1]; vn[2] = __uint_as_float(u.y << 16) - x[2]; vn[3] = __uint_as_float(u.y & 0xffff0000u) - x[3];
    const int vo = (nj * 16 + l16) * GP64 + (mi * 16 + 4 * q4) * 2;
    *(LAS u32x2*)(lds + SL_VN + vo) = (u32x2){pk2(vn[0], vn[1]), pk2(vn[2], vn[3])};
    *(LAS u32x2*)(lds + SL_VS + vo) = (u32x2){pk2(vn[0] * r_ek[0], vn[1] * r_ek[1]), pk2(vn[2] * r_ek[2], vn[3] * r_ek[3])};
    WG_BAR();
    f32x4 o = oa * r_eg;
#pragma unroll
    for (int kk = 0; kk < 2; ++kk) o = __builtin_amdgcn_mfma_f32_16x16x32_bf16(frag128(sb + SC_QK, mi * 16 + l16, kk * 4 + q4), ldfrag(lds + SL_VN, GP64, nj * 16, kk * 32, lane), o, 0, 0, 0);
#pragma unroll
    for (int rho = 0; rho < 4; ++rho) *(LAS bf16*)(lds + SL_OB + (mi * 16 + 4 * q4 + rho) * 64 + ((((nj * 16 + l16) >> 3) ^ q4) << 4) + (l16 & 7) * 2) = (bf16)f2bf(o[rho]);
    opend = o;
#pragma unroll
    for (int n2 = 0; n2 < 2; ++n2) {
        f32x4 s = accS[n2] * r_gl;
#pragma unroll
        for (int kk = 0; kk < 2; ++kk) s = __builtin_amdgcn_mfma_f32_16x16x32_bf16(frag128(sb + SC_KT, wave * 16 + l16, kk * 4 + q4), ldfrag(lds + SL_VS, GP64, n2 * 16, kk * 32, lane), s, 0, 0, 0);
        accS[n2] = s;
        *(LAS u32x2*)(lds + SL_ST + (n2 * 16 + l16) * GP128 + (wave * 16 + 4 * q4) * 2) = (u32x2){pk2(s[0], s[1]), pk2(s[2], s[3])};
    }
    if (wave < 7) { if (cvl) asm volatile("s_waitcnt vmcnt(8)" ::: "memory"); else asm volatile("s_waitcnt vmcnt(0)" ::: "memory"); }
    WG_BAR();
}
template <int VAR> __device__ __forceinline__ void scan_store(const f32x4& o, const Ptrs& P, LAS unsigned char* lds, int bh, int d, int sl, int n, int wave, int lane) {
    if constexpr (!(VAR & 2)) {
        if (wave == 7) {
            const int b = bh >> 3, h = bh & 7;
            bf16* Og = (bf16*)(P.ws + ((VAR & 4) ? WS_MERGED : (d == 0 ? WS_OF : WS_OB))) + ((size_t)b * SEQ + n * 64) * 1024 + h * 128 + sl * 32;
#pragma unroll
            for (int j = 0; j < 4; ++j) { const int row = 16 * j + (lane >> 2), c = lane & 3;
                const v4u dv = *(const LAS v4u*)(lds + SL_OB + row * 64 + ((c ^ ((row >> 2) & 3)) << 4));
                *(v4u*)(Og + (size_t)row * 1024 + c * 8) = dv; }
        }
    }
}
__device__ __forceinline__ const char* scan_touch(const Ptrs& P, int bh, int d, int sl, int n, int j, int lane) {
    const int item = bh * 64 + n, b = bh >> 3, h = bh & 7;
    int id = j * 64 + lane; id = id < 144 ? id : 143;
    const char* p;
    if (id < 112) { const int L = 4 * id + sl;
        if (L < 128) p = (const char*)(P.ws + WS_GW) + ((size_t)(d * 2048 + item) * 8192) * 2 + L * 128;
        else if (L < 256) p = (const char*)(P.ws + WS_GKT) + ((size_t)item * 8192) * 2 + (L - 128) * 128;
        else if (L < 320) p = (const char*)(P.ws + WS_GQK) + ((size_t)(d * 2048 + item) * 4096) * 2 + (L - 256) * 128;
        else { const int idx = L - 320; p = (const char*)(P.ws + WS_GQ) + (((size_t)b * SEQ + n * 64 + (idx >> 1)) * 1024 + h * 128) * 2 + (idx & 1) * 128; }
    } else p = (const char*)(P.ws + WS_GUT) + ((size_t)(d * 2048 + item) * 8192 + (sl * 32) * 64) * 2 + (id - 112) * 128;
    return p;
}
template <int VAR> __device__ __forceinline__ void gdn_scan_phase(const Ptrs& P, LAS unsigned char* lds, int vcu, int G, int tid, int wave, int lane) {
    for (int wk = vcu; wk < 256; wk += G) {
        const int sl = wk & 3, d = (wk >> 2) & 1, bh = wk >> 3;
        __syncthreads();
        for (int i = tid; i < 32 * GP128 / 4; i += 512) ((LAS unsigned*)(lds + SL_ST))[i] = 0u;
        f32x4 accS[2] = {{0.f, 0.f, 0.f, 0.f}, {0.f, 0.f, 0.f, 0.f}};
        f32x4 opend = {0.f, 0.f, 0.f, 0.f};
#define SCN(s) (d == 0 ? (s) : 63 - (s))
#define SCT(s) ((s) + 4 < 64 ? (s) + 4 : 63)
#define TOUCH_LD(T, n_) do { if (wave == 7) { _Pragma("unroll") for (int j_ = 0; j_ < 3; ++j_) { const char* tp_ = scan_touch(P, bh, d, sl, (n_), j_, lane); asm volatile("global_load_dword %0, %1, off" : "+v"(T[j_]) : "v"(tp_) : "memory"); } } } while (0)
        unsigned T0[3] = {0u, 0u, 0u}, T1[3] = {0u, 0u, 0u}, T2[3] = {0u, 0u, 0u}, T3[3] = {0u, 0u, 0u};
        TOUCH_LD(T0, SCN(1)); TOUCH_LD(T1, SCN(2)); TOUCH_LD(T2, SCN(3));
        scan_issue(P, lds, 0, bh, d, sl, SCN(0), wave, lane);
        asm volatile("s_waitcnt vmcnt(0)" ::: "memory"); WG_BAR();
        const bool cvon = SCAN_RIDE && G == 256 && wave < 6;
        LAS unsigned char* cvbuf = lds + (wave < 3 ? 2 * SC_SLOT + wave * 2048 : SL_OB + 4096 + (wave < 6 ? wave - 3 : 0) * 2048);
        CvIn CV;
#define CVQ_VALID(q) (cvon && (q) >= 0 && (q) < 24)
#define CVQ_P(q) (12288 + (q) * 1536 + vcu * 6 + wave)
#define SC_STEP(s, T, EV) do { if ((s) > 0) scan_store<VAR>(opend, P, lds, bh, d, sl, SCN((s) - 1), wave, lane); \
            if (EV) { const int qp_ = ((s) >> 1) - 1; if (CVQ_VALID(qp_)) cv_store(CV, P, CVQ_P(qp_), lane, cvbuf); } \
            if (!(VAR & 1)) scan_issue(P, lds, ((s) + 1) & 1, bh, d, sl, SCN((s) + 1 < 64 ? (s) + 1 : 63), wave, lane); \
            bool cvl_ = false; if (EV) { const int q_ = (s) >> 1; if (CVQ_VALID(q_)) { cv_load(CV, P, CVQ_P(q_), lane); cvl_ = true; } } \
            asm volatile("" ::: "memory"); TOUCH_LD(T, SCN(SCT(s))); \
            scan_step<VAR>(accS, opend, P, lds, (s) & 1, d, wave, lane, cvl_); } while (0)
#pragma unroll 1
        for (int st = 0; st < 64; st += 4) { SC_STEP(st, T3, 1); SC_STEP(st + 1, T0, 0); SC_STEP(st + 2, T1, 1); SC_STEP(st + 3, T2, 0); }
        scan_store<VAR>(opend, P, lds, bh, d, sl, SCN(63), wave, lane);
        asm volatile("s_waitcnt vmcnt(0)" : "+v"(T0[0]), "+v"(T0[1]), "+v"(T0[2]), "+v"(T1[0]), "+v"(T1[1]), "+v"(T1[2]), "+v"(T2[0]), "+v"(T2[1]), "+v"(T2[2]), "+v"(T3[0]), "+v"(T3[1]), "+v"(T3[2]) :: "memory"); asm volatile("" :: "v"(accS[0]), "v"(accS[1]));
#undef SC_STEP
#undef CVQ_VALID
#undef CVQ_P
#undef TOUCH_LD
#undef SCT
#undef SCN
    }
}
__device__ __forceinline__ void gdn_out_phase(const Ptrs& P, int G, int wave, int lane) {
    const bf16* OF = (const bf16*)(P.ws + WS_OF); const bf16* OB = (const bf16*)(P.ws + WS_OB); const bf16* proj = (const bf16*)(P.ws + WS_PROJ); bf16* YAB = (bf16*)(P.ws + WS_YAB);
    float nw[16];
#pragma unroll
    for (int c = 0; c < 16; ++c) nw[c] = P.gdn_nw[(lane & 7) * 16 + c];
    for (int m = blockIdx.x * NWAVES + wave; m < M; m += G * NWAVES) {
        const v4u a0 = *(const v4u*)(OF + (size_t)m * 1024 + lane * 16), a1 = *(const v4u*)(OF + (size_t)m * 1024 + lane * 16 + 8);
        const v4u b0 = *(const v4u*)(OB + (size_t)m * 1024 + lane * 16), b1 = *(const v4u*)(OB + (size_t)m * 1024 + lane * 16 + 8);
        const v4u z0 = *(const v4u*)(proj + (size_t)m * NINP + P_ZB + lane * 16), z1 = *(const v4u*)(proj + (size_t)m * NINP + P_ZB + lane * 16 + 8);
        float v[16], z[16];
#define UNP(dst, s0, s1, op, t0, t1) dst[0] op (__uint_as_float(s0.x << 16) + __uint_as_float(t0.x << 16)); dst[1] op (__uint_as_float(s0.x & 0xffff0000u) + __uint_as_float(t0.x & 0xffff0000u)); \
        dst[2] op (__uint_as_float(s0.y << 16) + __uint_as_float(t0.y << 16)); dst[3] op (__uint_as_float(s0.y & 0xffff0000u) + __uint_as_float(t0.y & 0xffff0000u)); \
        dst[4] op (__uint_as_float(s0.z << 16) + __uint_as_float(t0.z << 16)); dst[5] op (__uint_as_float(s0.z & 0xffff0000u) + __uint_as_float(t0.z & 0xffff0000u)); \
        dst[6] op (__uint_as_float(s0.w << 16) + __uint_as_float(t0.w << 16)); dst[7] op (__uint_as_float(s0.w & 0xffff0000u) + __uint_as_float(t0.w & 0xffff0000u)); \
        dst[8] op (__uint_as_float(s1.x << 16) + __uint_as_float(t1.x << 16)); dst[9] op (__uint_as_float(s1.x & 0xffff0000u) + __uint_as_float(t1.x & 0xffff0000u)); \
        dst[10] op (__uint_as_float(s1.y << 16) + __uint_as_float(t1.y << 16)); dst[11] op (__uint_as_float(s1.y & 0xffff0000u) + __uint_as_float(t1.y & 0xffff0000u)); \
        dst[12] op (__uint_as_float(s1.z << 16) + __uint_as_float(t1.z << 16)); dst[13] op (__uint_as_float(s1.z & 0xffff0000u) + __uint_as_float(t1.z & 0xffff0000u)); \
        dst[14] op (__uint_as_float(s1.w << 16) + __uint_as_float(t1.w << 16)); dst[15] op (__uint_as_float(s1.w & 0xffff0000u) + __uint_as_float(t1.w & 0xffff0000u));
        const v4u zz = {0u, 0u, 0u, 0u};
        UNP(v, a0, a1, =, b0, b1)
        UNP(z, z0, z1, =, zz, zz)
#undef UNP
        float ss = 0.f;
#pragma unroll
        for (int c = 0; c < 16; ++c) ss += v[c] * v[c];
        ss += __shfl_xor(ss, 1); ss += __shfl_xor(ss, 2); ss += __shfl_xor(ss, 4);
        const float r = rsqrtf(ss * (1.f / 128.f) + EPS);
        float o[16];
#pragma unroll
        for (int c = 0; c < 16; ++c) o[c] = v[c] * r * nw[c] * z[c] * __builtin_amdgcn_rcpf(1.f + __expf(-z[c]));
        v4u o0, o1;
        o0.x = pk2(o[0], o[1]); o0.y = pk2(o[2], o[3]); o0.z = pk2(o[4], o[5]); o0.w = pk2(o[6], o[7]); o1.x = pk2(o[8], o[9]); o1.y = pk2(o[10], o[11]); o1.z = pk2(o[12], o[13]); o1.w = pk2(o[14], o[15]);
        *(v4u*)(YAB + (size_t)m * KAB + 512 + lane * 16) = o0; *(v4u*)(YAB + (size_t)m * KAB + 512 + lane * 16 + 8) = o1;
    }
}
__device__ __forceinline__ void stagger_short(int nunits, int G, int c, int d0, int d1) {
    const int rem = nunits % G;
    if (rem != 0 && c >= rem) { const int n = d0 + ((c - rem) * d1) / (G - rem); for (int i = 0; i < n; ++i) __builtin_amdgcn_s_sleep(32); }
}
__global__ void __launch_bounds__(NWAVES * 64, 2) mega_fwd(Args args) {
    extern __shared__ __attribute__((aligned(16))) unsigned char lds_raw[];
    LAS unsigned char* lds = (LAS unsigned char*)lds_raw;
    const Ptrs& P = args.p;
    const int tid = threadIdx.x, lane = tid & 63, wave = __builtin_amdgcn_readfirstlane(tid >> 6);
    const int G = gridDim.x; const int bx = blockIdx.x; const int vcu = (G % 8 == 0) ? (bx % 8) * (G / 8) + bx / 8 : bx;
    gu32* ctl = (gu32*)(P.ws + WS_CTL);
    for (int u = tid; u < (GTAB_OFF - LDSCTL_OFF) / 4; u += NWAVES * 64) ((LAS unsigned*)(lds + LDSCTL_OFF))[u] = 0u;
    __syncthreads();
    XcdBarrier bar = xcd_barrier_post((unsigned*)(ctl + CW_BAR) + args.li * XCD_BAR_WORDS, (volatile LAS unsigned*)(lds + MISC_OFF) + 8);
    const int lo = args.ph_lo, hi = args.ph_hi;
#ifndef PH_MASK
#define PH_MASK 0xffff
#endif
#define IN(k) (((PH_MASK >> (k)) & 1) && lo <= (k) && (k) < hi)
#define BOTH(k) (IN(k) && IN((k) + 1))
#ifndef PH_TWICE
#define PH_TWICE 0
#endif
#define REP(k) for (int rep_ = 0; rep_ < (((PH_TWICE >> (k)) & 1) ? 2 : 1); ++rep_)
#ifndef PH_AGAIN
#define PH_AGAIN 0
#endif
#define AGAIN(k) if ((PH_AGAIN >> (k)) & 1)
    LAS unsigned* gtab = (LAS unsigned*)(lds + GTAB_OFF);
    LAS int* etab = (LAS int*)(lds + ETAB_OFF);

    if (IN(0)) { REP(0) p0_prologue(P, lds, vcu, G, wave, lane); if (BOTH(0)) xcd_barrier(bar); }
#if BAR_PROBE
    for (int i_ = 0; i_ < 16; ++i_) xcd_barrier(bar);
#endif

    if (IN(1)) {
#if P1_FP8
        pg8::DenseOrderG S; S.K = 512;
#else
        pg8::DenseOrder S;
#endif
        S.so.init(M, NINP, G, bx); S.A = (const char*)(P.ws + WS_XN); S.Bt = (const char*)(P.ws + WS_WIN); S.tstep = (size_t)256 * 1024 * (P1_FP8 ? 1 : 2);
        pg8::EpiBf16<0> E{(pg8::bf16_t*)(P.ws + WS_PROJ), NINP, nullptr, 0, 0, 1.f, lds + EPISCR_OFF, 1.0f};
        stagger_short(1984, G, bx, P1_DLY0, P1_DLY1);
#if P1_FP8
        pg8::gemm_phase<pg8::EpiBf16<0>, pg8::DenseOrderG, true, true, 2, 0x76767676, 0x7a7a7a7a>(lds + RING_OFF, 512, S, E, gtab);
#else
        pg8::gemm_phase<pg8::EpiBf16<0>, pg8::DenseOrder, true, true>(lds + RING_OFF, 1024, S, E, gtab);
#endif
#if !P1_FP8
        AGAIN(1) pg8::gemm_phase<pg8::EpiBf16<0>, pg8::DenseOrder, true, true>(lds + RING_OFF, 1024, S, E, gtab);
#endif
        if (BOTH(1)) xcd_barrier(bar);
    }
    if (IN(2)) {
        const int pre_ = vcu % 6;
#pragma unroll 1
        for (int part_ = 0; part_ < 2; ++part_) {
            attn_phase(P, lds, vcu, G, wave, lane, part_ == 0 ? 0 : pre_, part_ == 0 ? pre_ : 1 << 30, ATT_RIDE && !RIDE_OFF);
            if (part_ == 0) gdn_prep_phase(P, lds, vcu, G, tid, wave, lane, !SCAN_RIDE && !RIDE_OFF);
        }
#if STORE_PROBE
        store_probe<STORE_PROBE>(P, vcu, wave, lane);
#endif
        AGAIN(12) gdn_prep_phase(P, lds, vcu, G, tid, wave, lane, !((PH_AGAIN >> 13) & 1), PMODE); if (BOTH(2)) xcd_barrier(bar); }
    #ifndef SCAN_PROBE
#define SCAN_PROBE 0
#endif
    if (IN(3)) {
#if SCAN_STAG
        for (int i_ = 0; i_ < (vcu & 3); ++i_) __builtin_amdgcn_s_sleep(SCAN_STAG);
#endif
        gdn_scan_phase<0>(P, lds, vcu, G, tid, wave, lane); AGAIN(3) gdn_scan_phase<0>(P, lds, vcu, G, tid, wave, lane); if (SCAN_PROBE) { if (!(SCAN_HALF && (vcu & 1))) gdn_scan_phase<SCAN_PROBE>(P, lds, vcu, G, tid, wave, lane); } if (BOTH(3)) xcd_barrier(bar); }
    if (IN(4)) { REP(4) { merge_attn(P, G, wave, lane); gdn_out_phase(P, G, wave, lane); } if (BOTH(4)) xcd_barrier(bar); }

    if (IN(5)) {
        pg8::DenseOrder S; S.so.init(M, 1024, G, bx); S.A = (const char*)(P.ws + WS_YAB); S.Bt = (const char*)(P.ws + WS_WAB); S.tstep = (size_t)256 * KAB * 2;
        pg8::EpiMerged E{(const pg8::bf16_t*)(P.ws + WS_PROJ), (pg8::bf16_t*)(P.ws + WS_MERGED), NINP, P_GA, P_GB, lds + EPISCR_OFF};
        pg8::gemm_phase<pg8::EpiMerged, pg8::DenseOrder, true, true>(lds + RING_OFF, KAB, S, E, gtab);
        AGAIN(5) pg8::gemm_phase<pg8::EpiMerged, pg8::DenseOrder, true, true>(lds + RING_OFF, KAB, S, E, gtab);
        if (BOTH(5)) xcd_barrier(bar);
    }
    if (IN(6)) {
        pg8::DenseOrder S; S.so.init(M, 1024, G, bx); S.A = (const char*)(P.ws + WS_MERGED); S.Bt = (const char*)(P.ws + WS_WOUT); S.tstep = (size_t)256 * 1024 * 2;
        pg8::EpiResid E{P.x, P.out, lds + EPISCR_OFF};
        pg8::gemm_phase<pg8::EpiResid, pg8::DenseOrder, true, true>(lds + RING_OFF, 1024, S, E, gtab);
        AGAIN(6) pg8::gemm_phase<pg8::EpiResid, pg8::DenseOrder, true, true>(lds + RING_OFF, 1024, S, E, gtab);
        if (BOTH(6)) xcd_barrier(bar);
    }
    if (IN(7)) { p7_router<0>(P, lds, G, tid, wave, lane); AGAIN(7) { __syncthreads(); p7_router<1>(P, lds, G, tid, wave, lane); } if (BOTH(7)) xcd_barrier(bar); }
    if (IN(8)) {
        build_etab((const unsigned*)(ctl + CW_CNT), etab, tid);
        pg8::MoeOrder<8, true> S; S.etab = etab; S.G = G; S.c = vcu;     S.K = 512  ; S.A = (const char*)(P.ws + WS_XN); S.W = (const char*)(P.ws + WS_WGU); S.wstride = (size_t)2048 * 1024; S.list = (const int*)(P.ws + WS_LIST);
        LAS float* etb = (LAS float*)(lds + EPITAB_OFF);
        { pg8::MUnit tu[9]; bool tok[9]; float tv[9];
#pragma unroll
          for (int q = 0; q < 9; ++q) tok[q] = S.next(q, tu[q]);
#pragma unroll
          for (int q = 0; q < 9; ++q) tv[q] = (tok[q] && tid < 256) ? P.b_gu[(size_t)tu[q].e * 2048 + (tid < 128 ? tu[q].pn * 128 + tid : 1024 + tu[q].pn * 128 + tid - 128)] : 0.f;
#pragma unroll
          for (int q = 0; q < 9; ++q) if (tok[q] && tid < 256) etb[q * 256 + tid] = tv[q];
          LDS_WAIT(); __syncthreads(); }
        pg8::EpiSwiglu E{P.ws + WS_ACT, P.b_gu, lds + EPISCR_OFF, P8_FP8 == 2 ? 1.0f : 1.0f / (F8_SA * F8_SW), etb};
        if (MOE_HANDOFF) S.rdy = (unsigned*)(P.ws + WS_CTL) + CW_RDY;
        REP(8) pg8::gemm_phase<pg8::EpiSwiglu, pg8::MoeOrder<8, true>, true, true, P8_FP8, 0x76767676, 0x7a7a7a7a>(lds + RING_OFF, 512, S, E, gtab);
        S.flush();
        if (BOTH(8) && !MOE_HANDOFF) xcd_barrier(bar);
    }
    if (IN(9)) {
        build_etab((const unsigned*)(ctl + CW_CNT), etab, tid);
        pg8::MoeOrder<4, true, true> S; S.etab = etab; S.G = G; S.c = (MOE_HANDOFF && MOE_ROT && G == 256) ? ((bx & 4) ? 0 : 128) + (bx >> 3) * 4 + (bx & 3) : bx;     S.K = 512; S.A = (const char*)(P.ws + WS_ACT); if (MOE_HANDOFF) S.rdy = (unsigned*)(P.ws + WS_CTL) + CW_RDY; S.W = (const char*)(P.ws + WS_WD); S.wstride = (size_t)1024 * 1024; S.list = (const int*)(P.ws + WS_LIST);
        LAS float* etb = (LAS float*)(lds + EPITAB_OFF);
        { pg8::MUnit tu[5]; bool tok[5]; float tv[5];
#pragma unroll
          for (int q = 0; q < 5; ++q) tok[q] = S.next(q, tu[q]);
#pragma unroll
          for (int q = 0; q < 5; ++q) tv[q] = (tok[q] && tid < 256) ? P.b_d[(size_t)tu[q].e * 1024 + tu[q].pn * 256 + tid] * F8_SY : 0.f;
#pragma unroll
          for (int q = 0; q < 5; ++q) if (tok[q] && tid < 256) etb[q * 256 + tid] = tv[q];
          if (MOE_HANDOFF) {
#pragma unroll
              for (int q = 0; q < 3; ++q) if (tok[q]) pg8::MoeOrder<4, true, true>::wait_ready(S.rdy + tu[q].pm * 16);
              asm volatile("" ::: "memory"); }
          LDS_WAIT(); __syncthreads(); }
        pg8::EpiDown E{P.ws + WS_YEXP, P.b_d, (const float*)(P.ws + WS_GATEL), lds + EPISCR_OFF, P9_FP8 == 2 ? 1.0f : 1.0f / (F8_SC * F8_SW), etb};
        REP(9) pg8::gemm_phase<pg8::EpiDown, pg8::MoeOrder<4, true, true>, true, true, P9_FP8, 0x76767676, (int)0x81818181u>(lds + RING_OFF, 512, S, E, gtab);
        if (BOTH(9)) xcd_barrier(bar);
    }
    if (IN(10)) { p10_final<0>(P, lds, G, tid, wave, lane); AGAIN(10) { __syncthreads(); p10_final<1>(P, lds, G, tid, wave, lane); } }
#undef IN
#undef BOTH
}

extern "C" void kernel_launch(void* const* d_in, const int* in_sizes, int n_in, void* d_out, int out_size, void* d_ws, size_t ws_size, hipStream_t stream) {
    static int grid = 0;
    if (grid == 0) {
        if (n_in != 20 || out_size != M * DM || ws_size < WS_END) { fprintf(stderr, "kernel_launch: unexpected shapes (n_in %d out %d ws %zu)\n", n_in, out_size, ws_size); grid = -1; return; }
        int dev = 0, cus = 0;
        if (hipGetDevice(&dev) != hipSuccess || hipDeviceGetAttribute(&cus, hipDeviceAttributeMultiprocessorCount, dev) != hipSuccess) { grid = -1; return; }
        if (hipFuncSetAttribute((const void*)mega_fwd, hipFuncAttributeMaxDynamicSharedMemorySize, LDS_BYTES) != hipSuccess) { fprintf(stderr, "kernel_launch: hipFuncSetAttribute failed\n"); grid = -1; return; }
        (void)hipGetLastError();
        grid = cus;
    }
    if (grid < 0) return;
    (void)hipMemsetAsync((char*)d_ws + WS_CTL, 0, CTL_ZERO_BYTES, stream);
    Args a{};
    const float** pp = (const float**)&a.p;
    for (int i = 0; i < 20; ++i) pp[i] = (const float*)d_in[i];
    a.p.out = (float*)d_out; a.p.ws = (unsigned char*)d_ws;
    a.ph_lo = 0; a.ph_hi = 11; a.li = 0;
    hipLaunchKernelGGL(mega_fwd, dim3(grid), dim3(NWAVES * 64), LDS_BYTES, stream, a);
}
```
